# Optimizing an MI355X kernel written in HIP

```python
import jax, jax.numpy as jnp
from jax import lax
import numpy as np

D_MODEL = 1024
BATCH = 8
SEQ = 4096
DEPTH = 1

N_META = 16
MIX_WIDTH = D_MODEL
ATTN_WIDTH = MIX_WIDTH // 2
CONV_WIDTH = MIX_WIDTH - ATTN_WIDTH
HEAD_DIM = 64
N_ATTN_HEADS = ATTN_WIDTH // HEAD_DIM
Q_BLOCK = 128
CONV_K = 3
N_EXPERTS = 32
TOP_K = 4
D_FF = D_MODEL
SWIGLU_LIMIT = 7.0
SWIGLU_ALPHA = 1.702
MOE_BLOCK = 128
RMS_EPS = 1e-6
PROJ_WIDTH = 3 * ATTN_WIDTH + 3 * CONV_WIDTH

kernel_name = "hymba_stickbreak_shortconv_moe"


def rms_norm(x, g):
    xf = x.astype(jnp.float32)
    y = xf * lax.rsqrt(jnp.mean(xf * xf, axis=-1, keepdims=True) + RMS_EPS)
    return (y * g.astype(jnp.float32)).astype(x.dtype)


def stick_breaking_attention(q, k, v):
    b, h, t, d = q.shape
    pad = (-N_META) % Q_BLOCK
    n_blocks = -(-(pad + t) // Q_BLOCK)
    tail = n_blocks * Q_BLOCK - pad - t
    padw = ((0, 0), (0, 0), (pad, tail), (0, 0))
    qp, kp, vp = [jnp.pad(a, padw) for a in (q, k, v)]
    scale = d ** -0.5
    outs = []
    for i in range(n_blocks):
        q0, q1 = i * Q_BLOCK, (i + 1) * Q_BLOCK
        qb = qp[:, :, q0:q1]
        kb = kp[:, :, :q1]
        vb = vp[:, :, :q1]
        z = jnp.einsum('bhqd,bhkd->bhqk', qb, kb).astype(jnp.float32) * scale
        qpos = jnp.arange(q0, q1)[:, None]
        kpos = jnp.arange(q1)[None, :]
        valid = (kpos < qpos) & (kpos >= pad)
        log_keep = jnp.where(valid, -jax.nn.softplus(z), 0.0)
        later = lax.cumsum(log_keep, axis=3, reverse=True) - log_keep
        log_w = jax.nn.log_sigmoid(z) + later
        w = jnp.where(valid, jnp.exp(log_w), 0.0)
        outs.append(jnp.einsum('bhqk,bhkd->bhqd', w.astype(vb.dtype), vb))
    out = jnp.concatenate(outs, axis=2)
    return out[:, :, pad:pad + t]


def short_conv_mixer(xin, gate_b, gate_c, conv_w, conv_b):
    u = gate_c * xin
    y = lax.conv_general_dilated(
        u, conv_w[:, None, :].astype(u.dtype), window_strides=(1,),
        padding=[(CONV_K - 1, 0)], dimension_numbers=('NWC', 'WIO', 'NWC'),
        feature_group_count=u.shape[-1])
    return gate_b * (y + conv_b)


def clamped_swiglu(gu):
    gate, lin = jnp.split(gu, 2, axis=-1)
    gate = jnp.minimum(gate, SWIGLU_LIMIT)
    lin = jnp.clip(lin, -SWIGLU_LIMIT, SWIGLU_LIMIT)
    return (lin + 1.0) * (gate * jax.nn.sigmoid(SWIGLU_ALPHA * gate))


def moe(x, w_router, b_router, w_gu, b_gu, w_down, b_down):
    d = x.shape[-1]
    xf = x.reshape(-1, d)
    n = xf.shape[0]
    logits = (xf @ w_router).astype(jnp.float32) + b_router.astype(jnp.float32)
    top_logit, top_e = lax.top_k(logits, TOP_K)
    gates = jax.nn.softmax(top_logit, axis=-1)
    a = n * TOP_K
    e_flat = top_e.reshape(-1)
    order = jnp.argsort(e_flat)
    e_sorted = e_flat[order]
    counts = jnp.zeros((N_EXPERTS,), jnp.int32).at[e_flat].add(1)
    padded = (counts + MOE_BLOCK - 1) // MOE_BLOCK * MOE_BLOCK
    start = jnp.cumsum(counts) - counts
    pend = jnp.cumsum(padded)
    pstart = pend - padded
    dest = pstart[e_sorted] + (jnp.arange(a, dtype=jnp.int32) - start[e_sorted])
    n_blocks = -(-a // MOE_BLOCK) + N_EXPERTS
    cap = n_blocks * MOE_BLOCK
    slot_src = jnp.full((cap,), a, jnp.int32).at[dest].set(order.astype(jnp.int32))
    slot_tok = slot_src // TOP_K
    slot_gate = jnp.concatenate([gates.reshape(-1), jnp.zeros((1,), jnp.float32)])[slot_src]
    x_pad = jnp.concatenate([xf, jnp.zeros((1, d), xf.dtype)], axis=0)
    xs = x_pad[slot_tok].reshape(n_blocks, MOE_BLOCK, d)
    block_start = jnp.arange(n_blocks, dtype=jnp.int32) * MOE_BLOCK
    block_expert = jnp.clip(jnp.searchsorted(pend, block_start, side='right'), 0, N_EXPERTS - 1)

    def expert_block(args):
        xb, e = args
        hid = clamped_swiglu(xb @ w_gu[e] + b_gu[e])
        return hid @ w_down[e] + b_down[e]

    ys = lax.map(expert_block, (xs, block_expert)).reshape(cap, d)
    ys = ys * slot_gate[:, None].astype(ys.dtype)
    y = jax.ops.segment_sum(ys, slot_tok, num_segments=n + 1)[:n]
    return y.reshape(x.shape)


def setup_inputs(seed: int = 0) -> dict:
    key = jax.random.key(seed)
    ks = jax.random.split(key, 20)
    f32 = jnp.float32
    nrm = lambda k, s, sc: jax.random.normal(k, s, f32) * sc
    return {
        "x": nrm(ks[0], (BATCH, SEQ, D_MODEL), 1.0),
        "meta_tokens": nrm(ks[1], (N_META, D_MODEL), 1.0),
        "g_mix": 1.0 + nrm(ks[2], (DEPTH, D_MODEL), 0.02),
        "w_in": nrm(ks[3], (DEPTH, D_MODEL, PROJ_WIDTH), D_MODEL ** -0.5),
        "g_attn_out": 1.0 + nrm(ks[4], (DEPTH, ATTN_WIDTH), 0.02),
        "conv_w": nrm(ks[5], (DEPTH, CONV_K, CONV_WIDTH), CONV_K ** -0.5),
        "conv_b": nrm(ks[6], (DEPTH, CONV_WIDTH), 0.02),
        "g_conv_out": 1.0 + nrm(ks[7], (DEPTH, CONV_WIDTH), 0.02),
        "w_out": nrm(ks[8], (DEPTH, MIX_WIDTH, D_MODEL), MIX_WIDTH ** -0.5),
        "g_ffn": 1.0 + nrm(ks[9], (DEPTH, D_MODEL), 0.02),
        "w_router": nrm(ks[10], (DEPTH, D_MODEL, N_EXPERTS), D_MODEL ** -0.5),
        "b_router": nrm(ks[11], (DEPTH, N_EXPERTS), 0.01),
        "w_gu": nrm(ks[12], (DEPTH, N_EXPERTS, D_MODEL, 2 * D_FF), D_MODEL ** -0.5),
        "b_gu": nrm(ks[13], (DEPTH, N_EXPERTS, 2 * D_FF), 0.01),
        "w_down": nrm(ks[14], (DEPTH, N_EXPERTS, D_FF, D_MODEL), D_FF ** -0.5),
        "b_down": nrm(ks[15], (DEPTH, N_EXPERTS, D_MODEL), 0.01),
        "g_final": 1.0 + nrm(ks[16], (D_MODEL,), 0.02),
    }


def reference(x, meta_tokens, g_mix, w_in, g_attn_out, conv_w, conv_b, g_conv_out,
              w_out, g_ffn, w_router, b_router, w_gu, b_gu, w_down, b_down, g_final):
    b = x.shape[0]
    meta = jnp.broadcast_to(meta_tokens[None].astype(x.dtype), (b, N_META, x.shape[-1]))
    h = jnp.concatenate([meta, x], axis=1)
    t = h.shape[1]
    A, C = ATTN_WIDTH, CONV_WIDTH
    cuts = [A, 2 * A, 3 * A, 3 * A + C, 3 * A + 2 * C]
    for l in range(DEPTH):
        n = rms_norm(h, g_mix[l])
        proj = n @ w_in[l]
        q, k, v, cb, cc, cx = jnp.split(proj, cuts, axis=-1)
        to_heads = lambda a: a.reshape(b, t, N_ATTN_HEADS, HEAD_DIM).transpose(0, 2, 1, 3)
        att = stick_breaking_attention(to_heads(q), to_heads(k), to_heads(v))
        att = att.transpose(0, 2, 1, 3).reshape(b, t, A)
        conv = short_conv_mixer(cx, cb, cc, conv_w[l], conv_b[l])
        mixed = jnp.concatenate([rms_norm(att, g_attn_out[l]),
                                 rms_norm(conv, g_conv_out[l])], axis=-1)
        h = h + mixed @ w_out[l]
        h = h + moe(rms_norm(h, g_ffn[l]), w_router[l], b_router[l],
                    w_gu[l], b_gu[l], w_down[l], b_down[l])
    return rms_norm(h, g_final)[:, N_META:]
```

```cpp
#include <hip/hip_runtime.h>
#include <cstdio>
#include <cstdint>

#define GAS __attribute__((address_space(1)))
#define LAS __attribute__((address_space(3)))
typedef unsigned short bf16_t;
typedef short bf16x8 __attribute__((ext_vector_type(8)));
typedef float f32x2 __attribute__((ext_vector_type(2)));
typedef float f32x4 __attribute__((ext_vector_type(4)));
typedef float f32x16 __attribute__((ext_vector_type(16)));
typedef unsigned u32x2 __attribute__((ext_vector_type(2)));
typedef unsigned u32x4 __attribute__((ext_vector_type(4)));
typedef int i32x4 __attribute__((ext_vector_type(4)));
typedef __bf16 bf16x2_t __attribute__((ext_vector_type(2)));
typedef GAS unsigned gu32;
#define RLX_AGENT __ATOMIC_RELAXED, __HIP_MEMORY_SCOPE_AGENT

constexpr int DM = 1024, NB = 8, SEQ = 4096, NTOK = NB * SEQ;
constexpr int NMETA = 16, KPAD = 48, TPAD = KPAD + NMETA + SEQ;
constexpr int QOFF = KPAD + NMETA;
constexpr int AW = 512, NH = 8, HD = 64;
constexpr int NE = 32, TOPK = 4, FF = 1024;
constexpr int CAP_TILES = 544, CAP = CAP_TILES * 256;
constexpr float RMS_EPS = 1e-6f;
constexpr float LOG2E = 1.4426950408889634f;
constexpr float QSCALE = 0.125f * LOG2E;
constexpr float EXIT_THR = -152.0f;
constexpr int NWAVES = 8;

constexpr size_t MiB = 1u << 20, KiB = 1u << 10;
constexpr size_t WS_CTL = 0, CTL_ZERO_BYTES = 64 * KiB;
constexpr size_t WS_RSTD1 = 1 * MiB, WS_RSTD2 = WS_RSTD1 + 128 * KiB, WS_CNT = WS_RSTD2 + 128 * KiB, WS_TILEE = WS_CNT + 64 * KiB, WS_META = WS_TILEE + 64 * KiB;
constexpr size_t WS_TOPE = 2 * MiB, WS_GATE = WS_TOPE + 512 * KiB, WS_TOKSLOT = 3 * MiB;
constexpr size_t WS_SLOTTOK = 4 * MiB, WS_SLOTGATE = 5 * MiB, WS_SLOTRSTD = 6 * MiB;
constexpr size_t WS_SSP = 8 * MiB;
constexpr size_t WS_WIN = 10 * MiB, WS_WGU = 16 * MiB, WS_WD = 144 * MiB, WS_A = 208 * MiB;
constexpr size_t WS_HID = 272 * MiB;
constexpr size_t WS_Q = 272 * MiB, WS_KB = 304 * MiB, WS_VT = 337 * MiB, WS_CB = 370 * MiB, WS_CC = 402 * MiB, WS_CX = 434 * MiB, WS_MIXED = 466 * MiB;
constexpr size_t WS_YS = 544 * MiB, WS_WOUT = 816 * MiB, WS_END = 818 * MiB;
static_assert(WS_MIXED + 64 * MiB <= WS_HID + (size_t)CAP * 2048 && WS_HID + (size_t)CAP * 2048 <= WS_YS && WS_YS + (size_t)CAP * 2048 <= WS_WOUT, "ws map");
static_assert((size_t)NB * TPAD * 512 * 2 <= 33 * MiB, "K/Vt size");
constexpr int CW_TMO = 0, CW_BAR = 1024;

constexpr int RING_BYTES = 131072, LDSCTL_OFF = RING_BYTES, MISC_OFF = LDSCTL_OFF + 320, LDS_BYTES = 147456;

__device__ __forceinline__ unsigned cvtpk(float lo, float hi) { f32x2 v = {lo, hi}; bf16x2_t b = __builtin_convertvector(v, bf16x2_t); return __builtin_bit_cast(unsigned, b); }
__device__ __forceinline__ float bflo(unsigned u) { return __builtin_bit_cast(float, u << 16); }
__device__ __forceinline__ float bfhi(unsigned u) { return __builtin_bit_cast(float, u & 0xffff0000u); }
__device__ __forceinline__ float ex2(float x) { return __builtin_amdgcn_exp2f(x); }
__device__ __forceinline__ float lg2(float x) { return __builtin_amdgcn_logf(x); }
__device__ __forceinline__ int ld_i(const int* p) { return __hip_atomic_load(p, RLX_AGENT); }
__device__ __forceinline__ float ld_f(const float* p) { return __builtin_bit_cast(float, __hip_atomic_load((const int*)p, RLX_AGENT)); }
__device__ __forceinline__ float wave_sum(float v) {
#pragma unroll
    for (int o = 1; o < 64; o <<= 1) v += __shfl_xor(v, o);
    return v;
}
#define LDS_WAIT() asm volatile("s_waitcnt lgkmcnt(0)" ::: "memory")
#define VM_WAIT() asm volatile("s_waitcnt vmcnt(0)" ::: "memory")

namespace pg8 {
constexpr int BM = 256, BK = 64, HALF = 128, HTB = HALF * BK * 2, STAGE_BYTES = 8 * HTB, NXCD = 8, WGM = 8, GK = 1024;
__host__ __device__ __forceinline__ int lds_byte(int r, int c) { const int st = (r >> 4) * 2 + (c >> 5), rr = r & 15, cc = c & 31, ob = rr * 64 + cc * 2; return st * 1024 + (ob ^ (((ob >> 9) & 1) << 5)); }
__host__ __device__ __forceinline__ void stage_rc(int b, int& R, int& C) { const int st = b / 1024, sb = b % 1024, swz = sb ^ (((sb >> 9) & 1) << 5); R = (st >> 1) * 16 + swz / 64; C = (st & 1) * 32 + (swz % 64) / 2; }
__host__ __device__ __forceinline__ int perm32(int rho) { const int n = rho >> 4, i = rho & 15; return 8 * (i >> 2) + 4 * n + (i & 3); }
struct Unit { int pm, pn, e; };

struct SchedPlain {
    const char* A; const char* Bt; int nM, nN, nwg, G, c;
    __device__ void init(const void* A_, const void* Bt_, int M, int N, int G_, int c_) { A = (const char*)A_; Bt = (const char*)Bt_; nM = M / BM; nN = N / BM; nwg = nM * nN; G = G_; c = c_; }
    __device__ __forceinline__ bool next(int i, Unit& u) const {
        const long L = (long)i * G + c; if (L >= nwg) return false;
        int wgid = (int)L; { const int q = nwg / NXCD, r = nwg % NXCD, xcd = wgid % NXCD, off = wgid / NXCD; wgid = (xcd < r ? xcd * (q + 1) : r * (q + 1) + (xcd - r) * q) + off; }
        const int nig = WGM * nN, gid = wgid / nig, fm = gid * WGM, gsz = (nM - fm) < WGM ? (nM - fm) : WGM;
        u.pm = fm + ((wgid % nig) % gsz); u.pn = (wgid % nig) / gsz; u.e = 0; return true;
    }
    __device__ __forceinline__ const char* a_tile(const Unit& u) const { return A + (size_t)u.pm * (size_t)(BM * GK * 2); }
    __device__ __forceinline__ const char* b_tile(const Unit& u) const { return Bt + (size_t)u.pn * (size_t)(BM * GK * 2); }
    __device__ __forceinline__ unsigned tok_off(int) const { return 0u; }
};
struct SchedGrouped {
    const char* A; const char* Bt; size_t estep; int nN, G, c, ntiles; const int* tile_e; const int* slot_tok;
    __device__ __forceinline__ bool next(int i, Unit& u) const {
        const int L = i * G + c; if (L >= ntiles * nN) return false;
        u.pm = L / nN; u.pn = L % nN; u.e = __builtin_amdgcn_readfirstlane(ld_i(tile_e + u.pm)); return true;
    }
    __device__ __forceinline__ const char* a_tile(const Unit& u) const { return A + (size_t)u.pm * (size_t)(BM * GK * 2); }
    __device__ __forceinline__ const char* b_tile(const Unit& u) const { return Bt + (size_t)u.e * estep + (size_t)u.pn * (size_t)(BM * GK * 2); }
    __device__ __forceinline__ unsigned tok_off(int row) const { return (unsigned)ld_i(slot_tok + row) * (unsigned)(GK * 2); }
};

template <class Epi, class Sched, bool GATHER>
__device__ __forceinline__ void gemm_phase(LAS unsigned char* lds, const Sched& S, const Epi& E) {
    constexpr int K = GK, nt = K / BK;
    const int tid = threadIdx.x, wid = __builtin_amdgcn_readfirstlane(tid >> 6), lane = tid & 63, wr = wid >> 2, wc = wid & 3, fr = lane & 15, fq = lane >> 4;
    unsigned voffA[2], voffB[2], stC2[2]; int stR[2];
#pragma unroll
    for (int i = 0; i < 2; ++i) { int R, C; stage_rc(tid * 16 + i * 8192, R, C); const int Rb = (R & ~31) + perm32(R & 31);
        voffA[i] = (unsigned)(R * K + C) * 2u; voffB[i] = (unsigned)(Rb * K + C) * 2u; stR[i] = R; stC2[i] = (unsigned)C * 2u; }
    constexpr size_t kstep = (size_t)(BK * 2), hstep = (size_t)HALF * K * 2;
    const unsigned ldsw = (unsigned)wid * 1024u;
    const int aoff = lds_byte(wr * 64 + fr, fq * 8), boff = lds_byte(wc * 32 + fr, fq * 8);
#define PG8_SA(b, h) (((b) * 2 + (h)) * HTB)
#define PG8_SB(b, h) ((4 + (b) * 2 + (h)) * HTB)
#define PG8_STAGE2(bufoff, gbase, o0, o1) do { \
        __builtin_amdgcn_global_load_lds((const unsigned*)((const char*)(gbase) + (o0)), (LAS unsigned*)(lds + (bufoff) + ldsw), 16, 0, 0); \
        __builtin_amdgcn_global_load_lds((const unsigned*)((const char*)(gbase) + (o1)), (LAS unsigned*)(lds + (bufoff) + ldsw + 8192), 16, 0, 0); } while (0)
#define PG8_STAGE_B(bufoff, gbase) PG8_STAGE2(bufoff, gbase, voffB[0], voffB[1])
#define PG8_STAGE_A(bufoff, usenext, h, koff) do { if constexpr (GATHER) { const char* _p = S.A + (koff); \
            const unsigned _o0 = (usenext) ? ng[h][0] : cg[h][0], _o1 = (usenext) ? ng[h][1] : cg[h][1]; PG8_STAGE2(bufoff, _p, _o0, _o1); } \
        else { const char* _p = ((usenext) ? nA : cA) + (size_t)(h) * hstep + (koff); PG8_STAGE2(bufoff, _p, voffA[0], voffA[1]); } } while (0)
#define PG8_LDA(dst, b, h) do { _Pragma("unroll") for (int m = 0; m < 4; ++m) _Pragma("unroll") for (int k = 0; k < 2; ++k) dst[m][k] = *(const LAS bf16x8*)(lds + PG8_SA(b, h) + aoff + m * 2048 + k * 1024); } while (0)
#define PG8_LDB(dst, b, h) do { _Pragma("unroll") for (int n = 0; n < 2; ++n) _Pragma("unroll") for (int k = 0; k < 2; ++k) dst[n][k] = *(const LAS bf16x8*)(lds + PG8_SB(b, h) + boff + n * 2048 + k * 1024); } while (0)
#define PG8_MMA(ai, bj, At, Bt) do { __builtin_amdgcn_s_setprio(1); _Pragma("unroll") for (int m = 0; m < 4; ++m) _Pragma("unroll") for (int n = 0; n < 2; ++n) _Pragma("unroll") for (int k = 0; k < 2; ++k) \
        acc[ai][bj][m][n] = __builtin_amdgcn_mfma_f32_16x16x32_bf16(Bt[n][k], At[m][k], acc[ai][bj][m][n], 0, 0, 0); __builtin_amdgcn_s_setprio(0); } while (0)
#define PG8_WAIT_V(n) asm volatile("s_waitcnt vmcnt(" #n ")" ::: "memory")
#define PG8_WAIT_L(n) asm volatile("s_waitcnt lgkmcnt(" #n ")" ::: "memory")
#define PG8_BAR __builtin_amdgcn_s_barrier()
#define PG8_SCHED __builtin_amdgcn_sched_barrier(0)
    Unit cur, nxt; int ui = 0;
    if (!S.next(0, cur)) return;
    f32x4 acc[2][2][4][2];
#pragma unroll
    for (int a = 0; a < 2; ++a)
#pragma unroll
        for (int b = 0; b < 2; ++b)
#pragma unroll
            for (int m = 0; m < 4; ++m)
#pragma unroll
                for (int n = 0; n < 2; ++n) acc[a][b][m][n] = (f32x4){0.f, 0.f, 0.f, 0.f};
    bf16x8 At[4][2], B0[2][2], B1[2][2];
    const char* cA = S.a_tile(cur); const char* cB = S.b_tile(cur);
    const char* nA = cA;
    unsigned cg[2][2], ng[2][2];
    if constexpr (GATHER) {
#pragma unroll
        for (int h = 0; h < 2; ++h)
#pragma unroll
            for (int i = 0; i < 2; ++i) { cg[h][i] = S.tok_off(cur.pm * BM + h * HALF + stR[i]) + stC2[i]; ng[h][i] = cg[h][i]; }
    } else {
#pragma unroll
        for (int h = 0; h < 2; ++h)
#pragma unroll
            for (int i = 0; i < 2; ++i) { cg[h][i] = 0u; ng[h][i] = 0u; }
    }
    PG8_STAGE_B(PG8_SB(0, 0), cB); PG8_STAGE_B(PG8_SB(0, 1), cB + hstep); PG8_STAGE_A(PG8_SA(0, 0), false, 0, 0); PG8_STAGE_A(PG8_SA(0, 1), false, 1, 0);
    if (wr == 1) PG8_BAR;
    PG8_WAIT_V(2); PG8_BAR;
    PG8_STAGE_B(PG8_SB(1, 0), cB + kstep); PG8_STAGE_A(PG8_SA(1, 0), false, 0, kstep); PG8_STAGE_B(PG8_SB(1, 1), cB + hstep + kstep);
    PG8_WAIT_V(6); PG8_BAR;
    for (;;) {
        const bool has_next = S.next(ui + 1, nxt);
        nA = has_next ? S.a_tile(nxt) : cA; const char* nB = has_next ? S.b_tile(nxt) : cB;
        for (int t = 0; t < nt; t += 2) {
            const bool last = (t == nt - 2);
            const size_t koff1 = (size_t)(t + 1) * kstep, koff2 = last ? (size_t)0 : (size_t)(t + 2) * kstep, koff3 = koff2 + kstep;
            const char* b2 = last ? nB : cB + (size_t)(t + 2) * kstep; const char* b3 = b2 + kstep;
            if constexpr (GATHER) { if (last && has_next) {
#pragma unroll
                for (int h = 0; h < 2; ++h)
#pragma unroll
                    for (int i = 0; i < 2; ++i) ng[h][i] = S.tok_off(nxt.pm * BM + h * HALF + stR[i]) + stC2[i]; } }
            PG8_LDB(B0, 0, 0); PG8_LDB(B1, 0, 1); PG8_SCHED; PG8_LDA(At, 0, 0); PG8_STAGE_A(PG8_SA(1, 1), false, 1, koff1);
            PG8_WAIT_V(8); PG8_WAIT_L(0); PG8_BAR; PG8_MMA(0, 0, At, B0); PG8_MMA(0, 1, At, B1); PG8_BAR; PG8_SCHED;
            PG8_LDA(At, 0, 1); PG8_STAGE_B(PG8_SB(0, 0), b2); PG8_STAGE_B(PG8_SB(0, 1), b2 + hstep); PG8_STAGE_A(PG8_SA(0, 0), last, 0, koff2);
            PG8_WAIT_V(8); PG8_WAIT_L(0); PG8_BAR; PG8_MMA(1, 0, At, B0); PG8_MMA(1, 1, At, B1); PG8_BAR; PG8_SCHED;
            PG8_LDB(B0, 1, 0); PG8_LDB(B1, 1, 1); PG8_SCHED; PG8_LDA(At, 1, 0); PG8_STAGE_A(PG8_SA(0, 1), last, 1, koff2);
            PG8_WAIT_V(8); PG8_WAIT_L(0); PG8_BAR; PG8_MMA(0, 0, At, B0); PG8_MMA(0, 1, At, B1); PG8_BAR; PG8_SCHED;
            PG8_LDA(At, 1, 1); PG8_STAGE_B(PG8_SB(1, 0), b3); PG8_STAGE_B(PG8_SB(1, 1), b3 + hstep); PG8_STAGE_A(PG8_SA(1, 0), last, 0, koff3);
            PG8_WAIT_V(8); PG8_WAIT_L(0); PG8_BAR; PG8_MMA(1, 0, At, B0); PG8_MMA(1, 1, At, B1); PG8_BAR; PG8_SCHED;
        }
        if (wr == 0) PG8_BAR;
        E(acc, cur, wr, wc, fr, fq);
        if (!has_next) break;
#pragma unroll
        for (int a = 0; a < 2; ++a)
#pragma unroll
            for (int b = 0; b < 2; ++b)
#pragma unroll
                for (int m = 0; m < 4; ++m)
#pragma unroll
                    for (int n = 0; n < 2; ++n) acc[a][b][m][n] = (f32x4){0.f, 0.f, 0.f, 0.f};
        cur = nxt; cA = nA; cB = nB; ++ui;
#pragma unroll
        for (int h = 0; h < 2; ++h)
#pragma unroll
            for (int i = 0; i < 2; ++i) cg[h][i] = ng[h][i];
        if (wr == 1) PG8_BAR;
    }
    PG8_WAIT_V(0);
    PG8_BAR;
#undef PG8_SA
#undef PG8_SB
#undef PG8_STAGE2
#undef PG8_STAGE_B
#undef PG8_STAGE_A
#undef PG8_LDA
#undef PG8_LDB
#undef PG8_MMA
#undef PG8_WAIT_V
#undef PG8_WAIT_L
#undef PG8_BAR
#undef PG8_SCHED
}
}

#define XB_TMO      128
#define XB_XCNT(j)  (256  + 64 * (j))
#define XB_XSUB(j)  (1280 + 64 * (j))
#define XB_XGEN(j)  (2304 + 64 * (j))
#define XB_TOP      3328
#define XB_TOPGEN   3392
#define XCD_BAR_WORDS 3456
#define XB_SPIN_CAP (1u << 18)

__device__ __forceinline__ unsigned xb_ld(unsigned* p)              { return __hip_atomic_load(p, __ATOMIC_RELAXED, __HIP_MEMORY_SCOPE_AGENT); }
__device__ __forceinline__ unsigned xb_add(unsigned* p, unsigned v) { return __hip_atomic_fetch_add(p, v, __ATOMIC_RELAXED, __HIP_MEMORY_SCOPE_AGENT); }
__device__ __forceinline__ unsigned xb_xcc_id() { return (unsigned)__builtin_amdgcn_s_getreg((3 << 11) | 20) & 0xFu; }
#define XB_SPIN(cond, bar) do { unsigned _sp = 0; while (cond) { __builtin_amdgcn_s_sleep(1); \
    if ((++_sp & 255u) == 0u) { if (xb_ld(&(bar)[XB_TMO])) break; if (_sp > XB_SPIN_CAP) { atomicAdd(&(bar)[XB_TMO], 1u); break; } } } } while (0)

struct XcdBarrier {
    unsigned* bar; unsigned x;
    volatile LAS unsigned* st;
};

__device__ __forceinline__ XcdBarrier xcd_barrier_post(unsigned* bar, volatile LAS unsigned* st) {
    XcdBarrier b; b.bar = bar; b.x = xb_xcc_id(); b.st = st;
    if (threadIdx.x == 0) (void)xb_add(&bar[XB_XCNT(b.x)], 1u);
    return b;
}
__device__ __forceinline__ void xcd_barrier_complete(unsigned* bar, unsigned x, unsigned& nloc, unsigned& nx) {
    const unsigned G = gridDim.x * gridDim.y * gridDim.z;
    unsigned sum, cnt, mine, sp = 0u;
    for (;;) {
        sum = 0u; cnt = 0u; mine = 0u;
#pragma unroll
        for (unsigned j = 0; j < 16; ++j) { const unsigned c = xb_ld(&bar[XB_XCNT(j)]); sum += c; cnt += (c > 0u) ? 1u : 0u; mine = (j == x) ? c : mine; }
        if (sum == G) break;
        __builtin_amdgcn_s_sleep(1);
        if ((++sp & 255u) == 0u) { if (xb_ld(&bar[XB_TMO])) break; if (sp > XB_SPIN_CAP) { atomicAdd(&bar[XB_TMO], 1u); break; } }
    }
    nloc = mine > 0u ? mine : 1u; nx = cnt > 0u ? cnt : 1u;
}

__device__ __forceinline__ void xcd_barrier(const XcdBarrier& b) {
    asm volatile("s_waitcnt vmcnt(0)" ::: "memory");
    __syncthreads();
    if (threadIdx.x == 0) {
        unsigned* bar = b.bar;
        __builtin_amdgcn_s_waitcnt(0);
        unsigned nloc = b.st[0], nx = b.st[1];
        if (nloc == 0u) { xcd_barrier_complete(bar, b.x, nloc, nx); b.st[0] = nloc; b.st[1] = nx; }
        const unsigned old = xb_add(&bar[XB_XSUB(b.x)], 1u);
        const unsigned gen = old / nloc;
        if (old + 1u == (gen + 1u) * nloc) {
            __builtin_amdgcn_fence(__ATOMIC_RELEASE, "agent");
            asm volatile("s_waitcnt vmcnt(0)" ::: "memory");
            const unsigned og = xb_add(&bar[XB_TOP], 1u);
            const unsigned tg = og / nx;
            if (og + 1u == (tg + 1u) * nx) xb_add(&bar[XB_TOPGEN], 1u);
            else XB_SPIN(xb_ld(&bar[XB_TOPGEN]) == tg, bar);
            __builtin_amdgcn_fence(__ATOMIC_ACQUIRE, "agent");
            xb_add(&bar[XB_XGEN(b.x)], 1u);
            asm volatile("s_waitcnt vmcnt(0)" ::: "memory");
        } else {
            XB_SPIN(xb_ld(&bar[XB_XGEN(b.x)]) == gen, bar);
            __builtin_amdgcn_fence(__ATOMIC_ACQUIRE, "agent");
            asm volatile("s_waitcnt vmcnt(0)" ::: "memory");
        }
    }
    __syncthreads();
}

typedef f32x4 AccT[2][2][4][2];
struct EpiProj {
    bf16_t *Q, *KB, *CB, *CC, *CX; const float* rstd1;
    __device__ __forceinline__ void operator()(const AccT& acc, const pg8::Unit& u, int wr, int wc, int fr, int fq) const {
        const int sec = u.pn >> 1, row0 = u.pm * 256 + wr * 64 + fr, col0 = (u.pn & 1) * 256 + wc * 32 + 8 * fq;
        bf16_t* base = sec == 0 ? Q : sec == 1 ? KB : sec == 2 ? CB : sec == 3 ? CC : CX;
        const int radd = (sec == 1) ? 64 * ((u.pm >> 4) + 1) : 0;
        const float sc0 = (sec == 0) ? QSCALE : 1.0f;
#pragma unroll
        for (int ai = 0; ai < 2; ++ai)
#pragma unroll
            for (int m = 0; m < 4; ++m) { const int r = row0 + ai * 128 + m * 16; const float sc = ld_f(rstd1 + r) * sc0;
                bf16_t* rowp = base + (size_t)(r + radd) * 512 + col0;
#pragma unroll
                for (int bj = 0; bj < 2; ++bj) { const f32x4 v0 = acc[ai][bj][m][0] * sc, v1 = acc[ai][bj][m][1] * sc;
                    u32x4 w; w.x = cvtpk(v0[0], v0[1]); w.y = cvtpk(v0[2], v0[3]); w.z = cvtpk(v1[0], v1[1]); w.w = cvtpk(v1[2], v1[3]);
                    *(u32x4*)(rowp + bj * 128) = w; } }
    }
};
struct EpiVt {
    bf16_t* VT; const float* rstd1;
    __device__ __forceinline__ void operator()(const AccT& acc, const pg8::Unit& u, int wr, int wc, int fr, int fq) const {
        const int row0 = u.pm * 256 + wr * 64 + fr, col0 = u.pn * 256 + wc * 32 + 8 * fq;
        f32x4 rs[2][2];
#pragma unroll
        for (int bj = 0; bj < 2; ++bj)
#pragma unroll
            for (int n = 0; n < 2; ++n)
#pragma unroll
                for (int i = 0; i < 4; ++i) rs[bj][n][i] = ld_f(rstd1 + col0 + bj * 128 + 4 * n + i);
        const int dcol0 = col0 + 64 * ((u.pn >> 4) + 1);
#pragma unroll
        for (int ai = 0; ai < 2; ++ai)
#pragma unroll
            for (int m = 0; m < 4; ++m) { bf16_t* rowp = VT + (size_t)(row0 + ai * 128 + m * 16) * (size_t)(NB * TPAD) + dcol0;
#pragma unroll
                for (int bj = 0; bj < 2; ++bj) { const f32x4 v0 = acc[ai][bj][m][0] * rs[bj][0], v1 = acc[ai][bj][m][1] * rs[bj][1];
                    u32x4 w; w.x = cvtpk(v0[0], v0[1]); w.y = cvtpk(v0[2], v0[3]); w.z = cvtpk(v1[0], v1[1]); w.w = cvtpk(v1[2], v1[3]);
                    *(u32x4*)(rowp + bj * 128) = w; } }
    }
};
struct EpiOut {
    const float* x; float* h1; bf16_t* A2; float* ssp; const float* gffn;
    __device__ __forceinline__ void operator()(const AccT& acc, const pg8::Unit& u, int wr, int wc, int fr, int fq) const {
        const int row0 = u.pm * 256 + wr * 64 + fr, col0 = u.pn * 256 + wc * 32 + 8 * fq;
        f32x4 g[2][2];
#pragma unroll
        for (int bj = 0; bj < 2; ++bj)
#pragma unroll
            for (int n = 0; n < 2; ++n) g[bj][n] = *(const f32x4*)(gffn + col0 + bj * 128 + 4 * n);
#pragma unroll
        for (int ai = 0; ai < 2; ++ai)
#pragma unroll
            for (int m = 0; m < 4; ++m) { const int r = row0 + ai * 128 + m * 16; const size_t ro = (size_t)r * DM + col0; float ss = 0.f;
#pragma unroll
                for (int bj = 0; bj < 2; ++bj) {
                    const f32x4 v0 = acc[ai][bj][m][0] + *(const f32x4*)(x + ro + bj * 128), v1 = acc[ai][bj][m][1] + *(const f32x4*)(x + ro + bj * 128 + 4);
                    *(f32x4*)(h1 + ro + bj * 128) = v0; *(f32x4*)(h1 + ro + bj * 128 + 4) = v1;
                    ss += (v0[0] * v0[0] + v0[1] * v0[1]) + (v0[2] * v0[2] + v0[3] * v0[3]) + (v1[0] * v1[0] + v1[1] * v1[1]) + (v1[2] * v1[2] + v1[3] * v1[3]);
                    const f32x4 a0 = v0 * g[bj][0], a1 = v1 * g[bj][1];
                    u32x4 w; w.x = cvtpk(a0[0], a0[1]); w.y = cvtpk(a0[2], a0[3]); w.z = cvtpk(a1[0], a1[1]); w.w = cvtpk(a1[2], a1[3]);
                    *(u32x4*)(A2 + ro + bj * 128) = w; }
                ss += __shfl_xor(ss, 16); ss += __shfl_xor(ss, 32);
                if (fq == 0) ssp[(size_t)r * 16 + u.pn * 4 + wc] = ss; }
    }
};
struct EpiGU {
    bf16_t* hid; const float* bgu; const float* slot_rstd;
    __device__ __forceinline__ void operator()(const AccT& acc, const pg8::Unit& u, int wr, int wc, int fr, int fq) const {
        const int row0 = u.pm * 256 + wr * 64 + fr, colr = u.pn * 128 + wc * 32 + 8 * fq;
        const float* bg = bgu + (size_t)u.e * 2048 + colr;
        const f32x4 bg0 = *(const f32x4*)(bg), bg1 = *(const f32x4*)(bg + 4), bl0 = *(const f32x4*)(bg + 1024), bl1 = *(const f32x4*)(bg + 1028);
#pragma unroll
        for (int ai = 0; ai < 2; ++ai)
#pragma unroll
            for (int m = 0; m < 4; ++m) { const int r = row0 + ai * 128 + m * 16; const float rs = ld_f(slot_rstd + r);
                float hv[8];
#pragma unroll
                for (int n = 0; n < 2; ++n)
#pragma unroll
                    for (int i = 0; i < 4; ++i) {
                        float gt = acc[ai][0][m][n][i] * rs + (n ? bg1[i] : bg0[i]), ln = acc[ai][1][m][n][i] * rs + (n ? bl1[i] : bl0[i]);
                        gt = fminf(gt, 7.0f); ln = fminf(fmaxf(ln, -7.0f), 7.0f);
                        const float sg = __builtin_amdgcn_rcpf(1.0f + ex2(gt * (-1.702f * LOG2E)));
                        hv[n * 4 + i] = (ln + 1.0f) * (gt * sg); }
                u32x4 w; w.x = cvtpk(hv[0], hv[1]); w.y = cvtpk(hv[2], hv[3]); w.z = cvtpk(hv[4], hv[5]); w.w = cvtpk(hv[6], hv[7]);
                *(u32x4*)(hid + (size_t)r * FF + colr) = w; }
    }
};
struct EpiDown {
    bf16_t* ys; const float* bd; const float* slot_gate;
    __device__ __forceinline__ void operator()(const AccT& acc, const pg8::Unit& u, int wr, int wc, int fr, int fq) const {
        const int row0 = u.pm * 256 + wr * 64 + fr, col0 = u.pn * 256 + wc * 32 + 8 * fq;
        f32x4 bv[2][2];
#pragma unroll
        for (int bj = 0; bj < 2; ++bj)
#pragma unroll
            for (int n = 0; n < 2; ++n) bv[bj][n] = *(const f32x4*)(bd + (size_t)u.e * DM + col0 + bj * 128 + 4 * n);
#pragma unroll
        for (int ai = 0; ai < 2; ++ai)
#pragma unroll
            for (int m = 0; m < 4; ++m) { const int r = row0 + ai * 128 + m * 16; const float gt = ld_f(slot_gate + r);
                bf16_t* rowp = ys + (size_t)r * DM + col0;
#pragma unroll
                for (int bj = 0; bj < 2; ++bj) { const f32x4 v0 = (acc[ai][bj][m][0] + bv[bj][0]) * gt, v1 = (acc[ai][bj][m][1] + bv[bj][1]) * gt;
                    u32x4 w; w.x = cvtpk(v0[0], v0[1]); w.y = cvtpk(v0[2], v0[3]); w.z = cvtpk(v1[0], v1[1]); w.w = cvtpk(v1[2], v1[3]);
                    *(u32x4*)(rowp + bj * 128) = w; } }
    }
};

struct Args { const float* in[17]; float* out; unsigned char* ws; int ph_lo, ph_hi; };
struct Frame {
    LAS unsigned char* lds; gu32* ctl; int tid, lane, wave, vcu, G;
    const float *x, *meta, *g_mix, *w_in, *g_attn, *conv_w, *conv_b, *g_conv, *w_out, *g_ffn, *w_router, *b_router, *w_gu, *b_gu, *w_down, *b_down, *g_final;
    float* out; unsigned char* ws;
};
template <class T> __device__ __forceinline__ T* wsp(const Frame& F, size_t off) { return (T*)(F.ws + off); }

__device__ __forceinline__ void p0_transpose_item(const float* W, int ldw, int k0, int n0, bf16_t* WT, int Kd, int drow0, LAS float* scr, int lane) {
#pragma unroll 8
    for (int i = 0; i < 32; ++i) { const int kk = 2 * i + (lane >> 5); scr[kk * 33 + (lane & 31)] = W[(size_t)(k0 + kk) * ldw + n0 + (lane & 31)]; }
    LDS_WAIT(); asm volatile("" ::: "memory");
    const int c = lane & 7;
#pragma unroll
    for (int j = 0; j < 4; ++j) { const int n = (lane >> 3) + 8 * j; const LAS float* s = scr + (8 * c) * 33 + n;
        u32x4 o; o.x = cvtpk(s[0 * 33], s[1 * 33]); o.y = cvtpk(s[2 * 33], s[3 * 33]); o.z = cvtpk(s[4 * 33], s[5 * 33]); o.w = cvtpk(s[6 * 33], s[7 * 33]);
        *(u32x4*)(WT + (size_t)(drow0 + n) * Kd + k0 + 8 * c) = o; }
    LDS_WAIT(); asm volatile("" ::: "memory");
}
__device__ __forceinline__ void p0_meta_job(Frame& F, int mw) {
    LAS float* nm = (LAS float*)F.lds;
    LAS float* part = (LAS float*)(F.lds + 65536);
    for (int t = F.wave * 2; t < F.wave * 2 + 2; ++t) {
        float v[16]; float ss = 0.f;
#pragma unroll
        for (int j = 0; j < 16; ++j) { v[j] = F.meta[t * DM + j * 64 + F.lane]; ss += v[j] * v[j]; }
        const float rstd = 1.0f / sqrtf(wave_sum(ss) * (1.0f / DM) + RMS_EPS);
#pragma unroll
        for (int j = 0; j < 16; ++j) { const int k = j * 64 + F.lane; nm[k * 16 + t] = v[j] * rstd * F.g_mix[k]; }
    }
    __syncthreads();
    const int kq = F.tid >> 7, c = F.tid & 127, j = mw * 128 + c, sec4 = j >> 9, jc = j & 511;
    const int ocol = (sec4 == 0 ? 512 : sec4 == 1 ? 1024 : sec4 == 2 ? 2048 : 2560) + jc;
    float acc[16];
#pragma unroll
    for (int t = 0; t < 16; ++t) acc[t] = 0.f;
    for (int k = kq * 256; k < kq * 256 + 256; ++k) {
        const float w = F.w_in[(size_t)k * 3072 + ocol];
        const LAS f32x4* nv = (const LAS f32x4*)(nm + k * 16);
#pragma unroll
        for (int q = 0; q < 4; ++q) { const f32x4 n4 = nv[q]; acc[4 * q] += w * n4[0]; acc[4 * q + 1] += w * n4[1]; acc[4 * q + 2] += w * n4[2]; acc[4 * q + 3] += w * n4[3]; }
    }
#pragma unroll
    for (int t = 0; t < 16; ++t) part[(kq * 128 + c) * 16 + t] = acc[t];
    __syncthreads();
    {
        const int tq = F.tid >> 7;
        bf16_t* KB = wsp<bf16_t>(F, WS_KB); bf16_t* VT = wsp<bf16_t>(F, WS_VT); float* MT = wsp<float>(F, WS_META);
#pragma unroll
        for (int tt = 0; tt < 4; ++tt) { const int t = 4 * tq + tt;
            const float v = (part[(0 * 128 + c) * 16 + t] + part[(1 * 128 + c) * 16 + t]) + (part[(2 * 128 + c) * 16 + t] + part[(3 * 128 + c) * 16 + t]);
            const bf16_t bv = (bf16_t)(cvtpk(v, 0.f) & 0xffffu);
            if (sec4 == 0) { for (int b = 0; b < NB; ++b) KB[(size_t)(b * TPAD + KPAD + t) * 512 + jc] = bv; }
            else if (sec4 == 1) { for (int b = 0; b < NB; ++b) VT[(size_t)jc * (NB * TPAD) + b * TPAD + KPAD + t] = bv; }
            else if (t >= 14) MT[((sec4 - 2) * 2 + (t - 14)) * 512 + jc] = v;
        }
    }
    __syncthreads();
}
__device__ __forceinline__ void p0_prologue(Frame& F) {
    if (blockIdx.x < 16) p0_meta_job(F, (int)blockIdx.x);
    const int gw = F.vcu * NWAVES + F.wave, NGW = F.G * NWAVES;
    {
        bf16_t* KB = wsp<bf16_t>(F, WS_KB); bf16_t* VT = wsp<bf16_t>(F, WS_VT);
        const int gt = F.vcu * 512 + F.tid, NT = F.G * 512;
        for (int i = gt; i < NB * KPAD * 64; i += NT) { const int b = i / (KPAD * 64), r = i % (KPAD * 64); *(u32x4*)(KB + (size_t)(b * TPAD) * 512 + (size_t)r * 8) = (u32x4){0u, 0u, 0u, 0u}; }
        for (int i = gt; i < 512 * NB * 6; i += NT) { const int ch = i / (NB * 6), r = i % (NB * 6), b = r / 6, q = r % 6; *(u32x4*)(VT + (size_t)ch * (NB * TPAD) + b * TPAD + q * 8) = (u32x4){0u, 0u, 0u, 0u}; }
    }
    {
        float* rstd1 = wsp<float>(F, WS_RSTD1); bf16_t* A1 = wsp<bf16_t>(F, WS_A);
        f32x4 g4[4];
#pragma unroll
        for (int j = 0; j < 4; ++j) g4[j] = *(const f32x4*)(F.g_mix + 256 * j + 4 * F.lane);
        for (int m = gw; m < NTOK; m += NGW) {
            const f32x4* xr = (const f32x4*)(F.x + (size_t)m * DM) + F.lane;
            f32x4 v[4]; float s = 0.f;
#pragma unroll
            for (int j = 0; j < 4; ++j) { v[j] = xr[64 * j]; s += (v[j][0] * v[j][0] + v[j][1] * v[j][1]) + (v[j][2] * v[j][2] + v[j][3] * v[j][3]); }
            s = wave_sum(s);
            if (F.lane == 0) rstd1[m] = 1.0f / sqrtf(s * (1.0f / DM) + RMS_EPS);
            u32x2* o8 = (u32x2*)(A1 + (size_t)m * DM) + F.lane;
#pragma unroll
            for (int j = 0; j < 4; ++j) { const f32x4 a = v[j] * g4[j]; u32x2 o; o.x = cvtpk(a[0], a[1]); o.y = cvtpk(a[2], a[3]); o8[64 * j] = o; }
        }
    }
    {
        LAS float* scr = (LAS float*)(F.lds + F.wave * 16384);
        constexpr int I_IN = 16 * 96, I_OUT = 16 * 32, I_GU = 32 * 16 * 64, I_D = 32 * 16 * 32, NITEMS = I_IN + I_OUT + I_GU + I_D;
        bf16_t* WIN = wsp<bf16_t>(F, WS_WIN); bf16_t* WOUT = wsp<bf16_t>(F, WS_WOUT); bf16_t* WGU = wsp<bf16_t>(F, WS_WGU); bf16_t* WD = wsp<bf16_t>(F, WS_WD);
        for (int it = gw; it < NITEMS; it += NGW) {
            int r = it;
            if (r < I_IN) { const int kb = r / 96, nb = r % 96, n0 = 32 * nb, sec = n0 >> 9;
                const int dsec = sec == 0 ? 0 : sec == 1 ? 1 : sec == 2 ? 5 : sec - 1;
                p0_transpose_item(F.w_in, 3072, 64 * kb, n0, WIN, DM, dsec * 512 + (n0 & 511), scr, F.lane); continue; }
            r -= I_IN;
            if (r < I_OUT) { const int kb = r / 32, nb = r % 32; p0_transpose_item(F.w_out, 1024, 64 * kb, 32 * nb, WOUT, DM, 32 * nb, scr, F.lane); continue; }
            r -= I_OUT;
            if (r < I_GU) { const int e = r / 1024, q = r % 1024, kb = q / 64, nb = q % 64, n0 = 32 * nb, c = n0 & 1023;
                const int drow = (c >> 7) * 256 + (n0 >= 1024 ? 128 : 0) + (c & 127);
                p0_transpose_item(F.w_gu + (size_t)e * 1024 * 2048, 2048, 64 * kb, n0, WGU + (size_t)e * 2048 * 1024, DM, drow, scr, F.lane); continue; }
            r -= I_GU;
            { const int e = r / 512, q = r % 512, kb = q / 32, nb = q % 32;
                p0_transpose_item(F.w_down + (size_t)e * 1024 * 1024, 1024, 64 * kb, 32 * nb, WD + (size_t)e * 1024 * 1024, FF, 32 * nb, scr, F.lane); }
        }
    }
}

template <bool EDGE>
__device__ __forceinline__ void sb_tile(f32x16& s0, f32x16& s1, float& carry, int kp0  , int qpos, bool hi0, bf16x8 (&pf)[2][2]) {
    float R[4];
#pragma unroll
    for (int q = 0; q < 4; ++q) {
        float S = 0.f;
#pragma unroll
        for (int i = 7; i >= 0; --i) {
            const int r = (q & 1) * 8 + i;
            const float z = (q < 2) ? s0[r] : s1[r];
            const float L = lg2(1.0f + ex2(-fabsf(z)));
            float sp = fmaxf(z, 0.f) + L; float ls = z - sp;
            if (EDGE) { const int kp = kp0 + 16 * q + i; const bool valid = (kp < qpos) && (kp >= KPAD); sp = valid ? sp : 0.f; ls = valid ? ls : -INFINITY; }
            const float m = ls - S; S += sp;
            if (q < 2) s0[r] = m; else s1[r] = m;
        }
        R[q] = S;
        __builtin_amdgcn_sched_barrier(0);
    }
    const float P0 = __shfl_xor(R[0], 32), P1 = __shfl_xor(R[1], 32), P2 = __shfl_xor(R[2], 32), P3 = __shfl_xor(R[3], 32);
    const float T0 = R[0] + P0, T1 = R[1] + P1, T2 = R[2] + P2, T3 = R[3] + P3;
    const float b3 = carry - (hi0 ? P3 : 0.f), b2 = carry - (T3 + (hi0 ? P2 : 0.f)), b1 = carry - ((T3 + T2) + (hi0 ? P1 : 0.f)), b0 = carry - ((T3 + T2 + T1) + (hi0 ? P0 : 0.f));
#pragma unroll
    for (int i = 0; i < 8; ++i) { s0[i] = ex2(s0[i] + b0); s0[8 + i] = ex2(s0[8 + i] + b1); s1[i] = ex2(s1[i] + b2); s1[8 + i] = ex2(s1[8 + i] + b3); }
    carry -= (T0 + T1) + (T2 + T3);
    u32x4 w;
    w.x = cvtpk(s0[0], s0[1]); w.y = cvtpk(s0[2], s0[3]); w.z = cvtpk(s0[4], s0[5]); w.w = cvtpk(s0[6], s0[7]); pf[0][0] = __builtin_bit_cast(bf16x8, w);
    w.x = cvtpk(s0[8], s0[9]); w.y = cvtpk(s0[10], s0[11]); w.z = cvtpk(s0[12], s0[13]); w.w = cvtpk(s0[14], s0[15]); pf[0][1] = __builtin_bit_cast(bf16x8, w);
    w.x = cvtpk(s1[0], s1[1]); w.y = cvtpk(s1[2], s1[3]); w.z = cvtpk(s1[4], s1[5]); w.w = cvtpk(s1[6], s1[7]); pf[1][0] = __builtin_bit_cast(bf16x8, w);
    w.x = cvtpk(s1[8], s1[9]); w.y = cvtpk(s1[10], s1[11]); w.z = cvtpk(s1[12], s1[13]); w.w = cvtpk(s1[14], s1[15]); pf[1][1] = __builtin_bit_cast(bf16x8, w);
}
#define MFMA32(a, b, c) __builtin_amdgcn_mfma_f32_32x32x16_bf16((a), (b), (c), 0, 0, 0)
__device__ __forceinline__ void p2_unit(Frame& F, int b, int qb) {
    int lane_ = F.lane, head_ = F.wave;
    asm volatile("" : "+v"(lane_), "+s"(head_));
    const int lane = lane_, head = head_, l31 = lane & 31, hi = lane >> 5; const bool hi0 = hi == 0;
    const bf16_t* Q = wsp<bf16_t>(F, WS_Q); const bf16_t* KB = wsp<bf16_t>(F, WS_KB); const bf16_t* VT = wsp<bf16_t>(F, WS_VT);
    bf16_t* MX = wsp<bf16_t>(F, WS_MIXED);
    LAS float* ssA = (LAS float*)F.lds;
    LAS float* ssC = (LAS float*)(F.lds + 1024);
    const int row0 = b * SEQ + qb * 32;
#ifndef P2_SKIP_CONV
    {
        const int cgp = lane & 7, rg = lane >> 3, ch0 = head * 64 + cgp * 8;
        const bf16_t* CB = wsp<bf16_t>(F, WS_CB); const bf16_t* CC = wsp<bf16_t>(F, WS_CC); const bf16_t* CX = wsp<bf16_t>(F, WS_CX); const float* MT = wsp<float>(F, WS_META);
        float cv[4][8];
        {
            float w0[8], w1[8], w2[8], bs[8], u2[8], u1[8];
#pragma unroll
            for (int k = 0; k < 8; ++k) { w0[k] = F.conv_w[ch0 + k]; w1[k] = F.conv_w[512 + ch0 + k]; w2[k] = F.conv_w[1024 + ch0 + k]; bs[k] = F.conv_b[ch0 + k]; u2[k] = 0.f; u1[k] = 0.f; }
#pragma unroll
            for (int i = -2; i < 4; ++i) {
                const int sl = qb * 32 + rg * 4 + i;
                float u[8];
                if (sl >= 0) {
                    const size_t ro = (size_t)(b * SEQ + sl) * 512 + ch0;
                    const u32x4 c4 = *(const u32x4*)(CC + ro), x4 = *(const u32x4*)(CX + ro);
                    u[0] = bflo(c4.x) * bflo(x4.x); u[1] = bfhi(c4.x) * bfhi(x4.x); u[2] = bflo(c4.y) * bflo(x4.y); u[3] = bfhi(c4.y) * bfhi(x4.y);
                    u[4] = bflo(c4.z) * bflo(x4.z); u[5] = bfhi(c4.z) * bfhi(x4.z); u[6] = bflo(c4.w) * bflo(x4.w); u[7] = bfhi(c4.w) * bfhi(x4.w);
                } else {
                    const int mt = 2 + sl;
                    const f32x4 c0 = *(const f32x4*)(MT + mt * 512 + ch0), c1 = *(const f32x4*)(MT + mt * 512 + ch0 + 4), x0 = *(const f32x4*)(MT + (2 + mt) * 512 + ch0), x1 = *(const f32x4*)(MT + (2 + mt) * 512 + ch0 + 4);
#pragma unroll
                    for (int k = 0; k < 4; ++k) { u[k] = c0[k] * x0[k]; u[4 + k] = c1[k] * x1[k]; }
                }
                if (i >= 0) {
                    const u32x4 b4 = *(const u32x4*)(CB + (size_t)(b * SEQ + sl) * 512 + ch0);
                    const float cbv[8] = {bflo(b4.x), bfhi(b4.x), bflo(b4.y), bfhi(b4.y), bflo(b4.z), bfhi(b4.z), bflo(b4.w), bfhi(b4.w)};
#pragma unroll
                    for (int k = 0; k < 8; ++k) cv[i < 0 ? 0 : i][k] = cbv[k] * (w0[k] * u2[k] + w1[k] * u1[k] + w2[k] * u[k] + bs[k]);
                }
#pragma unroll
                for (int k = 0; k < 8; ++k) { u2[k] = u1[k]; u1[k] = u[k]; }
            }
        }
#pragma unroll
        for (int i = 0; i < 4; ++i) { float ss = 0.f;
#pragma unroll
            for (int k = 0; k < 8; ++k) ss += cv[i][k] * cv[i][k];
            ss += __shfl_xor(ss, 1); ss += __shfl_xor(ss, 2); ss += __shfl_xor(ss, 4);
            if (cgp == 0) ssC[head * 32 + rg * 4 + i] = ss; }
        __syncthreads();
        const f32x4 gc0 = *(const f32x4*)(F.g_conv + ch0), gc1 = *(const f32x4*)(F.g_conv + ch0 + 4);
#pragma unroll
        for (int i = 0; i < 4; ++i) { const int rl = rg * 4 + i; float tot = 0.f;
#pragma unroll
            for (int w = 0; w < 8; ++w) tot += ssC[w * 32 + rl];
            const float rstd = 1.0f / sqrtf(tot * (1.0f / AW) + RMS_EPS);
            u32x4 w4; w4.x = cvtpk(cv[i][0] * rstd * gc0[0], cv[i][1] * rstd * gc0[1]); w4.y = cvtpk(cv[i][2] * rstd * gc0[2], cv[i][3] * rstd * gc0[3]);
            w4.z = cvtpk(cv[i][4] * rstd * gc1[0], cv[i][5] * rstd * gc1[1]); w4.w = cvtpk(cv[i][6] * rstd * gc1[2], cv[i][7] * rstd * gc1[3]);
            *(u32x4*)(MX + (size_t)(row0 + rl) * DM + 512 + ch0) = w4; }
    }
#endif
#ifndef P2_SKIP_ATT
    LAS bf16x8* qlds = (LAS bf16x8*)(F.lds + 4096 + head * 4096) + lane;
    {
        const bf16_t* Qp = Q + (size_t)(row0 + l31) * 512 + head * 64 + hi * 8;
#pragma unroll
        for (int s = 0; s < 4; ++s) qlds[s * 64] = *(const bf16x8*)(Qp + s * 16);
    }
    f32x16 o[2];
#pragma unroll
    for (int d = 0; d < 2; ++d)
#pragma unroll
        for (int r = 0; r < 16; ++r) o[d][r] = 0.f;
    float carry = 0.f;
    const int pi = (l31 & 0x13) | ((l31 & 4) << 1) | ((l31 & 8) >> 1);
    const __amdgpu_buffer_rsrc_t rsK = __builtin_amdgcn_make_buffer_rsrc((void*)(KB + (size_t)b * TPAD * 512), (short)0, TPAD * 512 * 2, 0x00020000);
    const __amdgpu_buffer_rsrc_t rsV = __builtin_amdgcn_make_buffer_rsrc((void*)(VT + (size_t)b * TPAD), (short)0, (511 * NB * TPAD + TPAD) * 2, 0x00020000);
    const int voffK = (pi * 512 + head * 64 + hi * 8) * 2;
    const int voffV = ((head * 64 + l31) * (NB * TPAD) + hi * 8) * 2;
    const int P0 = QOFF + 32 * qb, qpos = P0 + l31;
    for (int start = P0 - 32; ; start -= 64) {
        bf16x8 kf[2][4];
#pragma unroll
        for (int kb = 0; kb < 2; ++kb)
#pragma unroll
            for (int s = 0; s < 4; ++s) kf[kb][s] = __builtin_bit_cast(bf16x8, __builtin_amdgcn_raw_buffer_load_b128(rsK, voffK + kb * 32768 + s * 32, start * 1024, 0));
        bf16x8 vf[2][2][2];
#pragma unroll
        for (int d = 0; d < 2; ++d)
#pragma unroll
            for (int kb = 0; kb < 2; ++kb)
#pragma unroll
                for (int s2 = 0; s2 < 2; ++s2) vf[d][kb][s2] = __builtin_bit_cast(bf16x8, __builtin_amdgcn_raw_buffer_load_b128(rsV, voffV + d * (32 * NB * TPAD * 2) + kb * 64 + s2 * 32, start * 2, 0));
        const bool lastt = start <= KPAD;
        const bool edge = (start == P0 - 32) || lastt;
        f32x16 s0, s1;
#pragma unroll
        for (int r = 0; r < 16; ++r) { s0[r] = 0.f; s1[r] = 0.f; }
#pragma unroll
        for (int s = 0; s < 4; ++s) { const bf16x8 qf = qlds[s * 64]; s0 = MFMA32(kf[0][s], qf, s0); s1 = MFMA32(kf[1][s], qf, s1); }
        bf16x8 pf[2][2];
        if (edge) sb_tile<true>(s0, s1, carry, start + 8 * hi, qpos, hi0, pf);
        else sb_tile<false>(s0, s1, carry, start + 8 * hi, qpos, hi0, pf);
#pragma unroll
        for (int d = 0; d < 2; ++d)
#pragma unroll
            for (int kb = 0; kb < 2; ++kb)
#pragma unroll
                for (int s2 = 0; s2 < 2; ++s2) o[d] = MFMA32(vf[d][kb][s2], pf[kb][s2], o[d]);
        if (lastt || __all(carry < EXIT_THR)) break;
    }
    int lane2 = lane; asm volatile("" : "+v"(lane2));
    const int l31b = lane2 & 31, hib = lane2 >> 5;
    {
        float ss = 0.f;
#pragma unroll
        for (int d = 0; d < 2; ++d)
#pragma unroll
            for (int r = 0; r < 16; ++r) ss += o[d][r] * o[d][r];
        ss += __shfl_xor(ss, 32);
        if (hib == 0) ssA[head * 32 + l31b] = ss;
    }
    __syncthreads();
    {
        float tot = 0.f;
#pragma unroll
        for (int h = 0; h < 8; ++h) tot += ssA[h * 32 + l31b];
        const float rstd = 1.0f / sqrtf(tot * (1.0f / AW) + RMS_EPS);
        bf16_t* orow = MX + (size_t)(row0 + l31b) * DM + head * 64 + 4 * hib;
#pragma unroll
        for (int d = 0; d < 2; ++d)
#pragma unroll
            for (int g = 0; g < 4; ++g) { const f32x4 ga = *(const f32x4*)(F.g_attn + head * 64 + 32 * d + 8 * g + 4 * hib);
                u32x2 w; w.x = cvtpk(o[d][4 * g] * rstd * ga[0], o[d][4 * g + 1] * rstd * ga[1]); w.y = cvtpk(o[d][4 * g + 2] * rstd * ga[2], o[d][4 * g + 3] * rstd * ga[3]);
                *(u32x2*)(orow + 32 * d + 8 * g) = w; }
    }
    __syncthreads();
#endif
}

__device__ __forceinline__ void p4_router(Frame& F) {
    LAS unsigned char* img = F.lds;
    LAS int* hist = (LAS int*)(F.lds + 65536);
    for (int idx = F.tid; idx < 64 * 2 * 32; idx += 512) { const int s = idx >> 6, h = (idx >> 5) & 1, e = idx & 31; const float* wp = F.w_router + (size_t)(16 * s + 8 * h) * NE + e;
        u32x4 w; w.x = cvtpk(wp[0], wp[NE]); w.y = cvtpk(wp[2 * NE], wp[3 * NE]); w.z = cvtpk(wp[4 * NE], wp[5 * NE]); w.w = cvtpk(wp[6 * NE], wp[7 * NE]);
        *(LAS u32x4*)(img + idx * 16) = w; }
    if (F.tid < 32) hist[F.tid] = 0;
    __syncthreads();
    const bf16_t* A2 = wsp<bf16_t>(F, WS_A); const float* ssp = wsp<float>(F, WS_SSP); float* rstd2 = wsp<float>(F, WS_RSTD2);
    int* tope = wsp<int>(F, WS_TOPE); float* gate = wsp<float>(F, WS_GATE); int* cnt = wsp<int>(F, WS_CNT);
    const int wg = F.vcu;
    if (F.wave < 4) {
        const int l31 = F.lane & 31, hi = F.lane >> 5, row = wg * 128 + F.wave * 32 + l31;
        f32x16 acc;
#pragma unroll
        for (int r = 0; r < 16; ++r) acc[r] = 0.f;
        const bf16_t* ap = A2 + (size_t)row * DM + 8 * hi;
#pragma unroll 8
        for (int s = 0; s < 64; ++s) { const bf16x8 a = *(const LAS bf16x8*)(img + ((s * 2 + hi) * 32 + l31) * 16); const bf16x8 bq = *(const bf16x8*)(ap + 16 * s); acc = MFMA32(a, bq, acc); }
        float ss = 0.f;
#pragma unroll
        for (int q = 0; q < 4; ++q) { const f32x4 p4 = *(const f32x4*)(ssp + (size_t)row * 16 + 4 * q); ss += (p4[0] + p4[1]) + (p4[2] + p4[3]); }
        const float rstd = 1.0f / sqrtf(ss * (1.0f / DM) + RMS_EPS);
        float lg[16];
#pragma unroll
        for (int r = 0; r < 16; ++r) lg[r] = acc[r] * rstd + F.b_router[(r & 3) + 8 * (r >> 2) + 4 * hi];
        float cvv[8]; int cei[8];
#pragma unroll
        for (int k = 0; k < 4; ++k) { float best = -INFINITY; int bi = 0;
#pragma unroll
            for (int r = 0; r < 16; ++r) { const bool gtb = lg[r] > best; best = gtb ? lg[r] : best; bi = gtb ? r : bi; }
#pragma unroll
            for (int r = 0; r < 16; ++r) lg[r] = (r == bi) ? -INFINITY : lg[r];
            cvv[k] = best; cei[k] = (bi & 3) + 8 * (bi >> 2) + 4 * hi; }
#pragma unroll
        for (int k = 0; k < 4; ++k) { cvv[4 + k] = __shfl_xor(cvv[k], 32); cei[4 + k] = __shfl_xor(cei[k], 32); }
        float tv[4]; int te[4];
#pragma unroll
        for (int k = 0; k < 4; ++k) { float best = -INFINITY; int be = 1 << 30, bi = 0;
#pragma unroll
            for (int c = 0; c < 8; ++c) { const bool better = (cvv[c] > best) || (cvv[c] == best && cei[c] < be); best = better ? cvv[c] : best; be = better ? cei[c] : be; bi = better ? c : bi; }
#pragma unroll
            for (int c = 0; c < 8; ++c) { const bool hit = (c == bi); cvv[c] = hit ? -INFINITY : cvv[c]; cei[c] = hit ? (1 << 30) : cei[c]; }
            tv[k] = best; te[k] = be; }
        const float e1 = ex2((tv[1] - tv[0]) * LOG2E), e2 = ex2((tv[2] - tv[0]) * LOG2E), e3 = ex2((tv[3] - tv[0]) * LOG2E);
        const float inv = 1.0f / (1.0f + e1 + e2 + e3);
        if (hi == 0) {
            rstd2[row] = rstd;
            *(i32x4*)(tope + (size_t)row * 4) = (i32x4){te[0], te[1], te[2], te[3]};
            *(f32x4*)(gate + (size_t)row * 4) = (f32x4){inv, e1 * inv, e2 * inv, e3 * inv};
#pragma unroll
            for (int k = 0; k < 4; ++k) atomicAdd((int*)(hist + te[k]), 1);
        }
    }
    __syncthreads();
    if (F.tid < 32) cnt[wg * 32 + F.tid] = hist[F.tid];
    __syncthreads();
}

__device__ __forceinline__ void p5_scatter(Frame& F) {
    LAS int* tot = (LAS int*)F.lds; LAS int* pre = tot + 32; LAS int* ctr = tot + 64; LAS int* pstart = tot + 96;
    const int* cnt = wsp<int>(F, WS_CNT); const int wg = F.vcu;
    if (F.tid < 64) tot[F.tid] = 0;
    __syncthreads();
    { const int e = F.tid & 31, j = F.tid >> 5; int t = 0, p = 0;
        for (int w = j; w < 256; w += 16) { const int c = ld_i(cnt + w * 32 + e); t += c; p += (w < wg) ? c : 0; }
        atomicAdd((int*)(tot + e), t); atomicAdd((int*)(pre + e), p); }
    __syncthreads();
    if (F.tid == 0) { int run = 0; for (int e = 0; e < 32; ++e) { pstart[e] = run; run += (tot[e] + 255) & ~255; } pstart[32] = run; }
    __syncthreads();
    if (F.tid < 32) ctr[F.tid] = pstart[F.tid] + pre[F.tid];
    int* slot_tok = wsp<int>(F, WS_SLOTTOK); float* slot_gate = wsp<float>(F, WS_SLOTGATE); float* slot_rstd = wsp<float>(F, WS_SLOTRSTD);
    int* tile_e = wsp<int>(F, WS_TILEE);
    if (wg == 0) {
        if (F.tid < 32) { for (int rt = pstart[F.tid] >> 8; rt < (pstart[F.tid + 1] >> 8); ++rt) tile_e[rt] = F.tid; }
        if (F.tid == 0) tile_e[CAP_TILES] = pstart[32] >> 8;
    }
    if (wg < 32) { const int e = wg; for (int s = pstart[e] + tot[e] + F.tid; s < pstart[e + 1]; s += 512) { slot_tok[s] = 0; slot_gate[s] = 0.f; slot_rstd[s] = 0.f; } }
    __syncthreads();
    { const int tok = wg * 128 + (F.tid >> 2), k = F.tid & 3;
        const int e = ld_i(wsp<int>(F, WS_TOPE) + tok * 4 + k);
        const int slot = atomicAdd((int*)(ctr + e), 1);
        slot_tok[slot] = tok; slot_gate[slot] = ld_f(wsp<float>(F, WS_GATE) + tok * 4 + k); slot_rstd[slot] = ld_f(wsp<float>(F, WS_RSTD2) + tok);
        wsp<int>(F, WS_TOKSLOT)[tok * 4 + k] = slot; }
    __syncthreads();
}

__device__ __forceinline__ void p8_combine(Frame& F) {
    const int gw = F.vcu * NWAVES + F.wave, NGW = F.G * NWAVES;
    const bf16_t* ys = wsp<bf16_t>(F, WS_YS); const int* tokslot = wsp<int>(F, WS_TOKSLOT);
    f32x4 gf[2][2];
#pragma unroll
    for (int j = 0; j < 2; ++j) { gf[j][0] = *(const f32x4*)(F.g_final + 512 * j + 8 * F.lane); gf[j][1] = *(const f32x4*)(F.g_final + 512 * j + 8 * F.lane + 4); }
    for (int m = gw; m < NTOK; m += NGW) {
        int sl[4];
#pragma unroll
        for (int k = 0; k < 4; ++k) sl[k] = ld_i(tokslot + (size_t)m * 4 + k);
        float* hrow = F.out + (size_t)m * DM + 8 * F.lane;
        f32x4 v[2][2]; float ss = 0.f;
#pragma unroll
        for (int j = 0; j < 2; ++j) { v[j][0] = *(const f32x4*)(hrow + 512 * j); v[j][1] = *(const f32x4*)(hrow + 512 * j + 4);
#pragma unroll
            for (int k = 0; k < 4; ++k) { const u32x4 y = *(const u32x4*)(ys + (size_t)sl[k] * DM + 512 * j + 8 * F.lane);
                v[j][0][0] += bflo(y.x); v[j][0][1] += bfhi(y.x); v[j][0][2] += bflo(y.y); v[j][0][3] += bfhi(y.y);
                v[j][1][0] += bflo(y.z); v[j][1][1] += bfhi(y.z); v[j][1][2] += bflo(y.w); v[j][1][3] += bfhi(y.w); }
#pragma unroll
            for (int q = 0; q < 2; ++q) ss += (v[j][q][0] * v[j][q][0] + v[j][q][1] * v[j][q][1]) + (v[j][q][2] * v[j][q][2] + v[j][q][3] * v[j][q][3]); }
        const float rstd = 1.0f / sqrtf(wave_sum(ss) * (1.0f / DM) + RMS_EPS);
#pragma unroll
        for (int j = 0; j < 2; ++j) { *(f32x4*)(hrow + 512 * j) = v[j][0] * rstd * gf[j][0]; *(f32x4*)(hrow + 512 * j + 4) = v[j][1] * rstd * gf[j][1]; }
    }
}

constexpr int N_PHASES = 9;
__global__ void __launch_bounds__(NWAVES * 64, 2) fwd(Args args) {
    extern __shared__ __attribute__((aligned(16))) unsigned char lds_raw[];
    Frame F;
    F.lds = (LAS unsigned char*)lds_raw;
    F.tid = threadIdx.x; F.lane = F.tid & 63; F.wave = __builtin_amdgcn_readfirstlane(F.tid >> 6);
    F.G = gridDim.x; { const int bx = blockIdx.x; F.vcu = (F.G % 8 == 0) ? (bx % 8) * (F.G / 8) + bx / 8 : bx; }
    F.ws = args.ws; F.ctl = (gu32*)(args.ws + WS_CTL); F.out = args.out;
    F.x = args.in[0]; F.meta = args.in[1]; F.g_mix = args.in[2]; F.w_in = args.in[3]; F.g_attn = args.in[4]; F.conv_w = args.in[5]; F.conv_b = args.in[6]; F.g_conv = args.in[7];
    F.w_out = args.in[8]; F.g_ffn = args.in[9]; F.w_router = args.in[10]; F.b_router = args.in[11]; F.w_gu = args.in[12]; F.b_gu = args.in[13]; F.w_down = args.in[14]; F.b_down = args.in[15]; F.g_final = args.in[16];
    volatile LAS unsigned* MISC = (volatile LAS unsigned*)(F.lds + MISC_OFF);
    for (int u = F.tid; u < (LDS_BYTES - LDSCTL_OFF) / 4; u += NWAVES * 64) ((LAS unsigned*)(F.lds + LDSCTL_OFF))[u] = 0u;
    __syncthreads();
    const int lo = args.ph_lo, hi = args.ph_hi;
    const bool multi = (hi - lo) > 1;
    XcdBarrier bar; bar.bar = (unsigned*)(F.ctl + CW_BAR); bar.x = 0; bar.st = nullptr;
    if (multi) bar = xcd_barrier_post((unsigned*)(F.ctl + CW_BAR), MISC + 8);
#ifndef PH_MASK
#define PH_MASK 0x1ff
#endif
#define IN(k) (((PH_MASK >> (k)) & 1) && lo <= (k) && (k) < hi)
#define SEAM(k) do { if (IN(k) && IN((k) + 1)) xcd_barrier(bar); } while (0)

    if (IN(0)) { p0_prologue(F); }
    SEAM(0);
    if (IN(1)) {
        { pg8::SchedPlain S; S.init(wsp<bf16_t>(F, WS_A), wsp<bf16_t>(F, WS_WIN), NTOK, 2560, F.G, (int)blockIdx.x);
          EpiProj E{wsp<bf16_t>(F, WS_Q), wsp<bf16_t>(F, WS_KB), wsp<bf16_t>(F, WS_CB), wsp<bf16_t>(F, WS_CC), wsp<bf16_t>(F, WS_CX), wsp<float>(F, WS_RSTD1)};
          pg8::gemm_phase<EpiProj, pg8::SchedPlain, false>(F.lds, S, E); }
        { pg8::SchedPlain S; S.init(wsp<bf16_t>(F, WS_WIN) + (size_t)2560 * DM, wsp<bf16_t>(F, WS_A), 512, NTOK, F.G, (int)blockIdx.x);
          EpiVt E{wsp<bf16_t>(F, WS_VT), wsp<float>(F, WS_RSTD1)};
          pg8::gemm_phase<EpiVt, pg8::SchedPlain, false>(F.lds, S, E); }
    }
    SEAM(1);
    if (IN(2)) {
        for (int u = F.vcu; u < NB * (SEQ / 32); u += F.G) p2_unit(F, u >> 7, u & 127);
    }
    SEAM(2);
    if (IN(3)) {
        pg8::SchedPlain S; S.init(wsp<bf16_t>(F, WS_MIXED), wsp<bf16_t>(F, WS_WOUT), NTOK, DM, F.G, (int)blockIdx.x);
        EpiOut E{F.x, F.out, wsp<bf16_t>(F, WS_A), wsp<float>(F, WS_SSP), F.g_ffn};
        pg8::gemm_phase<EpiOut, pg8::SchedPlain, false>(F.lds, S, E);
    }
    SEAM(3);
    if (IN(4)) { p4_router(F); }
    SEAM(4);
    if (IN(5)) { p5_scatter(F); }
    SEAM(5);
    if (IN(6)) {
        pg8::SchedGrouped S; S.A = (const char*)wsp<bf16_t>(F, WS_A); S.Bt = (const char*)wsp<bf16_t>(F, WS_WGU); S.estep = (size_t)2048 * 1024 * 2; S.nN = 8; S.G = F.G; S.c = F.vcu;
        S.tile_e = wsp<int>(F, WS_TILEE); S.slot_tok = wsp<int>(F, WS_SLOTTOK); S.ntiles = __builtin_amdgcn_readfirstlane(ld_i(S.tile_e + CAP_TILES));
        EpiGU E{wsp<bf16_t>(F, WS_HID), F.b_gu, wsp<float>(F, WS_SLOTRSTD)};
        pg8::gemm_phase<EpiGU, pg8::SchedGrouped, true>(F.lds, S, E);
    }
    SEAM(6);
    if (IN(7)) {
        pg8::SchedGrouped S; S.A = (const char*)wsp<bf16_t>(F, WS_HID); S.Bt = (const char*)wsp<bf16_t>(F, WS_WD); S.estep = (size_t)1024 * 1024 * 2; S.nN = 4; S.G = F.G; S.c = F.vcu;
        S.tile_e = wsp<int>(F, WS_TILEE); S.slot_tok = wsp<int>(F, WS_SLOTTOK); S.ntiles = __builtin_amdgcn_readfirstlane(ld_i(S.tile_e + CAP_TILES));
        EpiDown E{wsp<bf16_t>(F, WS_YS), F.b_down, wsp<float>(F, WS_SLOTGATE)};
        pg8::gemm_phase<EpiDown, pg8::SchedGrouped, false>(F.lds, S, E);
    }
    SEAM(7);
    if (IN(8)) { p8_combine(F); }
#undef IN
#undef SEAM
}

#ifndef MK_N_LAUNCHES
#define MK_N_LAUNCHES 9
#endif
extern "C" void kernel_launch(void* const* d_in, const int* in_sizes, int n_in, void* d_out, int out_size, void* d_ws, size_t ws_size, hipStream_t stream) {
    static int grid = 0;
    if (grid == 0) {
        if (n_in != 17 || out_size != NTOK * DM || ws_size < WS_END) { fprintf(stderr, "kernel_launch: unexpected problem (n_in %d out %d ws %zu)\n", n_in, out_size, ws_size); grid = -1; return; }
        int dev = 0, cus = 0, per_cu = 0;
        if (hipGetDevice(&dev) != hipSuccess || hipDeviceGetAttribute(&cus, hipDeviceAttributeMultiprocessorCount, dev) != hipSuccess) { grid = -1; return; }
        if (hipFuncSetAttribute((const void*)fwd, hipFuncAttributeMaxDynamicSharedMemorySize, LDS_BYTES) != hipSuccess) { fprintf(stderr, "kernel_launch: hipFuncSetAttribute failed\n"); grid = -1; return; }
        if (hipOccupancyMaxActiveBlocksPerMultiprocessor(&per_cu, (const void*)fwd, NWAVES * 64, LDS_BYTES) != hipSuccess || per_cu < 1) { fprintf(stderr, "kernel_launch: occupancy query says %d\n", per_cu); }
        (void)hipGetLastError();
        grid = cus;
        if (grid != 256) fprintf(stderr, "kernel_launch: %d CUs (built for 256)\n", grid);
    }
    if (grid < 0) return;
    (void)hipMemsetAsync((char*)d_ws + WS_CTL, 0, CTL_ZERO_BYTES, stream);
    Args a{};
    for (int i = 0; i < 17; ++i) a.in[i] = (const float*)d_in[i];
    a.out = (float*)d_out; a.ws = (unsigned char*)d_ws;
    if (MK_N_LAUNCHES == 1) { a.ph_lo = 0; a.ph_hi = N_PHASES; hipLaunchKernelGGL(fwd, dim3(grid), dim3(NWAVES * 64), LDS_BYTES, stream, a); }
    else for (int p = 0; p < N_PHASES; ++p) { a.ph_lo = p; a.ph_hi = p + 1; hipLaunchKernelGGL(fwd, dim3(grid), dim3(NWAVES * 64), LDS_BYTES, stream, a); }
    const hipError_t le = hipPeekAtLastError();
    if (le != hipSuccess) fprintf(stderr, "kernel_launch: launch failed: %s\n", hipGetErrorName(le));
}
```

```cpp
#include <hip/hip_runtime.h>
#include <cstdio>
#include <cstdint>

#define GAS __attribute__((address_space(1)))
#define LAS __attribute__((address_space(3)))
typedef unsigned short bf16_t;
typedef short bf16x8 __attribute__((ext_vector_type(8)));
typedef float f32x2 __attribute__((ext_vector_type(2)));
typedef float f32x4 __attribute__((ext_vector_type(4)));
typedef float f32x16 __attribute__((ext_vector_type(16)));
typedef unsigned u32x2 __attribute__((ext_vector_type(2)));
typedef unsigned u32x4 __attribute__((ext_vector_type(4)));
typedef int i32x4 __attribute__((ext_vector_type(4)));
typedef __bf16 bf16x2_t __attribute__((ext_vector_type(2)));
typedef GAS unsigned gu32;
#define RLX_AGENT __ATOMIC_RELAXED, __HIP_MEMORY_SCOPE_AGENT

constexpr int DM = 1024, NB = 8, SEQ = 4096, NTOK = NB * SEQ;
constexpr int NMETA = 16, KPAD = 48, TPAD = KPAD + NMETA + SEQ;
constexpr int QOFF = KPAD + NMETA;
constexpr int AW = 512, NH = 8, HD = 64;
constexpr int NE = 32, TOPK = 4, FF = 1024;
constexpr int CAP_TILES = 544, CAP = CAP_TILES * 256;
constexpr float RMS_EPS = 1e-6f;
constexpr float LOG2E = 1.4426950408889634f;
constexpr float QSCALE = 0.125f * LOG2E;
constexpr float EXIT_THR = -152.0f;
constexpr int NWAVES = 8;

constexpr size_t MiB = 1u << 20, KiB = 1u << 10;
constexpr size_t WS_CTL = 0, CTL_ZERO_BYTES = 64 * KiB;
constexpr size_t WS_RSTD1 = 1 * MiB, WS_RSTD2 = WS_RSTD1 + 128 * KiB, WS_CNT = WS_RSTD2 + 128 * KiB, WS_TILEE = WS_CNT + 64 * KiB, WS_META = WS_TILEE + 64 * KiB;
constexpr size_t WS_TOPE = 2 * MiB, WS_GATE = WS_TOPE + 512 * KiB, WS_TOKSLOT = 3 * MiB;
constexpr size_t WS_SLOTTOK = 4 * MiB, WS_SLOTGATE = 5 * MiB, WS_SLOTRSTD = 6 * MiB;
constexpr size_t WS_SSP = 8 * MiB;
constexpr size_t WS_WIN = 10 * MiB, WS_WGU = 16 * MiB, WS_WD = 144 * MiB, WS_A = 208 * MiB;
constexpr size_t WS_HID = 272 * MiB;
constexpr size_t WS_Q = 272 * MiB, WS_KB = 304 * MiB, WS_VT = 337 * MiB, WS_CB = 370 * MiB, WS_CC = 402 * MiB, WS_CX = 434 * MiB, WS_MIXED = 466 * MiB;
constexpr size_t WS_YS = 544 * MiB, WS_WOUT = 816 * MiB, WS_END = 818 * MiB;
static_assert(WS_MIXED + 64 * MiB <= WS_HID + (size_t)CAP * 2048 && WS_HID + (size_t)CAP * 2048 <= WS_YS && WS_YS + (size_t)CAP * 2048 <= WS_WOUT, "ws map");
static_assert((size_t)NB * TPAD * 512 * 2 <= 33 * MiB, "K/Vt size");
constexpr int CW_TMO = 0, CW_BAR = 1024;

constexpr int RING_BYTES = 131072, LDSCTL_OFF = RING_BYTES, MISC_OFF = LDSCTL_OFF + 320, LDS_BYTES = 147456;

__device__ __forceinline__ unsigned cvtpk(float lo, float hi) { f32x2 v = {lo, hi}; bf16x2_t b = __builtin_convertvector(v, bf16x2_t); return __builtin_bit_cast(unsigned, b); }
__device__ __forceinline__ float bflo(unsigned u) { return __builtin_bit_cast(float, u << 16); }
__device__ __forceinline__ float bfhi(unsigned u) { return __builtin_bit_cast(float, u & 0xffff0000u); }
__device__ __forceinline__ float ex2(float x) { return __builtin_amdgcn_exp2f(x); }
__device__ __forceinline__ float lg2(float x) { return __builtin_amdgcn_logf(x); }
__device__ __forceinline__ int ld_i(const int* p) { return __hip_atomic_load(p, RLX_AGENT); }
__device__ __forceinline__ float ld_f(const float* p) { return __builtin_bit_cast(float, __hip_atomic_load((const int*)p, RLX_AGENT)); }
__device__ __forceinline__ float wave_sum(float v) {
#pragma unroll
    for (int o = 1; o < 64; o <<= 1) v += __shfl_xor(v, o);
    return v;
}
#define LDS_WAIT() asm volatile("s_waitcnt lgkmcnt(0)" ::: "memory")
#define VM_WAIT() asm volatile("s_waitcnt vmcnt(0)" ::: "memory")

namespace pg8 {
constexpr int BM = 256, BK = 64, HALF = 128, HTB = HALF * BK * 2, STAGE_BYTES = 8 * HTB, NXCD = 8, WGM = 8, GK = 1024;
__host__ __device__ __forceinline__ int lds_byte(int r, int c) { const int st = (r >> 4) * 2 + (c >> 5), rr = r & 15, cc = c & 31, ob = rr * 64 + cc * 2; return st * 1024 + (ob ^ (((ob >> 9) & 1) << 5)); }
__host__ __device__ __forceinline__ void stage_rc(int b, int& R, int& C) { const int st = b / 1024, sb = b % 1024, swz = sb ^ (((sb >> 9) & 1) << 5); R = (st >> 1) * 16 + swz / 64; C = (st & 1) * 32 + (swz % 64) / 2; }
__host__ __device__ __forceinline__ int perm32(int rho) { const int n = rho >> 4, i = rho & 15; return 8 * (i >> 2) + 4 * n + (i & 3); }
struct Unit { int pm, pn, e; };

struct SchedPlain {
    const char* A; const char* Bt; int nM, nN, nwg, G, c;
    __device__ void init(const void* A_, const void* Bt_, int M, int N, int G_, int c_) { A = (const char*)A_; Bt = (const char*)Bt_; nM = M / BM; nN = N / BM; nwg = nM * nN; G = G_; c = c_; }
    __device__ __forceinline__ bool next(int i, Unit& u) const {
        const long L = (long)i * G + c; if (L >= nwg) return false;
        int wgid = (int)L; { const int q = nwg / NXCD, r = nwg % NXCD, xcd = wgid % NXCD, off = wgid / NXCD; wgid = (xcd < r ? xcd * (q + 1) : r * (q + 1) + (xcd - r) * q) + off; }
        const int nig = WGM * nN, gid = wgid / nig, fm = gid * WGM, gsz = (nM - fm) < WGM ? (nM - fm) : WGM;
        u.pm = fm + ((wgid % nig) % gsz); u.pn = (wgid % nig) / gsz; u.e = 0; return true;
    }
    __device__ __forceinline__ const char* a_tile(const Unit& u) const { return A + (size_t)u.pm * (size_t)(BM * GK * 2); }
    __device__ __forceinline__ const char* b_tile(const Unit& u) const { return Bt + (size_t)u.pn * (size_t)(BM * GK * 2); }
    __device__ __forceinline__ unsigned tok_off(int) const { return 0u; }
};
struct SchedGrouped {
    const char* A; const char* Bt; size_t estep; int nN, G, c, ntiles; const int* tile_e; const int* slot_tok;
    __device__ __forceinline__ bool next(int i, Unit& u) const {
        const int L = i * G + c; if (L >= ntiles * nN) return false;
        u.pm = L / nN; u.pn = L % nN; u.e = __builtin_amdgcn_readfirstlane(ld_i(tile_e + u.pm)); return true;
    }
    __device__ __forceinline__ const char* a_tile(const Unit& u) const { return A + (size_t)u.pm * (size_t)(BM * GK * 2); }
    __device__ __forceinline__ const char* b_tile(const Unit& u) const { return Bt + (size_t)u.e * estep + (size_t)u.pn * (size_t)(BM * GK * 2); }
    __device__ __forceinline__ unsigned tok_off(int row) const { return (unsigned)ld_i(slot_tok + row) * (unsigned)(GK * 2); }
};

template <class Epi, class Sched, bool GATHER>
__device__ __forceinline__ void gemm_phase(LAS unsigned char* lds, const Sched& S, const Epi& E) {
    constexpr int K = GK, nt = K / BK;
    const int tid = threadIdx.x, wid = __builtin_amdgcn_readfirstlane(tid >> 6), lane = tid & 63, wr = wid >> 2, wc = wid & 3, fr = lane & 15, fq = lane >> 4;
    unsigned voffA[2], voffB[2], stC2[2]; int stR[2];
#pragma unroll
    for (int i = 0; i < 2; ++i) { int R, C; stage_rc(tid * 16 + i * 8192, R, C); const int Rb = (R & ~31) + perm32(R & 31);
        voffA[i] = (unsigned)(R * K + C) * 2u; voffB[i] = (unsigned)(Rb * K + C) * 2u; stR[i] = R; stC2[i] = (unsigned)C * 2u; }
    constexpr size_t kstep = (size_t)(BK * 2), hstep = (size_t)HALF * K * 2;
    const unsigned ldsw = (unsigned)wid * 1024u;
    const int aoff = lds_byte(wr * 64 + fr, fq * 8), boff = lds_byte(wc * 32 + fr, fq * 8);
#define PG8_SA(b, h) (((b) * 2 + (h)) * HTB)
#define PG8_SB(b, h) ((4 + (b) * 2 + (h)) * HTB)
#define PG8_STAGE2(bufoff, gbase, o0, o1) do { \
        __builtin_amdgcn_global_load_lds((const unsigned*)((const char*)(gbase) + (o0)), (LAS unsigned*)(lds + (bufoff) + ldsw), 16, 0, 0); \
        __builtin_amdgcn_global_load_lds((const unsigned*)((const char*)(gbase) + (o1)), (LAS unsigned*)(lds + (bufoff) + ldsw + 8192), 16, 0, 0); } while (0)
#define PG8_STAGE_B(bufoff, gbase) PG8_STAGE2(bufoff, gbase, voffB[0], voffB[1])
#define PG8_STAGE_A(bufoff, usenext, h, koff) do { if constexpr (GATHER) { const char* _p = S.A + (koff); \
            const unsigned _o0 = (usenext) ? ng[h][0] : cg[h][0], _o1 = (usenext) ? ng[h][1] : cg[h][1]; PG8_STAGE2(bufoff, _p, _o0, _o1); } \
        else { const char* _p = ((usenext) ? nA : cA) + (size_t)(h) * hstep + (koff); PG8_STAGE2(bufoff, _p, voffA[0], voffA[1]); } } while (0)
#define PG8_LDA(dst, b, h) do { _Pragma("unroll") for (int m = 0; m < 4; ++m) _Pragma("unroll") for (int k = 0; k < 2; ++k) dst[m][k] = *(const LAS bf16x8*)(lds + PG8_SA(b, h) + aoff + m * 2048 + k * 1024); } while (0)
#define PG8_LDB(dst, b, h) do { _Pragma("unroll") for (int n = 0; n < 2; ++n) _Pragma("unroll") for (int k = 0; k < 2; ++k) dst[n][k] = *(const LAS bf16x8*)(lds + PG8_SB(b, h) + boff + n * 2048 + k * 1024); } while (0)
#define PG8_MMA(ai, bj, At, Bt) do { __builtin_amdgcn_s_setprio(1); _Pragma("unroll") for (int m = 0; m < 4; ++m) _Pragma("unroll") for (int n = 0; n < 2; ++n) _Pragma("unroll") for (int k = 0; k < 2; ++k) \
        acc[ai][bj][m][n] = __builtin_amdgcn_mfma_f32_16x16x32_bf16(Bt[n][k], At[m][k], acc[ai][bj][m][n], 0, 0, 0); __builtin_amdgcn_s_setprio(0); } while (0)
#define PG8_WAIT_V(n) asm volatile("s_waitcnt vmcnt(" #n ")" ::: "memory")
#define PG8_WAIT_L(n) asm volatile("s_waitcnt lgkmcnt(" #n ")" ::: "memory")
#define PG8_BAR __builtin_amdgcn_s_barrier()
#define PG8_SCHED __builtin_amdgcn_sched_barrier(0)
    Unit cur, nxt; int ui = 0;
    if (!S.next(0, cur)) return;
    f32x4 acc[2][2][4][2];
#pragma unroll
    for (int a = 0; a < 2; ++a)
#pragma unroll
        for (int b = 0; b < 2; ++b)
#pragma unroll
            for (int m = 0; m < 4; ++m)
#pragma unroll
                for (int n = 0; n < 2; ++n) acc[a][b][m][n] = (f32x4){0.f, 0.f, 0.f, 0.f};
    bf16x8 At[4][2], B0[2][2], B1[2][2];
    const char* cA = S.a_tile(cur); const char* cB = S.b_tile(cur);
    const char* nA = cA;
    unsigned cg[2][2], ng[2][2];
    if constexpr (GATHER) {
#pragma unroll
        for (int h = 0; h < 2; ++h)
#pragma unroll
            for (int i = 0; i < 2; ++i) { cg[h][i] = S.tok_off(cur.pm * BM + h * HALF + stR[i]) + stC2[i]; ng[h][i] = cg[h][i]; }
    } else {
#pragma unroll
        for (int h = 0; h < 2; ++h)
#pragma unroll
            for (int i = 0; i < 2; ++i) { cg[h][i] = 0u; ng[h][i] = 0u; }
    }
    PG8_STAGE_B(PG8_SB(0, 0), cB); PG8_STAGE_B(PG8_SB(0, 1), cB + hstep); PG8_STAGE_A(PG8_SA(0, 0), false, 0, 0); PG8_STAGE_A(PG8_SA(0, 1), false, 1, 0);
    if (wr == 1) PG8_BAR;
    PG8_WAIT_V(2); PG8_BAR;
    PG8_STAGE_B(PG8_SB(1, 0), cB + kstep); PG8_STAGE_A(PG8_SA(1, 0), false, 0, kstep); PG8_STAGE_B(PG8_SB(1, 1), cB + hstep + kstep);
    PG8_WAIT_V(6); PG8_BAR;
    for (;;) {
        const bool has_next = S.next(ui + 1, nxt);
        nA = has_next ? S.a_tile(nxt) : cA; const char* nB = has_next ? S.b_tile(nxt) : cB;
        for (int t = 0; t < nt; t += 2) {
            const bool last = (t == nt - 2);
            const size_t koff1 = (size_t)(t + 1) * kstep, koff2 = last ? (size_t)0 : (size_t)(t + 2) * kstep, koff3 = koff2 + kstep;
            const char* b2 = last ? nB : cB + (size_t)(t + 2) * kstep; const char* b3 = b2 + kstep;
            if constexpr (GATHER) { if (last && has_next) {
#pragma unroll
                for (int h = 0; h < 2; ++h)
#pragma unroll
                    for (int i = 0; i < 2; ++i) ng[h][i] = S.tok_off(nxt.pm * BM + h * HALF + stR[i]) + stC2[i]; } }
            PG8_LDB(B0, 0, 0); PG8_LDB(B1, 0, 1); PG8_SCHED; PG8_LDA(At, 0, 0); PG8_STAGE_A(PG8_SA(1, 1), false, 1, koff1);
            PG8_WAIT_V(8); PG8_WAIT_L(0); PG8_BAR; PG8_MMA(0, 0, At, B0); PG8_MMA(0, 1, At, B1); PG8_BAR; PG8_SCHED;
            PG8_LDA(At, 0, 1); PG8_STAGE_B(PG8_SB(0, 0), b2); PG8_STAGE_B(PG8_SB(0, 1), b2 + hstep); PG8_STAGE_A(PG8_SA(0, 0), last, 0, koff2);
            PG8_WAIT_V(8); PG8_WAIT_L(0); PG8_BAR; PG8_MMA(1, 0, At, B0); PG8_MMA(1, 1, At, B1); PG8_BAR; PG8_SCHED;
            PG8_LDB(B0, 1, 0); PG8_LDB(B1, 1, 1); PG8_SCHED; PG8_LDA(At, 1, 0); PG8_STAGE_A(PG8_SA(0, 1), last, 1, koff2);
            PG8_WAIT_V(8); PG8_WAIT_L(0); PG8_BAR; PG8_MMA(0, 0, At, B0); PG8_MMA(0, 1, At, B1); PG8_BAR; PG8_SCHED;
            PG8_LDA(At, 1, 1); PG8_STAGE_B(PG8_SB(1, 0), b3); PG8_STAGE_B(PG8_SB(1, 1), b3 + hstep); PG8_STAGE_A(PG8_SA(1, 0), last, 0, koff3);
            PG8_WAIT_V(8); PG8_WAIT_L(0); PG8_BAR; PG8_MMA(1, 0, At, B0); PG8_MMA(1, 1, At, B1); PG8_BAR; PG8_SCHED;
        }
        if (wr == 0) PG8_BAR;
        E(acc, cur, wr, wc, fr, fq);
        if (!has_next) break;
#pragma unroll
        for (int a = 0; a < 2; ++a)
#pragma unroll
            for (int b = 0; b < 2; ++b)
#pragma unroll
                for (int m = 0; m < 4; ++m)
#pragma unroll
                    for (int n = 0; n < 2; ++n) acc[a][b][m][n] = (f32x4){0.f, 0.f, 0.f, 0.f};
        cur = nxt; cA = nA; cB = nB; ++ui;
#pragma unroll
        for (int h = 0; h < 2; ++h)
#pragma unroll
            for (int i = 0; i < 2; ++i) cg[h][i] = ng[h][i];
        if (wr == 1) PG8_BAR;
    }
    PG8_WAIT_V(0);
    PG8_BAR;
#undef PG8_SA
#undef PG8_SB
#undef PG8_STAGE2
#undef PG8_STAGE_B
#undef PG8_STAGE_A
#undef PG8_LDA
#undef PG8_LDB
#undef PG8_MMA
#undef PG8_WAIT_V
#undef PG8_WAIT_L
#undef PG8_BAR
#undef PG8_SCHED
}
}

#define XB_TMO      128
#define XB_XCNT(j)  (256  + 64 * (j))
#define XB_XSUB(j)  (1280 + 64 * (j))
#define XB_XGEN(j)  (2304 + 64 * (j))
#define XB_TOP      3328
#define XB_TOPGEN   3392
#define XCD_BAR_WORDS 3456
#define XB_SPIN_CAP (1u << 18)

__device__ __forceinline__ unsigned xb_ld(unsigned* p)              { return __hip_atomic_load(p, __ATOMIC_RELAXED, __HIP_MEMORY_SCOPE_AGENT); }
__device__ __forceinline__ unsigned xb_add(unsigned* p, unsigned v) { return __hip_atomic_fetch_add(p, v, __ATOMIC_RELAXED, __HIP_MEMORY_SCOPE_AGENT); }
__device__ __forceinline__ unsigned xb_xcc_id() { return (unsigned)__builtin_amdgcn_s_getreg((3 << 11) | 20) & 0xFu; }
#define XB_SPIN(cond, bar) do { unsigned _sp = 0; while (cond) { __builtin_amdgcn_s_sleep(1); \
    if ((++_sp & 255u) == 0u) { if (xb_ld(&(bar)[XB_TMO])) break; if (_sp > XB_SPIN_CAP) { atomicAdd(&(bar)[XB_TMO], 1u); break; } } } } while (0)

struct XcdBarrier {
    unsigned* bar; unsigned x;
    volatile LAS unsigned* st;
};

__device__ __forceinline__ XcdBarrier xcd_barrier_post(unsigned* bar, volatile LAS unsigned* st) {
    XcdBarrier b; b.bar = bar; b.x = xb_xcc_id(); b.st = st;
    if (threadIdx.x == 0) (void)xb_add(&bar[XB_XCNT(b.x)], 1u);
    return b;
}
__device__ __forceinline__ void xcd_barrier_complete(unsigned* bar, unsigned x, unsigned& nloc, unsigned& nx) {
    const unsigned G = gridDim.x * gridDim.y * gridDim.z;
    unsigned sum, cnt, mine, sp = 0u;
    for (;;) {
        sum = 0u; cnt = 0u; mine = 0u;
#pragma unroll
        for (unsigned j = 0; j < 16; ++j) { const unsigned c = xb_ld(&bar[XB_XCNT(j)]); sum += c; cnt += (c > 0u) ? 1u : 0u; mine = (j == x) ? c : mine; }
        if (sum == G) break;
        __builtin_amdgcn_s_sleep(1);
        if ((++sp & 255u) == 0u) { if (xb_ld(&bar[XB_TMO])) break; if (sp > XB_SPIN_CAP) { atomicAdd(&bar[XB_TMO], 1u); break; } }
    }
    nloc = mine > 0u ? mine : 1u; nx = cnt > 0u ? cnt : 1u;
}

__device__ __forceinline__ void xcd_barrier(const XcdBarrier& b) {
    asm volatile("s_waitcnt vmcnt(0)" ::: "memory");
    __syncthreads();
    if (threadIdx.x == 0) {
        unsigned* bar = b.bar;
        __builtin_amdgcn_s_waitcnt(0);
        unsigned nloc = b.st[0], nx = b.st[1];
        if (nloc == 0u) { xcd_barrier_complete(bar, b.x, nloc, nx); b.st[0] = nloc; b.st[1] = nx; }
        const unsigned old = xb_add(&bar[XB_XSUB(b.x)], 1u);
        const unsigned gen = old / nloc;
        if (old + 1u == (gen + 1u) * nloc) {
            __builtin_amdgcn_fence(__ATOMIC_RELEASE, "agent");
            asm volatile("s_waitcnt vmcnt(0)" ::: "memory");
            const unsigned og = xb_add(&bar[XB_TOP], 1u);
            const unsigned tg = og / nx;
            if (og + 1u == (tg + 1u) * nx) xb_add(&bar[XB_TOPGEN], 1u);
            else XB_SPIN(xb_ld(&bar[XB_TOPGEN]) == tg, bar);
            __builtin_amdgcn_fence(__ATOMIC_ACQUIRE, "agent");
            xb_add(&bar[XB_XGEN(b.x)], 1u);
            asm volatile("s_waitcnt vmcnt(0)" ::: "memory");
        } else {
            XB_SPIN(xb_ld(&bar[XB_XGEN(b.x)]) == gen, bar);
            __builtin_amdgcn_fence(__ATOMIC_ACQUIRE, "agent");
            asm volatile("s_waitcnt vmcnt(0)" ::: "memory");
        }
    }
    __syncthreads();
}

typedef f32x4 AccT[2][2][4][2];
struct EpiProj {
    bf16_t *Q, *KB, *CB, *CC, *CX; const float* rstd1;
    __device__ __forceinline__ void operator()(const AccT& acc, const pg8::Unit& u, int wr, int wc, int fr, int fq) const {
        const int sec = u.pn >> 1, row0 = u.pm * 256 + wr * 64 + fr, col0 = (u.pn & 1) * 256 + wc * 32 + 8 * fq;
        bf16_t* base = sec == 0 ? Q : sec == 1 ? KB : sec == 2 ? CB : sec == 3 ? CC : CX;
        const int radd = (sec == 1) ? 64 * ((u.pm >> 4) + 1) : 0;
        const float sc0 = (sec == 0) ? QSCALE : 1.0f;
#pragma unroll
        for (int ai = 0; ai < 2; ++ai)
#pragma unroll
            for (int m = 0; m < 4; ++m) { const int r = row0 + ai * 128 + m * 16; const float sc = ld_f(rstd1 + r) * sc0;
                bf16_t* rowp = base + (size_t)(r + radd) * 512 + col0;
#pragma unroll
                for (int bj = 0; bj < 2; ++bj) { const f32x4 v0 = acc[ai][bj][m][0] * sc, v1 = acc[ai][bj][m][1] * sc;
                    u32x4 w; w.x = cvtpk(v0[0], v0[1]); w.y = cvtpk(v0[2], v0[3]); w.z = cvtpk(v1[0], v1[1]); w.w = cvtpk(v1[2], v1[3]);
                    *(u32x4*)(rowp + bj * 128) = w; } }
    }
};
struct EpiVt {
    bf16_t* VT; const float* rstd1;
    __device__ __forceinline__ void operator()(const AccT& acc, const pg8::Unit& u, int wr, int wc, int fr, int fq) const {
        const int row0 = u.pm * 256 + wr * 64 + fr, col0 = u.pn * 256 + wc * 32 + 8 * fq;
        f32x4 rs[2][2];
#pragma unroll
        for (int bj = 0; bj < 2; ++bj)
#pragma unroll
            for (int n = 0; n < 2; ++n)
#pragma unroll
                for (int i = 0; i < 4; ++i) rs[bj][n][i] = ld_f(rstd1 + col0 + bj * 128 + 4 * n + i);
        const int dcol0 = col0 + 64 * ((u.pn >> 4) + 1);
#pragma unroll
        for (int ai = 0; ai < 2; ++ai)
#pragma unroll
            for (int m = 0; m < 4; ++m) { bf16_t* rowp = VT + (size_t)(row0 + ai * 128 + m * 16) * (size_t)(NB * TPAD) + dcol0;
#pragma unroll
                for (int bj = 0; bj < 2; ++bj) { const f32x4 v0 = acc[ai][bj][m][0] * rs[bj][0], v1 = acc[ai][bj][m][1] * rs[bj][1];
                    u32x4 w; w.x = cvtpk(v0[0], v0[1]); w.y = cvtpk(v0[2], v0[3]); w.z = cvtpk(v1[0], v1[1]); w.w = cvtpk(v1[2], v1[3]);
                    *(u32x4*)(rowp + bj * 128) = w; } }
    }
};
struct EpiOut {
    const float* x; float* h1; bf16_t* A2; float* ssp; const float* gffn;
    __device__ __forceinline__ void operator()(const AccT& acc, const pg8::Unit& u, int wr, int wc, int fr, int fq) const {
        const int row0 = u.pm * 256 + wr * 64 + fr, col0 = u.pn * 256 + wc * 32 + 8 * fq;
        f32x4 g[2][2];
#pragma unroll
        for (int bj = 0; bj < 2; ++bj)
#pragma unroll
            for (int n = 0; n < 2; ++n) g[bj][n] = *(const f32x4*)(gffn + col0 + bj * 128 + 4 * n);
#pragma unroll
        for (int ai = 0; ai < 2; ++ai)
#pragma unroll
            for (int m = 0; m < 4; ++m) { const int r = row0 + ai * 128 + m * 16; const size_t ro = (size_t)r * DM + col0; float ss = 0.f;
#pragma unroll
                for (int bj = 0; bj < 2; ++bj) {
                    const f32x4 v0 = acc[ai][bj][m][0] + *(const f32x4*)(x + ro + bj * 128), v1 = acc[ai][bj][m][1] + *(const f32x4*)(x + ro + bj * 128 + 4);
                    *(f32x4*)(h1 + ro + bj * 128) = v0; *(f32x4*)(h1 + ro + bj * 128 + 4) = v1;
                    ss += (v0[0] * v0[0] + v0[1] * v0[1]) + (v0[2] * v0[2] + v0[3] * v0[3]) + (v1[0] * v1[0] + v1[1] * v1[1]) + (v1[2] * v1[2] + v1[3] * v1[3]);
                    const f32x4 a0 = v0 * g[bj][0], a1 = v1 * g[bj][1];
                    u32x4 w; w.x = cvtpk(a0[0], a0[1]); w.y = cvtpk(a0[2], a0[3]); w.z = cvtpk(a1[0], a1[1]); w.w = cvtpk(a1[2], a1[3]);
                    *(u32x4*)(A2 + ro + bj * 128) = w; }
                ss += __shfl_xor(ss, 16); ss += __shfl_xor(ss, 32);
                if (fq == 0) ssp[(size_t)r * 16 + u.pn * 4 + wc] = ss; }
    }
};
struct EpiGU {
    bf16_t* hid; const float* bgu; const float* slot_rstd;
    __device__ __forceinline__ void operator()(const AccT& acc, const pg8::Unit& u, int wr, int wc, int fr, int fq) const {
        const int row0 = u.pm * 256 + wr * 64 + fr, colr = u.pn * 128 + wc * 32 + 8 * fq;
        const float* bg = bgu + (size_t)u.e * 2048 + colr;
        const f32x4 bg0 = *(const f32x4*)(bg), bg1 = *(const f32x4*)(bg + 4), bl0 = *(const f32x4*)(bg + 1024), bl1 = *(const f32x4*)(bg + 1028);
#pragma unroll
        for (int ai = 0; ai < 2; ++ai)
#pragma unroll
            for (int m = 0; m < 4; ++m) { const int r = row0 + ai * 128 + m * 16; const float rs = ld_f(slot_rstd + r);
                float hv[8];
#pragma unroll
                for (int n = 0; n < 2; ++n)
#pragma unroll
                    for (int i = 0; i < 4; ++i) {
                        float gt = acc[ai][0][m][n][i] * rs + (n ? bg1[i] : bg0[i]), ln = acc[ai][1][m][n][i] * rs + (n ? bl1[i] : bl0[i]);
                        gt = fminf(gt, 7.0f); ln = fminf(fmaxf(ln, -7.0f), 7.0f);
                        const float sg = __builtin_amdgcn_rcpf(1.0f + ex2(gt * (-1.702f * LOG2E)));
                        hv[n * 4 + i] = (ln + 1.0f) * (gt * sg); }
                u32x4 w; w.x = cvtpk(hv[0], hv[1]); w.y = cvtpk(hv[2], hv[3]); w.z = cvtpk(hv[4], hv[5]); w.w = cvtpk(hv[6], hv[7]);
                *(u32x4*)(hid + (size_t)r * FF + colr) = w; }
    }
};
struct EpiDown {
    bf16_t* ys; const float* bd; const float* slot_gate;
    __device__ __forceinline__ void operator()(const AccT& acc, const pg8::Unit& u, int wr, int wc, int fr, int fq) const {
        const int row0 = u.pm * 256 + wr * 64 + fr, col0 = u.pn * 256 + wc * 32 + 8 * fq;
        f32x4 bv[2][2];
#pragma unroll
        for (int bj = 0; bj < 2; ++bj)
#pragma unroll
            for (int n = 0; n < 2; ++n) bv[bj][n] = *(const f32x4*)(bd + (size_t)u.e * DM + col0 + bj * 128 + 4 * n);
#pragma unroll
        for (int ai = 0; ai < 2; ++ai)
#pragma unroll
            for (int m = 0; m < 4; ++m) { const int r = row0 + ai * 128 + m * 16; const float gt = ld_f(slot_gate + r);
                bf16_t* rowp = ys + (size_t)r * DM + col0;
#pragma unroll
                for (int bj = 0; bj < 2; ++bj) { const f32x4 v0 = (acc[ai][bj][m][0] + bv[bj][0]) * gt, v1 = (acc[ai][bj][m][1] + bv[bj][1]) * gt;
                    u32x4 w; w.x = cvtpk(v0[0], v0[1]); w.y = cvtpk(v0[2], v0[3]); w.z = cvtpk(v1[0], v1[1]); w.w = cvtpk(v1[2], v1[3]);
                    *(u32x4*)(rowp + bj * 128) = w; } }
    }
};

struct Args { const float* in[17]; float* out; unsigned char* ws; int ph_lo, ph_hi; };
struct Frame {
    LAS unsigned char* lds; gu32* ctl; int tid, lane, wave, vcu, G;
    const float *x, *meta, *g_mix, *w_in, *g_attn, *conv_w, *conv_b, *g_conv, *w_out, *g_ffn, *w_router, *b_router, *w_gu, *b_gu, *w_down, *b_down, *g_final;
    float* out; unsigned char* ws;
};
template <class T> __device__ __forceinline__ T* wsp(const Frame& F, size_t off) { return (T*)(F.ws + off); }

__device__ __forceinline__ void p0_transpose_item(const float* W, int ldw, int k0, int n0, bf16_t* WT, int Kd, int drow0, LAS float* scr, int lane) {
#pragma unroll 8
    for (int i = 0; i < 32; ++i) { const int kk = 2 * i + (lane >> 5); scr[kk * 33 + (lane & 31)] = W[(size_t)(k0 + kk) * ldw + n0 + (lane & 31)]; }
    LDS_WAIT(); asm volatile("" ::: "memory");
    const int c = lane & 7;
#pragma unroll
    for (int j = 0; j < 4; ++j) { const int n = (lane >> 3) + 8 * j; const LAS float* s = scr + (8 * c) * 33 + n;
        u32x4 o; o.x = cvtpk(s[0 * 33], s[1 * 33]); o.y = cvtpk(s[2 * 33], s[3 * 33]); o.z = cvtpk(s[4 * 33], s[5 * 33]); o.w = cvtpk(s[6 * 33], s[7 * 33]);
        *(u32x4*)(WT + (size_t)(drow0 + n) * Kd + k0 + 8 * c) = o; }
    LDS_WAIT(); asm volatile("" ::: "memory");
}
__device__ __forceinline__ void p0_meta_job(Frame& F, int mw) {
    LAS float* nm = (LAS float*)F.lds;
    LAS float* part = (LAS float*)(F.lds + 65536);
    for (int t = F.wave * 2; t < F.wave * 2 + 2; ++t) {
        float v[16]; float ss = 0.f;
#pragma unroll
        for (int j = 0; j < 16; ++j) { v[j] = F.meta[t * DM + j * 64 + F.lane]; ss += v[j] * v[j]; }
        const float rstd = 1.0f / sqrtf(wave_sum(ss) * (1.0f / DM) + RMS_EPS);
#pragma unroll
        for (int j = 0; j < 16; ++j) { const int k = j * 64 + F.lane; nm[k * 16 + t] = v[j] * rstd * F.g_mix[k]; }
    }
    __syncthreads();
    const int kq = F.tid >> 7, c = F.tid & 127, j = mw * 128 + c, sec4 = j >> 9, jc = j & 511;
    const int ocol = (sec4 == 0 ? 512 : sec4 == 1 ? 1024 : sec4 == 2 ? 2048 : 2560) + jc;
    float acc[16];
#pragma unroll
    for (int t = 0; t < 16; ++t) acc[t] = 0.f;
    for (int k = kq * 256; k < kq * 256 + 256; ++k) {
        const float w = F.w_in[(size_t)k * 3072 + ocol];
        const LAS f32x4* nv = (const LAS f32x4*)(nm + k * 16);
#pragma unroll
        for (int q = 0; q < 4; ++q) { const f32x4 n4 = nv[q]; acc[4 * q] += w * n4[0]; acc[4 * q + 1] += w * n4[1]; acc[4 * q + 2] += w * n4[2]; acc[4 * q + 3] += w * n4[3]; }
    }
#pragma unroll
    for (int t = 0; t < 16; ++t) part[(kq * 128 + c) * 16 + t] = acc[t];
    __syncthreads();
    {
        const int tq = F.tid >> 7;
        bf16_t* KB = wsp<bf16_t>(F, WS_KB); bf16_t* VT = wsp<bf16_t>(F, WS_VT); float* MT = wsp<float>(F, WS_META);
#pragma unroll
        for (int tt = 0; tt < 4; ++tt) { const int t = 4 * tq + tt;
            const float v = (part[(0 * 128 + c) * 16 + t] + part[(1 * 128 + c) * 16 + t]) + (part[(2 * 128 + c) * 16 + t] + part[(3 * 128 + c) * 16 + t]);
            const bf16_t bv = (bf16_t)(cvtpk(v, 0.f) & 0xffffu);
            if (sec4 == 0) { for (int b = 0; b < NB; ++b) KB[(size_t)(b * TPAD + KPAD + t) * 512 + jc] = bv; }
            else if (sec4 == 1) { for (int b = 0; b < NB; ++b) VT[(size_t)jc * (NB * TPAD) + b * TPAD + KPAD + t] = bv; }
            else if (t >= 14) MT[((sec4 - 2) * 2 + (t - 14)) * 512 + jc] = v;
        }
    }
    __syncthreads();
}
__device__ __forceinline__ void p0_prologue(Frame& F) {
    if (blockIdx.x < 16) p0_meta_job(F, (int)blockIdx.x);
    const int gw = F.vcu * NWAVES + F.wave, NGW = F.G * NWAVES;
    {
        bf16_t* KB = wsp<bf16_t>(F, WS_KB); bf16_t* VT = wsp<bf16_t>(F, WS_VT);
        const int gt = F.vcu * 512 + F.tid, NT = F.G * 512;
        for (int i = gt; i < NB * KPAD * 64; i += NT) { const int b = i / (KPAD * 64), r = i % (KPAD * 64); *(u32x4*)(KB + (size_t)(b * TPAD) * 512 + (size_t)r * 8) = (u32x4){0u, 0u, 0u, 0u}; }
        for (int i = gt; i < 512 * NB * 6; i += NT) { const int ch = i / (NB * 6), r = i % (NB * 6), b = r / 6, q = r % 6; *(u32x4*)(VT + (size_t)ch * (NB * TPAD) + b * TPAD + q * 8) = (u32x4){0u, 0u, 0u, 0u}; }
    }
    {
        float* rstd1 = wsp<float>(F, WS_RSTD1); bf16_t* A1 = wsp<bf16_t>(F, WS_A);
        f32x4 g4[4];
#pragma unroll
        for (int j = 0; j < 4; ++j) g4[j] = *(const f32x4*)(F.g_mix + 256 * j + 4 * F.lane);
        for (int m = gw; m < NTOK; m += NGW) {
            const f32x4* xr = (const f32x4*)(F.x + (size_t)m * DM) + F.lane;
            f32x4 v[4]; float s = 0.f;
#pragma unroll
            for (int j = 0; j < 4; ++j) { v[j] = xr[64 * j]; s += (v[j][0] * v[j][0] + v[j][1] * v[j][1]) + (v[j][2] * v[j][2] + v[j][3] * v[j][3]); }
            s = wave_sum(s);
            if (F.lane == 0) rstd1[m] = 1.0f / sqrtf(s * (1.0f / DM) + RMS_EPS);
            u32x2* o8 = (u32x2*)(A1 + (size_t)m * DM) + F.lane;
#pragma unroll
            for (int j = 0; j < 4; ++j) { const f32x4 a = v[j] * g4[j]; u32x2 o; o.x = cvtpk(a[0], a[1]); o.y = cvtpk(a[2], a[3]); o8[64 * j] = o; }
        }
    }
    {
        LAS float* scr = (LAS float*)(F.lds + F.wave * 16384);
        constexpr int I_IN = 16 * 96, I_OUT = 16 * 32, I_GU = 32 * 16 * 64, I_D = 32 * 16 * 32, NITEMS = I_IN + I_OUT + I_GU + I_D;
        bf16_t* WIN = wsp<bf16_t>(F, WS_WIN); bf16_t* WOUT = wsp<bf16_t>(F, WS_WOUT); bf16_t* WGU = wsp<bf16_t>(F, WS_WGU); bf16_t* WD = wsp<bf16_t>(F, WS_WD);
        for (int it = gw; it < NITEMS; it += NGW) {
            int r = it;
            if (r < I_IN) { const int kb = r / 96, nb = r % 96, n0 = 32 * nb, sec = n0 >> 9;
                const int dsec = sec == 0 ? 0 : sec == 1 ? 1 : sec == 2 ? 5 : sec - 1;
                p0_transpose_item(F.w_in, 3072, 64 * kb, n0, WIN, DM, dsec * 512 + (n0 & 511), scr, F.lane); continue; }
            r -= I_IN;
            if (r < I_OUT) { const int kb = r / 32, nb = r % 32; p0_transpose_item(F.w_out, 1024, 64 * kb, 32 * nb, WOUT, DM, 32 * nb, scr, F.lane); continue; }
            r -= I_OUT;
            if (r < I_GU) { const int e = r / 1024, q = r % 1024, kb = q / 64, nb = q % 64, n0 = 32 * nb, c = n0 & 1023;
                const int drow = (c >> 7) * 256 + (n0 >= 1024 ? 128 : 0) + (c & 127);
                p0_transpose_item(F.w_gu + (size_t)e * 1024 * 2048, 2048, 64 * kb, n0, WGU + (size_t)e * 2048 * 1024, DM, drow, scr, F.lane); continue; }
            r -= I_GU;
            { const int e = r / 512, q = r % 512, kb = q / 32, nb = q % 32;
                p0_transpose_item(F.w_down + (size_t)e * 1024 * 1024, 1024, 64 * kb, 32 * nb, WD + (size_t)e * 1024 * 1024, FF, 32 * nb, scr, F.lane); }
        }
    }
}

template <bool EDGE>
__device__ __forceinline__ void sb_tile(f32x16& s0, f32x16& s1, float& carry, int kp0  , int qpos, bool hi0, bf16x8 (&pf)[2][2]) {
    float R[4];
#pragma unroll
    for (int q = 0; q < 4; ++q) {
        float S = 0.f;
#pragma unroll
        for (int i = 7; i >= 0; --i) {
            const int r = (q & 1) * 8 + i;
            const float z = (q < 2) ? s0[r] : s1[r];
            const float L = lg2(1.0f + ex2(-fabsf(z)));
            float sp = fmaxf(z, 0.f) + L; float ls = z - sp;
            if (EDGE) { const int kp = kp0 + 16 * q + i; const bool valid = (kp < qpos) && (kp >= KPAD); sp = valid ? sp : 0.f; ls = valid ? ls : -INFINITY; }
            const float m = ls - S; S += sp;
            if (q < 2) s0[r] = m; else s1[r] = m;
        }
        R[q] = S;
        __builtin_amdgcn_sched_barrier(0);
    }
    const float P0 = __shfl_xor(R[0], 32), P1 = __shfl_xor(R[1], 32), P2 = __shfl_xor(R[2], 32), P3 = __shfl_xor(R[3], 32);
    const float T0 = R[0] + P0, T1 = R[1] + P1, T2 = R[2] + P2, T3 = R[3] + P3;
    const float b3 = carry - (hi0 ? P3 : 0.f), b2 = carry - (T3 + (hi0 ? P2 : 0.f)), b1 = carry - ((T3 + T2) + (hi0 ? P1 : 0.f)), b0 = carry - ((T3 + T2 + T1) + (hi0 ? P0 : 0.f));
#pragma unroll
    for (int i = 0; i < 8; ++i) { s0[i] = ex2(s0[i] + b0); s0[8 + i] = ex2(s0[8 + i] + b1); s1[i] = ex2(s1[i] + b2); s1[8 + i] = ex2(s1[8 + i] + b3); }
    carry -= (T0 + T1) + (T2 + T3);
    u32x4 w;
    w.x = cvtpk(s0[0], s0[1]); w.y = cvtpk(s0[2], s0[3]); w.z = cvtpk(s0[4], s0[5]); w.w = cvtpk(s0[6], s0[7]); pf[0][0] = __builtin_bit_cast(bf16x8, w);
    w.x = cvtpk(s0[8], s0[9]); w.y = cvtpk(s0[10], s0[11]); w.z = cvtpk(s0[12], s0[13]); w.w = cvtpk(s0[14], s0[15]); pf[0][1] = __builtin_bit_cast(bf16x8, w);
    w.x = cvtpk(s1[0], s1[1]); w.y = cvtpk(s1[2], s1[3]); w.z = cvtpk(s1[4], s1[5]); w.w = cvtpk(s1[6], s1[7]); pf[1][0] = __builtin_bit_cast(bf16x8, w);
    w.x = cvtpk(s1[8], s1[9]); w.y = cvtpk(s1[10], s1[11]); w.z = cvtpk(s1[12], s1[13]); w.w = cvtpk(s1[14], s1[15]); pf[1][1] = __builtin_bit_cast(bf16x8, w);
}
#define MFMA32(a, b, c) __builtin_amdgcn_mfma_f32_32x32x16_bf16((a), (b), (c), 0, 0, 0)
__device__ __forceinline__ void p2_unit(Frame& F, int b, int qb) {
    int lane_ = F.lane, head_ = F.wave;
    asm volatile("" : "+v"(lane_), "+s"(head_));
    const int lane = lane_, head = head_, l31 = lane & 31, hi = lane >> 5; const bool hi0 = hi == 0;
    const bf16_t* Q = wsp<bf16_t>(F, WS_Q); const bf16_t* KB = wsp<bf16_t>(F, WS_KB); const bf16_t* VT = wsp<bf16_t>(F, WS_VT);
    bf16_t* MX = wsp<bf16_t>(F, WS_MIXED);
    LAS float* ssA = (LAS float*)F.lds;
    LAS float* ssC = (LAS float*)(F.lds + 1024);
    const int row0 = b * SEQ + qb * 32;
#ifndef P2_SKIP_CONV
    {
        const int cgp = lane & 7, rg = lane >> 3, ch0 = head * 64 + cgp * 8;
        const bf16_t* CB = wsp<bf16_t>(F, WS_CB); const bf16_t* CC = wsp<bf16_t>(F, WS_CC); const bf16_t* CX = wsp<bf16_t>(F, WS_CX); const float* MT = wsp<float>(F, WS_META);
        float cv[4][8];
        {
            float w0[8], w1[8], w2[8], bs[8], u2[8], u1[8];
#pragma unroll
            for (int k = 0; k < 8; ++k) { w0[k] = F.conv_w[ch0 + k]; w1[k] = F.conv_w[512 + ch0 + k]; w2[k] = F.conv_w[1024 + ch0 + k]; bs[k] = F.conv_b[ch0 + k]; u2[k] = 0.f; u1[k] = 0.f; }
#pragma unroll
            for (int i = -2; i < 4; ++i) {
                const int sl = qb * 32 + rg * 4 + i;
                float u[8];
                if (sl >= 0) {
                    const size_t ro = (size_t)(b * SEQ + sl) * 512 + ch0;
                    const u32x4 c4 = *(const u32x4*)(CC + ro), x4 = *(const u32x4*)(CX + ro);
                    u[0] = bflo(c4.x) * bflo(x4.x); u[1] = bfhi(c4.x) * bfhi(x4.x); u[2] = bflo(c4.y) * bflo(x4.y); u[3] = bfhi(c4.y) * bfhi(x4.y);
                    u[4] = bflo(c4.z) * bflo(x4.z); u[5] = bfhi(c4.z) * bfhi(x4.z); u[6] = bflo(c4.w) * bflo(x4.w); u[7] = bfhi(c4.w) * bfhi(x4.w);
                } else {
                    const int mt = 2 + sl;
                    const f32x4 c0 = *(const f32x4*)(MT + mt * 512 + ch0), c1 = *(const f32x4*)(MT + mt * 512 + ch0 + 4), x0 = *(const f32x4*)(MT + (2 + mt) * 512 + ch0), x1 = *(const f32x4*)(MT + (2 + mt) * 512 + ch0 + 4);
#pragma unroll
                    for (int k = 0; k < 4; ++k) { u[k] = c0[k] * x0[k]; u[4 + k] = c1[k] * x1[k]; }
                }
                if (i >= 0) {
                    const u32x4 b4 = *(const u32x4*)(CB + (size_t)(b * SEQ + sl) * 512 + ch0);
                    const float cbv[8] = {bflo(b4.x), bfhi(b4.x), bflo(b4.y), bfhi(b4.y), bflo(b4.z), bfhi(b4.z), bflo(b4.w), bfhi(b4.w)};
#pragma unroll
                    for (int k = 0; k < 8; ++k) cv[i < 0 ? 0 : i][k] = cbv[k] * (w0[k] * u2[k] + w1[k] * u1[k] + w2[k] * u[k] + bs[k]);
                }
#pragma unroll
                for (int k = 0; k < 8; ++k) { u2[k] = u1[k]; u1[k] = u[k]; }
            }
        }
#pragma unroll
        for (int i = 0; i < 4; ++i) { float ss = 0.f;
#pragma unroll
            for (int k = 0; k < 8; ++k) ss += cv[i][k] * cv[i][k];
            ss += __shfl_xor(ss, 1); ss += __shfl_xor(ss, 2); ss += __shfl_xor(ss, 4);
            if (cgp == 0) ssC[head * 32 + rg * 4 + i] = ss; }
        __syncthreads();
        const f32x4 gc0 = *(const f32x4*)(F.g_conv + ch0), gc1 = *(const f32x4*)(F.g_conv + ch0 + 4);
#pragma unroll
        for (int i = 0; i < 4; ++i) { const int rl = rg * 4 + i; float tot = 0.f;
#pragma unroll
            for (int w = 0; w < 8; ++w) tot += ssC[w * 32 + rl];
            const float rstd = 1.0f / sqrtf(tot * (1.0f / AW) + RMS_EPS);
            u32x4 w4; w4.x = cvtpk(cv[i][0] * rstd * gc0[0], cv[i][1] * rstd * gc0[1]); w4.y = cvtpk(cv[i][2] * rstd * gc0[2], cv[i][3] * rstd * gc0[3]);
            w4.z = cvtpk(cv[i][4] * rstd * gc1[0], cv[i][5] * rstd * gc1[1]); w4.w = cvtpk(cv[i][6] * rstd * gc1[2], cv[i][7] * rstd * gc1[3]);
            *(u32x4*)(MX + (size_t)(row0 + rl) * DM + 512 + ch0) = w4; }
    }
#endif
#ifndef P2_SKIP_ATT
    LAS bf16x8* qlds = (LAS bf16x8*)(F.lds + 4096 + head * 4096) + lane;
    {
        const bf16_t* Qp = Q + (size_t)(row0 + l31) * 512 + head * 64 + hi * 8;
#pragma unroll
        for (int s = 0; s < 4; ++s) qlds[s * 64] = *(const bf16x8*)(Qp + s * 16);
    }
    f32x16 o[2];
#pragma unroll
    for (int d = 0; d < 2; ++d)
#pragma unroll
        for (int r = 0; r < 16; ++r) o[d][r] = 0.f;
    float carry = 0.f;
    const int pi = (l31 & 0x13) | ((l31 & 4) << 1) | ((l31 & 8) >> 1);
    const __amdgpu_buffer_rsrc_t rsK = __builtin_amdgcn_make_buffer_rsrc((void*)(KB + (size_t)b * TPAD * 512), (short)0, TPAD * 512 * 2, 0x00020000);
    const __amdgpu_buffer_rsrc_t rsV = __builtin_amdgcn_make_buffer_rsrc((void*)(VT + (size_t)b * TPAD), (short)0, (511 * NB * TPAD + TPAD) * 2, 0x00020000);
    const int voffK = (pi * 512 + head * 64 + hi * 8) * 2;
    const int voffV = ((head * 64 + l31) * (NB * TPAD) + hi * 8) * 2;
    const int P0 = QOFF + 32 * qb, qpos = P0 + l31;
    for (int start = P0 - 32; ; start -= 64) {
        bf16x8 kf[2][4];
#pragma unroll
        for (int kb = 0; kb < 2; ++kb)
#pragma unroll
            for (int s = 0; s < 4; ++s) kf[kb][s] = __builtin_bit_cast(bf16x8, __builtin_amdgcn_raw_buffer_load_b128(rsK, voffK + kb * 32768 + s * 32, start * 1024, 0));
        bf16x8 vf[2][2][2];
#pragma unroll
        for (int d = 0; d < 2; ++d)
#pragma unroll
            for (int kb = 0; kb < 2; ++kb)
#pragma unroll
                for (int s2 = 0; s2 < 2; ++s2) vf[d][kb][s2] = __builtin_bit_cast(bf16x8, __builtin_amdgcn_raw_buffer_load_b128(rsV, voffV + d * (32 * NB * TPAD * 2) + kb * 64 + s2 * 32, start * 2, 0));
        const bool lastt = start <= KPAD;
        const bool edge = (start == P0 - 32) || lastt;
        f32x16 s0, s1;
#pragma unroll
        for (int r = 0; r < 16; ++r) { s0[r] = 0.f; s1[r] = 0.f; }
#pragma unroll
        for (int s = 0; s < 4; ++s) { const bf16x8 qf = qlds[s * 64]; s0 = MFMA32(kf[0][s], qf, s0); s1 = MFMA32(kf[1][s], qf, s1); }
        bf16x8 pf[2][2];
        if (edge) sb_tile<true>(s0, s1, carry, start + 8 * hi, qpos, hi0, pf);
        else sb_tile<false>(s0, s1, carry, start + 8 * hi, qpos, hi0, pf);
#pragma unroll
        for (int d = 0; d < 2; ++d)
#pragma unroll
            for (int kb = 0; kb < 2; ++kb)
#pragma unroll
                for (int s2 = 0; s2 < 2; ++s2) o[d] = MFMA32(vf[d][kb][s2], pf[kb][s2], o[d]);
        if (lastt || __all(carry < EXIT_THR)) break;
    }
    int lane2 = lane; asm volatile("" : "+v"(lane2));
    const int l31b = lane2 & 31, hib = lane2 >> 5;
    {
        float ss = 0.f;
#pragma unroll
        for (int d = 0; d < 2; ++d)
#pragma unroll
            for (int r = 0; r < 16; ++r) ss += o[d][r] * o[d][r];
        ss += __shfl_xor(ss, 32);
        if (hib == 0) ssA[head * 32 + l31b] = ss;
    }
    __syncthreads();
    {
        float tot = 0.f;
#pragma unroll
        for (int h = 0; h < 8; ++h) tot += ssA[h * 32 + l31b];
        const float rstd = 1.0f / sqrtf(tot * (1.0f / AW) + RMS_EPS);
        bf16_t* orow = MX + (size_t)(row0 + l31b) * DM + head * 64 + 4 * hib;
#pragma unroll
        for (int d = 0; d < 2; ++d)
#pragma unroll
            for (int g = 0; g < 4; ++g) { const f32x4 ga = *(const f32x4*)(F.g_attn + head * 64 + 32 * d + 8 * g + 4 * hib);
                u32x2 w; w.x = cvtpk(o[d][4 * g] * rstd * ga[0], o[d][4 * g + 1] * rstd * ga[1]); w.y = cvtpk(o[d][4 * g + 2] * rstd * ga[2], o[d][4 * g + 3] * rstd * ga[3]);
                *(u32x2*)(orow + 32 * d + 8 * g) = w; }
    }
    __syncthreads();
#endif
}

__device__ __forceinline__ void p4_router(Frame& F) {
    LAS unsigned char* img = F.lds;
    LAS int* hist = (LAS int*)(F.lds + 65536);
    for (int idx = F.tid; idx < 64 * 2 * 32; idx += 512) { const int s = idx >> 6, h = (idx >> 5) & 1, e = idx & 31; const float* wp = F.w_router + (size_t)(16 * s + 8 * h) * NE + e;
        u32x4 w; w.x = cvtpk(wp[0], wp[NE]); w.y = cvtpk(wp[2 * NE], wp[3 * NE]); w.z = cvtpk(wp[4 * NE], wp[5 * NE]); w.w = cvtpk(wp[6 * NE], wp[7 * NE]);
        *(LAS u32x4*)(img + idx * 16) = w; }
    if (F.tid < 32) hist[F.tid] = 0;
    __syncthreads();
    const bf16_t* A2 = wsp<bf16_t>(F, WS_A); const float* ssp = wsp<float>(F, WS_SSP); float* rstd2 = wsp<float>(F, WS_RSTD2);
    int* tope = wsp<int>(F, WS_TOPE); float* gate = wsp<float>(F, WS_GATE); int* cnt = wsp<int>(F, WS_CNT);
    const int wg = F.vcu;
    if (F.wave < 4) {
        const int l31 = F.lane & 31, hi = F.lane >> 5, row = wg * 128 + F.wave * 32 + l31;
        f32x16 acc;
#pragma unroll
        for (int r = 0; r < 16; ++r) acc[r] = 0.f;
        const bf16_t* ap = A2 + (size_t)row * DM + 8 * hi;
#pragma unroll 8
        for (int s = 0; s < 64; ++s) { const bf16x8 a = *(const LAS bf16x8*)(img + ((s * 2 + hi) * 32 + l31) * 16); const bf16x8 bq = *(const bf16x8*)(ap + 16 * s); acc = MFMA32(a, bq, acc); }
        float ss = 0.f;
#pragma unroll
        for (int q = 0; q < 4; ++q) { const f32x4 p4 = *(const f32x4*)(ssp + (size_t)row * 16 + 4 * q); ss += (p4[0] + p4[1]) + (p4[2] + p4[3]); }
        const float rstd = 1.0f / sqrtf(ss * (1.0f / DM) + RMS_EPS);
        float lg[16];
#pragma unroll
        for (int r = 0; r < 16; ++r) lg[r] = acc[r] * rstd + F.b_router[(r & 3) + 8 * (r >> 2) + 4 * hi];
        float cvv[8]; int cei[8];
#pragma unroll
        for (int k = 0; k < 4; ++k) { float best = -INFINITY; int bi = 0;
#pragma unroll
            for (int r = 0; r < 16; ++r) { const bool gtb = lg[r] > best; best = gtb ? lg[r] : best; bi = gtb ? r : bi; }
#pragma unroll
            for (int r = 0; r < 16; ++r) lg[r] = (r == bi) ? -INFINITY : lg[r];
            cvv[k] = best; cei[k] = (bi & 3) + 8 * (bi >> 2) + 4 * hi; }
#pragma unroll
        for (int k = 0; k < 4; ++k) { cvv[4 + k] = __shfl_xor(cvv[k], 32); cei[4 + k] = __shfl_xor(cei[k], 32); }
        float tv[4]; int te[4];
#pragma unroll
        for (int k = 0; k < 4; ++k) { float best = -INFINITY; int be = 1 << 30, bi = 0;
#pragma unroll
            for (int c = 0; c < 8; ++c) { const bool better = (cvv[c] > best) || (cvv[c] == best && cei[c] < be); best = better ? cvv[c] : best; be = better ? cei[c] : be; bi = better ? c : bi; }
#pragma unroll
            for (int c = 0; c < 8; ++c) { const bool hit = (c == bi); cvv[c] = hit ? -INFINITY : cvv[c]; cei[c] = hit ? (1 << 30) : cei[c]; }
            tv[k] = best; te[k] = be; }
        const float e1 = ex2((tv[1] - tv[0]) * LOG2E), e2 = ex2((tv[2] - tv[0]) * LOG2E), e3 = ex2((tv[3] - tv[0]) * LOG2E);
        const float inv = 1.0f / (1.0f + e1 + e2 + e3);
        if (hi == 0) {
            rstd2[row] = rstd;
            *(i32x4*)(tope + (size_t)row * 4) = (i32x4){te[0], te[1], te[2], te[3]};
            *(f32x4*)(gate + (size_t)row * 4) = (f32x4){inv, e1 * inv, e2 * inv, e3 * inv};
#pragma unroll
            for (int k = 0; k < 4; ++k) atomicAdd((int*)(hist + te[k]), 1);
        }
    }
    __syncthreads();
    if (F.tid < 32) cnt[wg * 32 + F.tid] = hist[F.tid];
    __syncthreads();
}

__device__ __forceinline__ void p5_scatter(Frame& F) {
    LAS int* tot = (LAS int*)F.lds; LAS int* pre = tot + 32; LAS int* ctr = tot + 64; LAS int* pstart = tot + 96;
    const int* cnt = wsp<int>(F, WS_CNT); const int wg = F.vcu;
    if (F.tid < 64) tot[F.tid] = 0;
    __syncthreads();
    { const int e = F.tid & 31, j = F.tid >> 5; int t = 0, p = 0;
        for (int w = j; w < 256; w += 16) { const int c = ld_i(cnt + w * 32 + e); t += c; p += (w < wg) ? c : 0; }
        atomicAdd((int*)(tot + e), t); atomicAdd((int*)(pre + e), p); }
    __syncthreads();
    if (F.tid == 0) { int run = 0; for (int e = 0; e < 32; ++e) { pstart[e] = run; run += (tot[e] + 255) & ~255; } pstart[32] = run; }
    __syncthreads();
    if (F.tid < 32) ctr[F.tid] = pstart[F.tid] + pre[F.tid];
    int* slot_tok = wsp<int>(F, WS_SLOTTOK); float* slot_gate = wsp<float>(F, WS_SLOTGATE); float* slot_rstd = wsp<float>(F, WS_SLOTRSTD);
    int* tile_e = wsp<int>(F, WS_TILEE);
    if (wg == 0) {
        if (F.tid < 32) { for (int rt = pstart[F.tid] >> 8; rt < (pstart[F.tid + 1] >> 8); ++rt) tile_e[rt] = F.tid; }
        if (F.tid == 0) tile_e[CAP_TILES] = pstart[32] >> 8;
    }
    if (wg < 32) { const int e = wg; for (int s = pstart[e] + tot[e] + F.tid; s < pstart[e + 1]; s += 512) { slot_tok[s] = 0; slot_gate[s] = 0.f; slot_rstd[s] = 0.f; } }
    __syncthreads();
    { const int tok = wg * 128 + (F.tid >> 2), k = F.tid & 3;
        const int e = ld_i(wsp<int>(F, WS_TOPE) + tok * 4 + k);
        const int slot = atomicAdd((int*)(ctr + e), 1);
        slot_tok[slot] = tok; slot_gate[slot] = ld_f(wsp<float>(F, WS_GATE) + tok * 4 + k); slot_rstd[slot] = ld_f(wsp<float>(F, WS_RSTD2) + tok);
        wsp<int>(F, WS_TOKSLOT)[tok * 4 + k] = slot; }
    __syncthreads();
}

__device__ __forceinline__ void p8_combine(Frame& F) {
    const int gw = F.vcu * NWAVES + F.wave, NGW = F.G * NWAVES;
    const bf16_t* ys = wsp<bf16_t>(F, WS_YS); const int* tokslot = wsp<int>(F, WS_TOKSLOT);
    f32x4 gf[2][2];
#pragma unroll
    for (int j = 0; j < 2; ++j) { gf[j][0] = *(const f32x4*)(F.g_final + 512 * j + 8 * F.lane); gf[j][1] = *(const f32x4*)(F.g_final + 512 * j + 8 * F.lane + 4); }
    for (int m = gw; m < NTOK; m += NGW) {
        int sl[4];
#pragma unroll
        for (int k = 0; k < 4; ++k) sl[k] = ld_i(tokslot + (size_t)m * 4 + k);
        float* hrow = F.out + (size_t)m * DM + 8 * F.lane;
        f32x4 v[2][2]; float ss = 0.f;
#pragma unroll
        for (int j = 0; j < 2; ++j) { v[j][0] = *(const f32x4*)(hrow + 512 * j); v[j][1] = *(const f32x4*)(hrow + 512 * j + 4);
#pragma unroll
            for (int k = 0; k < 4; ++k) { const u32x4 y = *(const u32x4*)(ys + (size_t)sl[k] * DM + 512 * j + 8 * F.lane);
                v[j][0][0] += bflo(y.x); v[j][0][1] += bfhi(y.x); v[j][0][2] += bflo(y.y); v[j][0][3] += bfhi(y.y);
                v[j][1][0] += bflo(y.z); v[j][1][1] += bfhi(y.z); v[j][1][2] += bflo(y.w); v[j][1][3] += bfhi(y.w); }
#pragma unroll
            for (int q = 0; q < 2; ++q) ss += (v[j][q][0] * v[j][q][0] + v[j][q][1] * v[j][q][1]) + (v[j][q][2] * v[j][q][2] + v[j][q][3] * v[j][q][3]); }
        const float rstd = 1.0f / sqrtf(wave_sum(ss) * (1.0f / DM) + RMS_EPS);
#pragma unroll
        for (int j = 0; j < 2; ++j) { *(f32x4*)(hrow + 512 * j) = v[j][0] * rstd * gf[j][0]; *(f32x4*)(hrow + 512 * j + 4) = v[j][1] * rstd * gf[j][1]; }
    }
}

constexpr int N_PHASES = 9;
__global__ void __launch_bounds__(NWAVES * 64, 2) fwd(Args args) {
    extern __shared__ __attribute__((aligned(16))) unsigned char lds_raw[];
    Frame F;
    F.lds = (LAS unsigned char*)lds_raw;
    F.tid = threadIdx.x; F.lane = F.tid & 63; F.wave = __builtin_amdgcn_readfirstlane(F.tid >> 6);
    F.G = gridDim.x; { const int bx = blockIdx.x; F.vcu = (F.G % 8 == 0) ? (bx % 8) * (F.G / 8) + bx / 8 : bx; }
    F.ws = args.ws; F.ctl = (gu32*)(args.ws + WS_CTL); F.out = args.out;
    F.x = args.in[0]; F.meta = args.in[1]; F.g_mix = args.in[2]; F.w_in = args.in[3]; F.g_attn = args.in[4]; F.conv_w = args.in[5]; F.conv_b = args.in[6]; F.g_conv = args.in[7];
    F.w_out = args.in[8]; F.g_ffn = args.in[9]; F.w_router = args.in[10]; F.b_router = args.in[11]; F.w_gu = args.in[12]; F.b_gu = args.in[13]; F.w_down = args.in[14]; F.b_down = args.in[15]; F.g_final = args.in[16];
    volatile LAS unsigned* MISC = (volatile LAS unsigned*)(F.lds + MISC_OFF);
    for (int u = F.tid; u < (LDS_BYTES - LDSCTL_OFF) / 4; u += NWAVES * 64) ((LAS unsigned*)(F.lds + LDSCTL_OFF))[u] = 0u;
    __syncthreads();
    const int lo = args.ph_lo, hi = args.ph_hi;
    const bool multi = (hi - lo) > 1;
    XcdBarrier bar; bar.bar = (unsigned*)(F.ctl + CW_BAR); bar.x = 0; bar.st = nullptr;
    if (multi) bar = xcd_barrier_post((unsigned*)(F.ctl + CW_BAR), MISC + 8);
#ifndef PH_MASK
#define PH_MASK 0x1ff
#endif
#define IN(k) (((PH_MASK >> (k)) & 1) && lo <= (k) && (k) < hi)
#define SEAM(k) do { if (IN(k) && IN((k) + 1)) xcd_barrier(bar); } while (0)

    if (IN(0)) { p0_prologue(F); }
    SEAM(0);
    if (IN(1)) {
        { pg8::SchedPlain S; S.init(wsp<bf16_t>(F, WS_A), wsp<bf16_t>(F, WS_WIN), NTOK, 2560, F.G, (int)blockIdx.x);
          EpiProj E{wsp<bf16_t>(F, WS_Q), wsp<bf16_t>(F, WS_KB), wsp<bf16_t>(F, WS_CB), wsp<bf16_t>(F, WS_CC), wsp<bf16_t>(F, WS_CX), wsp<float>(F, WS_RSTD1)};
          pg8::gemm_phase<EpiProj, pg8::SchedPlain, false>(F.lds, S, E); }
        { pg8::SchedPlain S; S.init(wsp<bf16_t>(F, WS_WIN) + (size_t)2560 * DM, wsp<bf16_t>(F, WS_A), 512, NTOK, F.G, (int)blockIdx.x);
          EpiVt E{wsp<bf16_t>(F, WS_VT), wsp<float>(F, WS_RSTD1)};
          pg8::gemm_phase<EpiVt, pg8::SchedPlain, false>(F.lds, S, E); }
    }
    SEAM(1);
    if (IN(2)) {
        for (int u = F.vcu; u < NB * (SEQ / 32); u += F.G) p2_unit(F, u >> 7, u & 127);
    }
    SEAM(2);
    if (IN(3)) {
        pg8::SchedPlain S; S.init(wsp<bf16_t>(F, WS_MIXED), wsp<bf16_t>(F, WS_WOUT), NTOK, DM, F.G, (int)blockIdx.x);
        EpiOut E{F.x, F.out, wsp<bf16_t>(F, WS_A), wsp<float>(F, WS_SSP), F.g_ffn};
        pg8::gemm_phase<EpiOut, pg8::SchedPlain, false>(F.lds, S, E);
    }
    SEAM(3);
    if (IN(4)) { p4_router(F); }
    SEAM(4);
    if (IN(5)) { p5_scatter(F); }
    SEAM(5);
    if (IN(6)) {
        pg8::SchedGrouped S; S.A = (const char*)wsp<bf16_t>(F, WS_A); S.Bt = (const char*)wsp<bf16_t>(F, WS_WGU); S.estep = (size_t)2048 * 1024 * 2; S.nN = 8; S.G = F.G; S.c = F.vcu;
        S.tile_e = wsp<int>(F, WS_TILEE); S.slot_tok = wsp<int>(F, WS_SLOTTOK); S.ntiles = __builtin_amdgcn_readfirstlane(ld_i(S.tile_e + CAP_TILES));
        EpiGU E{wsp<bf16_t>(F, WS_HID), F.b_gu, wsp<float>(F, WS_SLOTRSTD)};
        pg8::gemm_phase<EpiGU, pg8::SchedGrouped, true>(F.lds, S, E);
    }
    SEAM(6);
    if (IN(7)) {
        pg8::SchedGrouped S; S.A = (const char*)wsp<bf16_t>(F, WS_HID); S.Bt = (const char*)wsp<bf16_t>(F, WS_WD); S.estep = (size_t)1024 * 1024 * 2; S.nN = 4; S.G = F.G; S.c = F.vcu;
        S.tile_e = wsp<int>(F, WS_TILEE); S.slot_tok = wsp<int>(F, WS_SLOTTOK); S.ntiles = __builtin_amdgcn_readfirstlane(ld_i(S.tile_e + CAP_TILES));
        EpiDown E{wsp<bf16_t>(F, WS_YS), F.b_down, wsp<float>(F, WS_SLOTGATE)};
        pg8::gemm_phase<EpiDown, pg8::SchedGrouped, false>(F.lds, S, E);
    }
    SEAM(7);
    if (IN(8)) { p8_combine(F); }
#undef IN
#undef SEAM
}

#ifndef MK_N_LAUNCHES
#define MK_N_LAUNCHES 1
#endif
extern "C" void kernel_launch(void* const* d_in, const int* in_sizes, int n_in, void* d_out, int out_size, void* d_ws, size_t ws_size, hipStream_t stream) {
    static int grid = 0;
    if (grid == 0) {
        if (n_in != 17 || out_size != NTOK * DM || ws_size < WS_END) { fprintf(stderr, "kernel_launch: unexpected problem (n_in %d out %d ws %zu)\n", n_in, out_size, ws_size); grid = -1; return; }
        int dev = 0, cus = 0, per_cu = 0;
        if (hipGetDevice(&dev) != hipSuccess || hipDeviceGetAttribute(&cus, hipDeviceAttributeMultiprocessorCount, dev) != hipSuccess) { grid = -1; return; }
        if (hipFuncSetAttribute((const void*)fwd, hipFuncAttributeMaxDynamicSharedMemorySize, LDS_BYTES) != hipSuccess) { fprintf(stderr, "kernel_launch: hipFuncSetAttribute failed\n"); grid = -1; return; }
        if (hipOccupancyMaxActiveBlocksPerMultiprocessor(&per_cu, (const void*)fwd, NWAVES * 64, LDS_BYTES) != hipSuccess || per_cu < 1) { fprintf(stderr, "kernel_launch: occupancy query says %d\n", per_cu); }
        (void)hipGetLastError();
        grid = cus;
        if (grid != 256) fprintf(stderr, "kernel_launch: %d CUs (built for 256)\n", grid);
    }
    if (grid < 0) return;
    (void)hipMemsetAsync((char*)d_ws + WS_CTL, 0, CTL_ZERO_BYTES, stream);
    Args a{};
    for (int i = 0; i < 17; ++i) a.in[i] = (const float*)d_in[i];
    a.out = (float*)d_out; a.ws = (unsigned char*)d_ws;
    if (MK_N_LAUNCHES == 1) { a.ph_lo = 0; a.ph_hi = N_PHASES; hipLaunchKernelGGL(fwd, dim3(grid), dim3(NWAVES * 64), LDS_BYTES, stream, a); }
    else for (int p = 0; p < N_PHASES; ++p) { a.ph_lo = p; a.ph_hi = p + 1; hipLaunchKernelGGL(fwd, dim3(grid), dim3(NWAVES * 64), LDS_BYTES, stream, a); }
    const hipError_t le = hipPeekAtLastError();
    if (le != hipSuccess) fprintf(stderr, "kernel_launch: launch failed: %s\n", hipGetErrorName(le));
}
```

```cpp
#include <hip/hip_runtime.h>
#include <cstdio>
#include <cstdint>

#define GAS __attribute__((address_space(1)))
#define LAS __attribute__((address_space(3)))
typedef unsigned short bf16_t;
typedef short bf16x8 __attribute__((ext_vector_type(8)));
typedef float f32x2 __attribute__((ext_vector_type(2)));
typedef float f32x4 __attribute__((ext_vector_type(4)));
typedef float f32x16 __attribute__((ext_vector_type(16)));
typedef unsigned u32x2 __attribute__((ext_vector_type(2)));
typedef unsigned u32x4 __attribute__((ext_vector_type(4)));
typedef int i32x4 __attribute__((ext_vector_type(4)));
typedef int i32x8 __attribute__((ext_vector_type(8)));
typedef __bf16 bf16x2_t __attribute__((ext_vector_type(2)));
typedef GAS unsigned gu32;
#define RLX_AGENT __ATOMIC_RELAXED, __HIP_MEMORY_SCOPE_AGENT

constexpr int DM = 1024, NB = 8, SEQ = 4096, NTOK = NB * SEQ;
constexpr int NMETA = 16, KPAD = 48, TPAD = KPAD + NMETA + SEQ;
constexpr int QOFF = KPAD + NMETA;
constexpr int AW = 512, NH = 8, HD = 64;
constexpr int NE = 32, TOPK = 4, FF = 1024;
constexpr int CAP_TILES = 544, CAP = CAP_TILES * 256;
constexpr float RMS_EPS = 1e-6f;
constexpr float LOG2E = 1.4426950408889634f;
constexpr float QSCALE = 0.125f * LOG2E;
constexpr float EXIT_THR = -152.0f;
constexpr int NWAVES = 8;
constexpr float WSCALE = 32.0f, WINV = 1.0f / 32.0f;

constexpr size_t MiB = 1u << 20, KiB = 1u << 10;
constexpr size_t WS_CTL = 0, CTL_ZERO_BYTES = 64 * KiB;
constexpr size_t WS_RSTD1 = 1 * MiB, WS_RSTD2 = WS_RSTD1 + 128 * KiB, WS_CNT = WS_RSTD2 + 128 * KiB, WS_TILEE = WS_CNT + 64 * KiB, WS_META = WS_TILEE + 64 * KiB;
constexpr size_t WS_TOPE = 2 * MiB, WS_GATE = WS_TOPE + 512 * KiB, WS_TOKSLOT = 3 * MiB;
constexpr size_t WS_SLOTTOK = 4 * MiB, WS_SLOTGATE = 5 * MiB, WS_SLOTRSTD = 6 * MiB;
constexpr size_t WS_SSP = 8 * MiB;
constexpr size_t WS_WIN = 10 * MiB, WS_WGU = 16 * MiB, WS_WD = 144 * MiB, WS_A = 208 * MiB;
constexpr size_t WS_HID = 272 * MiB;
constexpr size_t WS_Q = 272 * MiB, WS_KB = 304 * MiB, WS_VT = 337 * MiB, WS_CB = 370 * MiB, WS_CC = 402 * MiB, WS_CX = 434 * MiB, WS_MIXED = 466 * MiB;
constexpr size_t WS_YS = 544 * MiB, WS_WOUT = 816 * MiB, WS_A8 = 820 * MiB, WS_END = 852 * MiB;
static_assert(WS_MIXED + 64 * MiB <= WS_HID + (size_t)CAP * 2048 && WS_HID + (size_t)CAP * 2048 <= WS_YS && WS_YS + (size_t)CAP * 2048 <= WS_WOUT, "ws map");
static_assert((size_t)NB * TPAD * 512 * 2 <= 33 * MiB, "K/Vt size");
constexpr int CW_TMO = 0, CW_BAR = 1024;

constexpr int RING_BYTES = 131072, LDSCTL_OFF = RING_BYTES, MISC_OFF = LDSCTL_OFF + 320, LDS_BYTES = 147456;

__device__ __forceinline__ unsigned cvtpk(float lo, float hi) { f32x2 v = {lo, hi}; bf16x2_t b = __builtin_convertvector(v, bf16x2_t); return __builtin_bit_cast(unsigned, b); }
__device__ __forceinline__ unsigned pk4_fp8(float a, float b, float c, float d) { int w = 0; w = __builtin_amdgcn_cvt_pk_fp8_f32(a, b, w, false); w = __builtin_amdgcn_cvt_pk_fp8_f32(c, d, w, true); return (unsigned)w; }
__device__ __forceinline__ float bflo(unsigned u) { return __builtin_bit_cast(float, u << 16); }
__device__ __forceinline__ float bfhi(unsigned u) { return __builtin_bit_cast(float, u & 0xffff0000u); }
__device__ __forceinline__ float ex2(float x) { return __builtin_amdgcn_exp2f(x); }
__device__ __forceinline__ float lg2(float x) { return __builtin_amdgcn_logf(x); }
__device__ __forceinline__ int ld_i(const int* p) { return __hip_atomic_load(p, RLX_AGENT); }
__device__ __forceinline__ float ld_f(const float* p) { return __builtin_bit_cast(float, __hip_atomic_load((const int*)p, RLX_AGENT)); }
__device__ __forceinline__ float wave_sum(float v) {
#pragma unroll
    for (int o = 1; o < 64; o <<= 1) v += __shfl_xor(v, o);
    return v;
}
#define LDS_WAIT() asm volatile("s_waitcnt lgkmcnt(0)" ::: "memory")
#define VM_WAIT() asm volatile("s_waitcnt vmcnt(0)" ::: "memory")

namespace pg8 {
constexpr int BM = 256, BK = 64, HALF = 128, HTB = HALF * BK * 2, STAGE_BYTES = 8 * HTB, NXCD = 8, WGM = 8, GK = 1024;
__host__ __device__ __forceinline__ int lds_byte(int r, int c) { const int st = (r >> 4) * 2 + (c >> 5), rr = r & 15, cc = c & 31, ob = rr * 64 + cc * 2; return st * 1024 + (ob ^ (((ob >> 9) & 1) << 5)); }
__host__ __device__ __forceinline__ void stage_rc(int b, int& R, int& C) { const int st = b / 1024, sb = b % 1024, swz = sb ^ (((sb >> 9) & 1) << 5); R = (st >> 1) * 16 + swz / 64; C = (st & 1) * 32 + (swz % 64) / 2; }
__host__ __device__ __forceinline__ int perm32(int rho) { const int n = rho >> 4, i = rho & 15; return 8 * (i >> 2) + 4 * n + (i & 3); }
struct Unit { int pm, pn, e; };

struct SchedPlain {
    const char* A; const char* Bt; int nM, nN, nwg, G, c; static constexpr int RB = 2048;
    __device__ void init(const void* A_, const void* Bt_, int M, int N, int G_, int c_) { A = (const char*)A_; Bt = (const char*)Bt_; nM = M / BM; nN = N / BM; nwg = nM * nN; G = G_; c = c_; }
    __device__ __forceinline__ bool next(int i, Unit& u) const {
        const long L = (long)i * G + c; if (L >= nwg) return false;
        int wgid = (int)L; { const int q = nwg / NXCD, r = nwg % NXCD, xcd = wgid % NXCD, off = wgid / NXCD; wgid = (xcd < r ? xcd * (q + 1) : r * (q + 1) + (xcd - r) * q) + off; }
        const int nig = WGM * nN, gid = wgid / nig, fm = gid * WGM, gsz = (nM - fm) < WGM ? (nM - fm) : WGM;
        u.pm = fm + ((wgid % nig) % gsz); u.pn = (wgid % nig) / gsz; u.e = 0; return true;
    }
    __device__ __forceinline__ unsigned a_tile(const Unit& u) const { return (unsigned)u.pm * (unsigned)(BM * RB); }
    __device__ __forceinline__ unsigned b_tile(const Unit& u) const { return (unsigned)u.pn * (unsigned)(BM * RB); }
    __device__ __forceinline__ unsigned tok_off(int) const { return 0u; }
};
template <int RB_> struct SchedGrouped {
    static constexpr int RB = RB_;
    const char* A; const char* Bt; size_t estep; int nN, G, c, ntiles; const int* tile_e; const int* slot_tok;
    __device__ __forceinline__ bool next(int i, Unit& u) const {
        const int L = i * G + c; if (L >= ntiles * nN) return false;
        u.pm = L / nN; u.pn = L % nN; u.e = __builtin_amdgcn_readfirstlane(ld_i(tile_e + u.pm)); return true;
    }
    __device__ __forceinline__ unsigned a_tile(const Unit& u) const { return (unsigned)u.pm * (unsigned)(BM * RB); }
    __device__ __forceinline__ unsigned b_tile(const Unit& u) const { return (unsigned)u.e * (unsigned)estep + (unsigned)u.pn * (unsigned)(BM * RB); }
    __device__ __forceinline__ unsigned tok_off(int row) const { return (unsigned)ld_i(slot_tok + row) * (unsigned)RB; }
};

template <class Epi, class Sched, bool GATHER, bool FP8 = false>
__device__ __forceinline__ void gemm_phase(LAS unsigned char* lds, const Sched& S, const Epi& E) {
    constexpr int RB = Sched::RB, nt = RB / 128;
    const int tid = threadIdx.x, wid = __builtin_amdgcn_readfirstlane(tid >> 6), lane = tid & 63, wr = wid >> 2, wc = wid & 3, fr = lane & 15, fq = lane >> 4;
    unsigned voffA[2], voffB[2], stC2[2]; int stR[2];
#pragma unroll
    for (int i = 0; i < 2; ++i) { int R, C; stage_rc(tid * 16 + i * 8192, R, C); const int Rb = (R & ~31) + perm32(R & 31);
        voffA[i] = (unsigned)(R * RB + C * 2); voffB[i] = (unsigned)(Rb * RB + C * 2); stR[i] = R; stC2[i] = (unsigned)C * 2u; }
    constexpr unsigned kstep = 128u, hstep = (unsigned)(HALF * RB);
    const __amdgpu_buffer_rsrc_t rsA = __builtin_amdgcn_make_buffer_rsrc((void*)S.A, (short)0, 0x7fffff00, 0x00020000), rsB = __builtin_amdgcn_make_buffer_rsrc((void*)S.Bt, (short)0, 0x7fffff00, 0x00020000);
    const unsigned ldsw = (unsigned)wid * 1024u;
    const int aoff = lds_byte(wr * 64 + fr, fq * 8), boff = lds_byte(wc * 32 + fr, fq * 8);
#define PG8_SA(b, h) (((b) * 2 + (h)) * HTB)
#define PG8_SB(b, h) ((4 + (b) * 2 + (h)) * HTB)
#define PG8_STAGE2(bufoff, rs, soff, o0, o1) do { \
        __builtin_amdgcn_raw_ptr_buffer_load_lds(rs, (LAS void*)(lds + (bufoff) + ldsw), 16, (int)(o0), (int)(soff), 0, 0); \
        __builtin_amdgcn_raw_ptr_buffer_load_lds(rs, (LAS void*)(lds + (bufoff) + ldsw + 8192), 16, (int)(o1), (int)(soff), 0, 0); } while (0)
#define PG8_STAGE_B(bufoff, soff) PG8_STAGE2(bufoff, rsB, soff, voffB[0], voffB[1])
#define PG8_STAGE_A(bufoff, usenext, h, koff) do { if constexpr (GATHER) { \
            const unsigned _o0 = (usenext) ? ng[h][0] : cg[h][0], _o1 = (usenext) ? ng[h][1] : cg[h][1]; PG8_STAGE2(bufoff, rsA, (koff), _o0, _o1); } \
        else { PG8_STAGE2(bufoff, rsA, ((usenext) ? nA : cA) + (unsigned)(h) * hstep + (koff), voffA[0], voffA[1]); } } while (0)
#define PG8_LDA(dst, b, h) do { _Pragma("unroll") for (int m = 0; m < 4; ++m) _Pragma("unroll") for (int k = 0; k < 2; ++k) dst[m][k] = *(const LAS bf16x8*)(lds + PG8_SA(b, h) + aoff + m * 2048 + k * 1024); } while (0)
#define PG8_LDB(dst, b, h) do { _Pragma("unroll") for (int n = 0; n < 2; ++n) _Pragma("unroll") for (int k = 0; k < 2; ++k) dst[n][k] = *(const LAS bf16x8*)(lds + PG8_SB(b, h) + boff + n * 2048 + k * 1024); } while (0)
#define PG8_MMA(ai, bj, At, Bt) do { __builtin_amdgcn_s_setprio(1); _Pragma("unroll") for (int m = 0; m < 4; ++m) _Pragma("unroll") for (int n = 0; n < 2; ++n) { \
        if constexpr (FP8) { const i32x8 bb_ = __builtin_shufflevector(__builtin_bit_cast(i32x4, Bt[n][0]), __builtin_bit_cast(i32x4, Bt[n][1]), 0, 1, 2, 3, 4, 5, 6, 7); \
            const i32x8 aa_ = __builtin_shufflevector(__builtin_bit_cast(i32x4, At[m][0]), __builtin_bit_cast(i32x4, At[m][1]), 0, 1, 2, 3, 4, 5, 6, 7); \
            asm volatile("v_mfma_scale_f32_16x16x128_f8f6f4 %0, %1, %2, %0, %3, %3 op_sel_hi:[0,0,0]" : "+v"(acc[ai][bj][m][n]) : "v"(bb_), "v"(aa_), "v"(scl8)); } \
        else { _Pragma("unroll") for (int k = 0; k < 2; ++k) acc[ai][bj][m][n] = __builtin_amdgcn_mfma_f32_16x16x32_bf16(Bt[n][k], At[m][k], acc[ai][bj][m][n], 0, 0, 0); } } \
        __builtin_amdgcn_s_setprio(0); } while (0)
#define PG8_MFMA_DRAIN() do { if constexpr (FP8) asm volatile("s_nop 7\n\ts_nop 7" ::: "memory"); } while (0)
#define PG8_WAIT_V(n) asm volatile("s_waitcnt vmcnt(" #n ")" ::: "memory")
#define PG8_WAIT_L(n) asm volatile("s_waitcnt lgkmcnt(" #n ")" ::: "memory")
#define PG8_BAR __builtin_amdgcn_s_barrier()
#define PG8_SCHED __builtin_amdgcn_sched_barrier(0)
    Unit cur, nxt; int ui = 0;
    if (!S.next(0, cur)) return;
    f32x4 acc[2][2][4][2];
#pragma unroll
    for (int a = 0; a < 2; ++a)
#pragma unroll
        for (int b = 0; b < 2; ++b)
#pragma unroll
            for (int m = 0; m < 4; ++m)
#pragma unroll
                for (int n = 0; n < 2; ++n) acc[a][b][m][n] = (f32x4){0.f, 0.f, 0.f, 0.f};
    bf16x8 At[4][2], B0[2][2], B1[2][2];
    int scl8 = 0x7f7f7f7f; asm volatile("" : "+v"(scl8));
    unsigned cA = S.a_tile(cur), cB = S.b_tile(cur), nA = cA;
    unsigned cg[2][2], ng[2][2];
    if constexpr (GATHER) {
#pragma unroll
        for (int h = 0; h < 2; ++h)
#pragma unroll
            for (int i = 0; i < 2; ++i) { cg[h][i] = S.tok_off(cur.pm * BM + h * HALF + stR[i]) + stC2[i]; ng[h][i] = cg[h][i]; }
    } else {
#pragma unroll
        for (int h = 0; h < 2; ++h)
#pragma unroll
            for (int i = 0; i < 2; ++i) { cg[h][i] = 0u; ng[h][i] = 0u; }
    }
    PG8_STAGE_B(PG8_SB(0, 0), cB); PG8_STAGE_B(PG8_SB(0, 1), cB + hstep); PG8_STAGE_A(PG8_SA(0, 0), false, 0, 0); PG8_STAGE_A(PG8_SA(0, 1), false, 1, 0);
    if (wr == 1) PG8_BAR;
    PG8_WAIT_V(2); PG8_BAR;
    PG8_STAGE_B(PG8_SB(1, 0), cB + kstep); PG8_STAGE_A(PG8_SA(1, 0), false, 0, kstep); PG8_STAGE_B(PG8_SB(1, 1), cB + hstep + kstep);
    PG8_WAIT_V(6); PG8_BAR;
    for (;;) {
        const bool has_next = S.next(ui + 1, nxt);
        nA = has_next ? S.a_tile(nxt) : cA; const unsigned nB = has_next ? S.b_tile(nxt) : cB;
#pragma unroll 1
        for (int t = 0; t < nt; t += 2) {
            const bool last = (t == nt - 2);
            const unsigned koff1 = (unsigned)(t + 1) * kstep, koff2 = last ? 0u : (unsigned)(t + 2) * kstep, koff3 = koff2 + kstep;
            const unsigned b2 = last ? nB : cB + (unsigned)(t + 2) * kstep, b3 = b2 + kstep;
            if constexpr (GATHER) { if (last && has_next) {
#pragma unroll
                for (int h = 0; h < 2; ++h)
#pragma unroll
                    for (int i = 0; i < 2; ++i) ng[h][i] = S.tok_off(nxt.pm * BM + h * HALF + stR[i]) + stC2[i]; } }
            PG8_LDB(B0, 0, 0); PG8_LDB(B1, 0, 1); PG8_SCHED; PG8_LDA(At, 0, 0); PG8_STAGE_A(PG8_SA(1, 1), false, 1, koff1);
            PG8_WAIT_V(8); PG8_WAIT_L(0); PG8_BAR; PG8_MMA(0, 0, At, B0); PG8_MMA(0, 1, At, B1); PG8_BAR; PG8_SCHED;
            PG8_LDA(At, 0, 1); PG8_STAGE_B(PG8_SB(0, 0), b2); PG8_STAGE_B(PG8_SB(0, 1), b2 + hstep); PG8_STAGE_A(PG8_SA(0, 0), last, 0, koff2);
            PG8_WAIT_V(8); PG8_WAIT_L(0); PG8_BAR; PG8_MMA(1, 0, At, B0); PG8_MMA(1, 1, At, B1); PG8_BAR; PG8_SCHED;
            PG8_LDB(B0, 1, 0); PG8_LDB(B1, 1, 1); PG8_SCHED; PG8_LDA(At, 1, 0); PG8_STAGE_A(PG8_SA(0, 1), last, 1, koff2);
            PG8_WAIT_V(8); PG8_WAIT_L(0); PG8_BAR; PG8_MMA(0, 0, At, B0); PG8_MMA(0, 1, At, B1); PG8_BAR; PG8_SCHED;
            PG8_LDA(At, 1, 1); PG8_STAGE_B(PG8_SB(1, 0), b3); PG8_STAGE_B(PG8_SB(1, 1), b3 + hstep); PG8_STAGE_A(PG8_SA(1, 0), last, 0, koff3);
            PG8_WAIT_V(8); PG8_WAIT_L(0); PG8_BAR; PG8_MMA(1, 0, At, B0); PG8_MMA(1, 1, At, B1); PG8_BAR; PG8_SCHED;
        }
        if (wr == 0) PG8_BAR;
        PG8_MFMA_DRAIN();
        E(acc, cur, wr, wc, fr, fq);
        if (!has_next) break;
#pragma unroll
        for (int a = 0; a < 2; ++a)
#pragma unroll
            for (int b = 0; b < 2; ++b)
#pragma unroll
                for (int m = 0; m < 4; ++m)
#pragma unroll
                    for (int n = 0; n < 2; ++n) acc[a][b][m][n] = (f32x4){0.f, 0.f, 0.f, 0.f};
        cur = nxt; cA = nA; cB = nB; ++ui;
#pragma unroll
        for (int h = 0; h < 2; ++h)
#pragma unroll
            for (int i = 0; i < 2; ++i) cg[h][i] = ng[h][i];
        if (wr == 1) PG8_BAR;
    }
    PG8_WAIT_V(0);
    PG8_BAR;
#undef PG8_SA
#undef PG8_SB
#undef PG8_STAGE2
#undef PG8_STAGE_B
#undef PG8_STAGE_A
#undef PG8_LDA
#undef PG8_LDB
#undef PG8_MMA
#undef PG8_MFMA_DRAIN
#undef PG8_WAIT_V
#undef PG8_WAIT_L
#undef PG8_BAR
#undef PG8_SCHED
}
}

#define XB_TMO      128
#define XB_XCNT(j)  (256  + 64 * (j))
#define XB_XSUB(j)  (1280 + 64 * (j))
#define XB_XGEN(j)  (2304 + 64 * (j))
#define XB_TOP      3328
#define XB_TOPGEN   3392
#define XCD_BAR_WORDS 3456
#define XB_SPIN_CAP (1u << 18)

__device__ __forceinline__ unsigned xb_ld(unsigned* p)              { return __hip_atomic_load(p, __ATOMIC_RELAXED, __HIP_MEMORY_SCOPE_AGENT); }
__device__ __forceinline__ unsigned xb_add(unsigned* p, unsigned v) { return __hip_atomic_fetch_add(p, v, __ATOMIC_RELAXED, __HIP_MEMORY_SCOPE_AGENT); }
__device__ __forceinline__ unsigned xb_xcc_id() { return (unsigned)__builtin_amdgcn_s_getreg((3 << 11) | 20) & 0xFu; }
#define XB_SPIN(cond, bar) do { unsigned _sp = 0; while (cond) { __builtin_amdgcn_s_sleep(1); \
    if ((++_sp & 255u) == 0u) { if (xb_ld(&(bar)[XB_TMO])) break; if (_sp > XB_SPIN_CAP) { atomicAdd(&(bar)[XB_TMO], 1u); break; } } } } while (0)

struct XcdBarrier {
    unsigned* bar; unsigned x;
    volatile LAS unsigned* st;
};

__device__ __forceinline__ XcdBarrier xcd_barrier_post(unsigned* bar, volatile LAS unsigned* st) {
    XcdBarrier b; b.bar = bar; b.x = xb_xcc_id(); b.st = st;
    if (threadIdx.x == 0) (void)xb_add(&bar[XB_XCNT(b.x)], 1u);
    return b;
}
__device__ __forceinline__ void xcd_barrier_complete(unsigned* bar, unsigned x, unsigned& nloc, unsigned& nx) {
    const unsigned G = gridDim.x * gridDim.y * gridDim.z;
    unsigned sum, cnt, mine, sp = 0u;
    for (;;) {
        sum = 0u; cnt = 0u; mine = 0u;
#pragma unroll
        for (unsigned j = 0; j < 16; ++j) { const unsigned c = xb_ld(&bar[XB_XCNT(j)]); sum += c; cnt += (c > 0u) ? 1u : 0u; mine = (j == x) ? c : mine; }
        if (sum == G) break;
        __builtin_amdgcn_s_sleep(1);
        if ((++sp & 255u) == 0u) { if (xb_ld(&bar[XB_TMO])) break; if (sp > XB_SPIN_CAP) { atomicAdd(&bar[XB_TMO], 1u); break; } }
    }
    nloc = mine > 0u ? mine : 1u; nx = cnt > 0u ? cnt : 1u;
}

__device__ __forceinline__ void xcd_barrier(const XcdBarrier& b) {
    asm volatile("s_waitcnt vmcnt(0)" ::: "memory");
    __syncthreads();
    if (threadIdx.x == 0) {
        unsigned* bar = b.bar;
        __builtin_amdgcn_s_waitcnt(0);
        unsigned nloc = b.st[0], nx = b.st[1];
        if (nloc == 0u) { xcd_barrier_complete(bar, b.x, nloc, nx); b.st[0] = nloc; b.st[1] = nx; }
        const unsigned old = xb_add(&bar[XB_XSUB(b.x)], 1u);
        const unsigned gen = old / nloc;
        if (old + 1u == (gen + 1u) * nloc) {
            __builtin_amdgcn_fence(__ATOMIC_RELEASE, "agent");
            asm volatile("s_waitcnt vmcnt(0)" ::: "memory");
            const unsigned og = xb_add(&bar[XB_TOP], 1u);
            const unsigned tg = og / nx;
            if (og + 1u == (tg + 1u) * nx) xb_add(&bar[XB_TOPGEN], 1u);
            else XB_SPIN(xb_ld(&bar[XB_TOPGEN]) == tg, bar);
            __builtin_amdgcn_fence(__ATOMIC_ACQUIRE, "agent");
            xb_add(&bar[XB_XGEN(b.x)], 1u);
            asm volatile("s_waitcnt vmcnt(0)" ::: "memory");
        } else {
            XB_SPIN(xb_ld(&bar[XB_XGEN(b.x)]) == gen, bar);
            __builtin_amdgcn_fence(__ATOMIC_ACQUIRE, "agent");
            asm volatile("s_waitcnt vmcnt(0)" ::: "memory");
        }
    }
    __syncthreads();
}

typedef f32x4 AccT[2][2][4][2];
struct EpiProj {
    bf16_t *Q, *KB, *CB, *CC, *CX; const float* rstd1;
    __device__ __forceinline__ void operator()(const AccT& acc, const pg8::Unit& u, int wr, int wc, int fr, int fq) const {
        const int sec = u.pn >> 1, row0 = u.pm * 256 + wr * 64 + fr, col0 = (u.pn & 1) * 256 + wc * 32 + 8 * fq;
        bf16_t* base = sec == 0 ? Q : sec == 1 ? KB : sec == 2 ? CB : sec == 3 ? CC : CX;
        const int radd = (sec == 1) ? 64 * ((u.pm >> 4) + 1) : 0;
        const float sc0 = (sec == 0) ? QSCALE : 1.0f;
#pragma unroll
        for (int ai = 0; ai < 2; ++ai)
#pragma unroll
            for (int m = 0; m < 4; ++m) { const int r = row0 + ai * 128 + m * 16; const float sc = ld_f(rstd1 + r) * sc0;
                bf16_t* rowp = base + (size_t)(r + radd) * 512 + col0;
#pragma unroll
                for (int bj = 0; bj < 2; ++bj) { const f32x4 v0 = acc[ai][bj][m][0] * sc, v1 = acc[ai][bj][m][1] * sc;
                    u32x4 w; w.x = cvtpk(v0[0], v0[1]); w.y = cvtpk(v0[2], v0[3]); w.z = cvtpk(v1[0], v1[1]); w.w = cvtpk(v1[2], v1[3]);
                    *(u32x4*)(rowp + bj * 128) = w; } }
    }
};
struct EpiVt {
    bf16_t* VT; const float* rstd1;
    __device__ __forceinline__ void operator()(const AccT& acc, const pg8::Unit& u, int wr, int wc, int fr, int fq) const {
        const int row0 = u.pm * 256 + wr * 64 + fr, col0 = u.pn * 256 + wc * 32 + 8 * fq;
        f32x4 rs[2][2];
#pragma unroll
        for (int bj = 0; bj < 2; ++bj)
#pragma unroll
            for (int n = 0; n < 2; ++n)
#pragma unroll
                for (int i = 0; i < 4; ++i) rs[bj][n][i] = ld_f(rstd1 + col0 + bj * 128 + 4 * n + i);
        const int dcol0 = col0 + 64 * ((u.pn >> 4) + 1);
#pragma unroll
        for (int ai = 0; ai < 2; ++ai)
#pragma unroll
            for (int m = 0; m < 4; ++m) { bf16_t* rowp = VT + (size_t)(row0 + ai * 128 + m * 16) * (size_t)(NB * TPAD) + dcol0;
#pragma unroll
                for (int bj = 0; bj < 2; ++bj) { const f32x4 v0 = acc[ai][bj][m][0] * rs[bj][0], v1 = acc[ai][bj][m][1] * rs[bj][1];
                    u32x4 w; w.x = cvtpk(v0[0], v0[1]); w.y = cvtpk(v0[2], v0[3]); w.z = cvtpk(v1[0], v1[1]); w.w = cvtpk(v1[2], v1[3]);
                    *(u32x4*)(rowp + bj * 128) = w; } }
    }
};
struct EpiOut {
    const float* x; float* h1; bf16_t* A2; unsigned char* A8; float* ssp; const float* gffn;
    __device__ __forceinline__ void operator()(const AccT& acc, const pg8::Unit& u, int wr, int wc, int fr, int fq) const {
        const int row0 = u.pm * 256 + wr * 64 + fr, col0 = u.pn * 256 + wc * 32 + 8 * fq;
        f32x4 g[2][2];
#pragma unroll
        for (int bj = 0; bj < 2; ++bj)
#pragma unroll
            for (int n = 0; n < 2; ++n) g[bj][n] = *(const f32x4*)(gffn + col0 + bj * 128 + 4 * n);
#pragma unroll
        for (int ai = 0; ai < 2; ++ai)
#pragma unroll
            for (int m = 0; m < 4; ++m) { const int r = row0 + ai * 128 + m * 16; const size_t ro = (size_t)r * DM + col0; float ss = 0.f;
#pragma unroll
                for (int bj = 0; bj < 2; ++bj) {
                    const f32x4 v0 = acc[ai][bj][m][0] + *(const f32x4*)(x + ro + bj * 128), v1 = acc[ai][bj][m][1] + *(const f32x4*)(x + ro + bj * 128 + 4);
                    *(f32x4*)(h1 + ro + bj * 128) = v0; *(f32x4*)(h1 + ro + bj * 128 + 4) = v1;
                    ss += (v0[0] * v0[0] + v0[1] * v0[1]) + (v0[2] * v0[2] + v0[3] * v0[3]) + (v1[0] * v1[0] + v1[1] * v1[1]) + (v1[2] * v1[2] + v1[3] * v1[3]);
                    const f32x4 a0 = v0 * g[bj][0], a1 = v1 * g[bj][1];
                    u32x4 w; w.x = cvtpk(a0[0], a0[1]); w.y = cvtpk(a0[2], a0[3]); w.z = cvtpk(a1[0], a1[1]); w.w = cvtpk(a1[2], a1[3]);
                    *(u32x4*)(A2 + ro + bj * 128) = w;
                    u32x2 w8; w8.x = pk4_fp8(a0[0], a0[1], a0[2], a0[3]); w8.y = pk4_fp8(a1[0], a1[1], a1[2], a1[3]);
                    *(u32x2*)(A8 + ro + bj * 128) = w8; }
                ss += __shfl_xor(ss, 16); ss += __shfl_xor(ss, 32);
                if (fq == 0) ssp[(size_t)r * 16 + u.pn * 4 + wc] = ss; }
    }
};
struct EpiGU {
    unsigned char* hid; const float* bgu; const float* slot_rstd;
    __device__ __forceinline__ void operator()(const AccT& acc, const pg8::Unit& u, int wr, int wc, int fr, int fq) const {
        const int row0 = u.pm * 256 + wr * 64 + fr, colr = u.pn * 128 + wc * 32 + 8 * fq;
        const float* bg = bgu + (size_t)u.e * 2048 + colr;
        const f32x4 bg0 = *(const f32x4*)(bg), bg1 = *(const f32x4*)(bg + 4), bl0 = *(const f32x4*)(bg + 1024), bl1 = *(const f32x4*)(bg + 1028);
#pragma unroll
        for (int ai = 0; ai < 2; ++ai)
#pragma unroll
            for (int m = 0; m < 4; ++m) { const int r = row0 + ai * 128 + m * 16; const float rs = ld_f(slot_rstd + r) * WINV;
                float hv[8];
#pragma unroll
                for (int n = 0; n < 2; ++n)
#pragma unroll
                    for (int i = 0; i < 4; ++i) {
                        float gt = acc[ai][0][m][n][i] * rs + (n ? bg1[i] : bg0[i]), ln = acc[ai][1][m][n][i] * rs + (n ? bl1[i] : bl0[i]);
                        gt = fminf(gt, 7.0f); ln = fminf(fmaxf(ln, -7.0f), 7.0f);
                        const float sg = __builtin_amdgcn_rcpf(1.0f + ex2(gt * (-1.702f * LOG2E)));
                        hv[n * 4 + i] = (ln + 1.0f) * (gt * sg); }
                u32x2 w; w.x = pk4_fp8(hv[0], hv[1], hv[2], hv[3]); w.y = pk4_fp8(hv[4], hv[5], hv[6], hv[7]);
                *(u32x2*)(hid + (size_t)r * FF + colr) = w; }
    }
};
struct EpiDown {
    bf16_t* ys; const float* bd; const float* slot_gate;
    __device__ __forceinline__ void operator()(const AccT& acc, const pg8::Unit& u, int wr, int wc, int fr, int fq) const {
        const int row0 = u.pm * 256 + wr * 64 + fr, col0 = u.pn * 256 + wc * 32 + 8 * fq;
        f32x4 bv[2][2];
#pragma unroll
        for (int bj = 0; bj < 2; ++bj)
#pragma unroll
            for (int n = 0; n < 2; ++n) bv[bj][n] = *(const f32x4*)(bd + (size_t)u.e * DM + col0 + bj * 128 + 4 * n);
#pragma unroll
        for (int ai = 0; ai < 2; ++ai)
#pragma unroll
            for (int m = 0; m < 4; ++m) { const int r = row0 + ai * 128 + m * 16; const float gt = ld_f(slot_gate + r);
                bf16_t* rowp = ys + (size_t)r * DM + col0;
#pragma unroll
                for (int bj = 0; bj < 2; ++bj) { const f32x4 v0 = (acc[ai][bj][m][0] * WINV + bv[bj][0]) * gt, v1 = (acc[ai][bj][m][1] * WINV + bv[bj][1]) * gt;
                    u32x4 w; w.x = cvtpk(v0[0], v0[1]); w.y = cvtpk(v0[2], v0[3]); w.z = cvtpk(v1[0], v1[1]); w.w = cvtpk(v1[2], v1[3]);
                    *(u32x4*)(rowp + bj * 128) = w; } }
    }
};

struct Args { const float* in[17]; float* out; unsigned char* ws; int ph_lo, ph_hi; };
struct Frame {
    LAS unsigned char* lds; gu32* ctl; int tid, lane, wave, vcu, G;
    const float *x, *meta, *g_mix, *w_in, *g_attn, *conv_w, *conv_b, *g_conv, *w_out, *g_ffn, *w_router, *b_router, *w_gu, *b_gu, *w_down, *b_down, *g_final;
    float* out; unsigned char* ws;
};
template <class T> __device__ __forceinline__ T* wsp(const Frame& F, size_t off) { return (T*)(F.ws + off); }

__device__ __forceinline__ void p0_transpose_item(const float* W, int ldw, int k0, int n0, bf16_t* WT, int Kd, int drow0, LAS unsigned* scr, int lane) {
    const int ks = lane >> 4, n4 = lane & 15;
    f32x4 va[8], vb[8];
    const float* src = W + (size_t)(k0 + 2 * ks) * ldw + n0 + 4 * n4;
#pragma unroll
    for (int i = 0; i < 8; ++i) { va[i] = *(const f32x4*)(src + (size_t)(8 * i) * ldw); vb[i] = *(const f32x4*)(src + (size_t)(8 * i + 1) * ldw); }
#pragma unroll
    for (int i = 0; i < 8; ++i)
#pragma unroll
        for (int j = 0; j < 4; ++j) scr[(4 * n4 + j) * 33 + 4 * i + ks] = cvtpk(va[i][j], vb[i][j]);
    LDS_WAIT(); asm volatile("" ::: "memory");
    const int ns = lane >> 3, c = lane & 7;
#pragma unroll
    for (int r = 0; r < 8; ++r) { const int n = 8 * r + ns; const LAS unsigned* t = scr + n * 33 + 4 * c;
        u32x4 o; o.x = t[0]; o.y = t[1]; o.z = t[2]; o.w = t[3];
        *(u32x4*)(WT + (size_t)(drow0 + n) * Kd + k0 + 8 * c) = o; }
    LDS_WAIT(); asm volatile("" ::: "memory");
}
__device__ __forceinline__ void p0_transpose_item8(const float* W, int ldw, int k0, int n0, unsigned char* WT8, int Kd, int drow0, LAS unsigned* scr, int lane) {
    const int ks = lane >> 4, n4 = lane & 15;
#pragma unroll
    for (int h = 0; h < 2; ++h) {
        f32x4 v[4][4];
        const float* src = W + (size_t)(k0 + 64 * h + 4 * ks) * ldw + n0 + 4 * n4;
#pragma unroll
        for (int i = 0; i < 4; ++i)
#pragma unroll
            for (int q = 0; q < 4; ++q) v[i][q] = *(const f32x4*)(src + (size_t)(16 * i + q) * ldw);
#pragma unroll
        for (int i = 0; i < 4; ++i)
#pragma unroll
            for (int j = 0; j < 4; ++j) scr[(4 * n4 + j) * 33 + 16 * h + 4 * i + ks] = pk4_fp8(v[i][0][j] * WSCALE, v[i][1][j] * WSCALE, v[i][2][j] * WSCALE, v[i][3][j] * WSCALE);
    }
    LDS_WAIT(); asm volatile("" ::: "memory");
    const int ns = lane >> 3, c = lane & 7;
#pragma unroll
    for (int r = 0; r < 8; ++r) { const int n = 8 * r + ns; const LAS unsigned* t = scr + n * 33 + 4 * c;
        u32x4 o; o.x = t[0]; o.y = t[1]; o.z = t[2]; o.w = t[3];
        *(u32x4*)(WT8 + (size_t)(drow0 + n) * Kd + k0 + 16 * c) = o; }
    LDS_WAIT(); asm volatile("" ::: "memory");
}
__device__ __forceinline__ void p0_meta_job(Frame& F, int mw) {
    LAS float* nm = (LAS float*)F.lds;
    LAS float* part = (LAS float*)(F.lds + 65536);
    for (int t = F.wave * 2; t < F.wave * 2 + 2; ++t) {
        float v[16]; float ss = 0.f;
#pragma unroll
        for (int j = 0; j < 16; ++j) { v[j] = F.meta[t * DM + j * 64 + F.lane]; ss += v[j] * v[j]; }
        const float rstd = 1.0f / sqrtf(wave_sum(ss) * (1.0f / DM) + RMS_EPS);
#pragma unroll
        for (int j = 0; j < 16; ++j) { const int k = j * 64 + F.lane; nm[k * 16 + t] = v[j] * rstd * F.g_mix[k]; }
    }
    __syncthreads();
    const int kq = F.tid >> 7, c = F.tid & 127, j = mw * 128 + c, sec4 = j >> 9, jc = j & 511;
    const int ocol = (sec4 == 0 ? 512 : sec4 == 1 ? 1024 : sec4 == 2 ? 2048 : 2560) + jc;
    float acc[16];
#pragma unroll
    for (int t = 0; t < 16; ++t) acc[t] = 0.f;
    for (int kk = kq * 256; kk < kq * 256 + 256; kk += 16) {
        float wv[16];
#pragma unroll
        for (int u = 0; u < 16; ++u) wv[u] = F.w_in[(size_t)(kk + u) * 3072 + ocol];
#pragma unroll
        for (int u = 0; u < 16; ++u) { const float w = wv[u];
            const LAS f32x4* nv = (const LAS f32x4*)(nm + (kk + u) * 16);
#pragma unroll
            for (int q = 0; q < 4; ++q) { const f32x4 n4 = nv[q]; acc[4 * q] += w * n4[0]; acc[4 * q + 1] += w * n4[1]; acc[4 * q + 2] += w * n4[2]; acc[4 * q + 3] += w * n4[3]; } }
    }
#pragma unroll
    for (int t = 0; t < 16; ++t) part[(kq * 128 + c) * 16 + t] = acc[t];
    __syncthreads();
    {
        const int tq = F.tid >> 7;
        bf16_t* KB = wsp<bf16_t>(F, WS_KB); bf16_t* VT = wsp<bf16_t>(F, WS_VT); float* MT = wsp<float>(F, WS_META);
#pragma unroll
        for (int tt = 0; tt < 4; ++tt) { const int t = 4 * tq + tt;
            const float v = (part[(0 * 128 + c) * 16 + t] + part[(1 * 128 + c) * 16 + t]) + (part[(2 * 128 + c) * 16 + t] + part[(3 * 128 + c) * 16 + t]);
            const bf16_t bv = (bf16_t)(cvtpk(v, 0.f) & 0xffffu);
            if (sec4 == 0) { for (int b = 0; b < NB; ++b) KB[(size_t)(b * TPAD + KPAD + t) * 512 + jc] = bv; }
            else if (sec4 == 1) { for (int b = 0; b < NB; ++b) VT[(size_t)jc * (NB * TPAD) + b * TPAD + KPAD + t] = bv; }
            else if (t >= 14) MT[((sec4 - 2) * 2 + (t - 14)) * 512 + jc] = v;
        }
    }
    __syncthreads();
}
__device__ __forceinline__ void p0_prologue(Frame& F) {
    constexpr int NMW = 16;
    if (F.vcu < NMW) {
        p0_meta_job(F, F.vcu);
        bf16_t* KB = wsp<bf16_t>(F, WS_KB); bf16_t* VT = wsp<bf16_t>(F, WS_VT);
        const int gt = F.vcu * 512 + F.tid, NT = NMW * 512;
        for (int i = gt; i < NB * KPAD * 64; i += NT) { const int b = i / (KPAD * 64), r = i % (KPAD * 64); *(u32x4*)(KB + (size_t)(b * TPAD) * 512 + (size_t)r * 8) = (u32x4){0u, 0u, 0u, 0u}; }
        for (int i = gt; i < 512 * NB * 6; i += NT) { const int ch = i / (NB * 6), r = i % (NB * 6), b = r / 6, q = r % 6; *(u32x4*)(VT + (size_t)ch * (NB * TPAD) + b * TPAD + q * 8) = (u32x4){0u, 0u, 0u, 0u}; }
        return;
    }
    const int gw = (F.vcu - NMW) * NWAVES + F.wave, NGW = (F.G - NMW) * NWAVES;
    {
        float* rstd1 = wsp<float>(F, WS_RSTD1); bf16_t* A1 = wsp<bf16_t>(F, WS_A);
        f32x4 g4[4];
#pragma unroll
        for (int j = 0; j < 4; ++j) g4[j] = *(const f32x4*)(F.g_mix + 256 * j + 4 * F.lane);
        for (int m = gw; m < NTOK; m += NGW) {
            const f32x4* xr = (const f32x4*)(F.x + (size_t)m * DM) + F.lane;
            f32x4 v[4]; float s = 0.f;
#pragma unroll
            for (int j = 0; j < 4; ++j) { v[j] = xr[64 * j]; s += (v[j][0] * v[j][0] + v[j][1] * v[j][1]) + (v[j][2] * v[j][2] + v[j][3] * v[j][3]); }
            s = wave_sum(s);
            if (F.lane == 0) rstd1[m] = 1.0f / sqrtf(s * (1.0f / DM) + RMS_EPS);
            u32x2* o8 = (u32x2*)(A1 + (size_t)m * DM) + F.lane;
#pragma unroll
            for (int j = 0; j < 4; ++j) { const f32x4 a = v[j] * g4[j]; u32x2 o; o.x = cvtpk(a[0], a[1]); o.y = cvtpk(a[2], a[3]); o8[64 * j] = o; }
        }
    }
    {
        LAS unsigned* scr = (LAS unsigned*)(F.lds + F.wave * 8704);
        constexpr int I_IN = 16 * 48, I_OUT = 16 * 16, I_GU = 32 * 8 * 32, I_D = 32 * 8 * 16, NITEMS = I_IN + I_OUT + I_GU + I_D;
        bf16_t* WIN = wsp<bf16_t>(F, WS_WIN); bf16_t* WOUT = wsp<bf16_t>(F, WS_WOUT); unsigned char* WGU = wsp<unsigned char>(F, WS_WGU); unsigned char* WD = wsp<unsigned char>(F, WS_WD);
        for (int it = gw; it < NITEMS; it += NGW) {
            int r = it;
            if (r < I_IN) { const int kb = r / 48, nb = r % 48, n0 = 64 * nb, sec = n0 >> 9;
                const int dsec = sec == 0 ? 0 : sec == 1 ? 1 : sec == 2 ? 5 : sec - 1;
                p0_transpose_item(F.w_in, 3072, 64 * kb, n0, WIN, DM, dsec * 512 + (n0 & 511), scr, F.lane); continue; }
            r -= I_IN;
            if (r < I_OUT) { const int kb = r / 16, nb = r % 16; p0_transpose_item(F.w_out, 1024, 64 * kb, 64 * nb, WOUT, DM, 64 * nb, scr, F.lane); continue; }
            r -= I_OUT;
            if (r < I_GU) { const int e = r / 256, q = r % 256, kb = q / 32, nb = q % 32, n0 = 64 * nb, c = n0 & 1023;
                const int drow = (c >> 7) * 256 + (n0 >= 1024 ? 128 : 0) + (c & 127);
                p0_transpose_item8(F.w_gu + (size_t)e * 1024 * 2048, 2048, 128 * kb, n0, WGU + (size_t)e * 2048 * 1024, DM, drow, scr, F.lane); continue; }
            r -= I_GU;
            { const int e = r / 128, q = r % 128, kb = q / 16, nb = q % 16;
                p0_transpose_item8(F.w_down + (size_t)e * 1024 * 1024, 1024, 128 * kb, 64 * nb, WD + (size_t)e * 1024 * 1024, FF, 64 * nb, scr, F.lane); }
        }
    }
}

template <bool EDGE>
__device__ __forceinline__ void sb_tile(f32x16& s0, f32x16& s1, float& carry, int kp0  , int qpos, bool hi0, bf16x8 (&pf)[2][2]) {
    float R[4];
#pragma unroll
    for (int q = 0; q < 4; ++q) {
        float S = 0.f;
#pragma unroll
        for (int i = 7; i >= 0; --i) {
            const int r = (q & 1) * 8 + i;
            const float z = (q < 2) ? s0[r] : s1[r];
            const float L = lg2(1.0f + ex2(-fabsf(z)));
            float sp = fmaxf(z, 0.f) + L; float ls = z - sp;
            if (EDGE) { const int kp = kp0 + 16 * q + i; const bool valid = (kp < qpos) && (kp >= KPAD); sp = valid ? sp : 0.f; ls = valid ? ls : -INFINITY; }
            const float m = ls - S; S += sp;
            if (q < 2) s0[r] = m; else s1[r] = m;
        }
        R[q] = S;
        __builtin_amdgcn_sched_barrier(0);
    }
    const float P0 = __shfl_xor(R[0], 32), P1 = __shfl_xor(R[1], 32), P2 = __shfl_xor(R[2], 32), P3 = __shfl_xor(R[3], 32);
    const float T0 = R[0] + P0, T1 = R[1] + P1, T2 = R[2] + P2, T3 = R[3] + P3;
    const float b3 = carry - (hi0 ? P3 : 0.f), b2 = carry - (T3 + (hi0 ? P2 : 0.f)), b1 = carry - ((T3 + T2) + (hi0 ? P1 : 0.f)), b0 = carry - ((T3 + T2 + T1) + (hi0 ? P0 : 0.f));
#pragma unroll
    for (int i = 0; i < 8; ++i) { s0[i] = ex2(s0[i] + b0); s0[8 + i] = ex2(s0[8 + i] + b1); s1[i] = ex2(s1[i] + b2); s1[8 + i] = ex2(s1[8 + i] + b3); }
    carry -= (T0 + T1) + (T2 + T3);
    u32x4 w;
    w.x = cvtpk(s0[0], s0[1]); w.y = cvtpk(s0[2], s0[3]); w.z = cvtpk(s0[4], s0[5]); w.w = cvtpk(s0[6], s0[7]); pf[0][0] = __builtin_bit_cast(bf16x8, w);
    w.x = cvtpk(s0[8], s0[9]); w.y = cvtpk(s0[10], s0[11]); w.z = cvtpk(s0[12], s0[13]); w.w = cvtpk(s0[14], s0[15]); pf[0][1] = __builtin_bit_cast(bf16x8, w);
    w.x = cvtpk(s1[0], s1[1]); w.y = cvtpk(s1[2], s1[3]); w.z = cvtpk(s1[4], s1[5]); w.w = cvtpk(s1[6], s1[7]); pf[1][0] = __builtin_bit_cast(bf16x8, w);
    w.x = cvtpk(s1[8], s1[9]); w.y = cvtpk(s1[10], s1[11]); w.z = cvtpk(s1[12], s1[13]); w.w = cvtpk(s1[14], s1[15]); pf[1][1] = __builtin_bit_cast(bf16x8, w);
}
#define MFMA32(a, b, c) __builtin_amdgcn_mfma_f32_32x32x16_bf16((a), (b), (c), 0, 0, 0)
__device__ __forceinline__ void p2_unit(Frame& F, int b, int qb) {
    int lane_ = F.lane, head_ = F.wave;
    asm volatile("" : "+v"(lane_), "+s"(head_));
    const int lane = lane_, head = head_, l31 = lane & 31, hi = lane >> 5; const bool hi0 = hi == 0;
    const bf16_t* Q = wsp<bf16_t>(F, WS_Q); const bf16_t* KB = wsp<bf16_t>(F, WS_KB); const bf16_t* VT = wsp<bf16_t>(F, WS_VT);
    bf16_t* MX = wsp<bf16_t>(F, WS_MIXED);
    LAS float* ssA = (LAS float*)F.lds;
    LAS float* ssC = (LAS float*)(F.lds + 1024);
    const int row0 = b * SEQ + qb * 32;
#ifndef P2_SKIP_CONV
    {
        const int cgp = lane & 7, rg = lane >> 3, ch0 = head * 64 + cgp * 8;
        const bf16_t* CB = wsp<bf16_t>(F, WS_CB); const bf16_t* CC = wsp<bf16_t>(F, WS_CC); const bf16_t* CX = wsp<bf16_t>(F, WS_CX); const float* MT = wsp<float>(F, WS_META);
        float cv[4][8];
        {
            float w0[8], w1[8], w2[8], bs[8], u2[8], u1[8];
#pragma unroll
            for (int k = 0; k < 8; ++k) { w0[k] = F.conv_w[ch0 + k]; w1[k] = F.conv_w[512 + ch0 + k]; w2[k] = F.conv_w[1024 + ch0 + k]; bs[k] = F.conv_b[ch0 + k]; u2[k] = 0.f; u1[k] = 0.f; }
#pragma unroll
            for (int i = -2; i < 4; ++i) {
                const int sl = qb * 32 + rg * 4 + i;
                float u[8];
                if (sl >= 0) {
                    const size_t ro = (size_t)(b * SEQ + sl) * 512 + ch0;
                    const u32x4 c4 = *(const u32x4*)(CC + ro), x4 = *(const u32x4*)(CX + ro);
                    u[0] = bflo(c4.x) * bflo(x4.x); u[1] = bfhi(c4.x) * bfhi(x4.x); u[2] = bflo(c4.y) * bflo(x4.y); u[3] = bfhi(c4.y) * bfhi(x4.y);
                    u[4] = bflo(c4.z) * bflo(x4.z); u[5] = bfhi(c4.z) * bfhi(x4.z); u[6] = bflo(c4.w) * bflo(x4.w); u[7] = bfhi(c4.w) * bfhi(x4.w);
                } else {
                    const int mt = 2 + sl;
                    const f32x4 c0 = *(const f32x4*)(MT + mt * 512 + ch0), c1 = *(const f32x4*)(MT + mt * 512 + ch0 + 4), x0 = *(const f32x4*)(MT + (2 + mt) * 512 + ch0), x1 = *(const f32x4*)(MT + (2 + mt) * 512 + ch0 + 4);
#pragma unroll
                    for (int k = 0; k < 4; ++k) { u[k] = c0[k] * x0[k]; u[4 + k] = c1[k] * x1[k]; }
                }
                if (i >= 0) {
                    const u32x4 b4 = *(const u32x4*)(CB + (size_t)(b * SEQ + sl) * 512 + ch0);
                    const float cbv[8] = {bflo(b4.x), bfhi(b4.x), bflo(b4.y), bfhi(b4.y), bflo(b4.z), bfhi(b4.z), bflo(b4.w), bfhi(b4.w)};
#pragma unroll
                    for (int k = 0; k < 8; ++k) cv[i < 0 ? 0 : i][k] = cbv[k] * (w0[k] * u2[k] + w1[k] * u1[k] + w2[k] * u[k] + bs[k]);
                }
#pragma unroll
                for (int k = 0; k < 8; ++k) { u2[k] = u1[k]; u1[k] = u[k]; }
            }
        }
#pragma unroll
        for (int i = 0; i < 4; ++i) { float ss = 0.f;
#pragma unroll
            for (int k = 0; k < 8; ++k) ss += cv[i][k] * cv[i][k];
            ss += __shfl_xor(ss, 1); ss += __shfl_xor(ss, 2); ss += __shfl_xor(ss, 4);
            if (cgp == 0) ssC[head * 32 + rg * 4 + i] = ss; }
        __syncthreads();
        const f32x4 gc0 = *(const f32x4*)(F.g_conv + ch0), gc1 = *(const f32x4*)(F.g_conv + ch0 + 4);
#pragma unroll
        for (int i = 0; i < 4; ++i) { const int rl = rg * 4 + i; float tot = 0.f;
#pragma unroll
            for (int w = 0; w < 8; ++w) tot += ssC[w * 32 + rl];
            const float rstd = 1.0f / sqrtf(tot * (1.0f / AW) + RMS_EPS);
            u32x4 w4; w4.x = cvtpk(cv[i][0] * rstd * gc0[0], cv[i][1] * rstd * gc0[1]); w4.y = cvtpk(cv[i][2] * rstd * gc0[2], cv[i][3] * rstd * gc0[3]);
            w4.z = cvtpk(cv[i][4] * rstd * gc1[0], cv[i][5] * rstd * gc1[1]); w4.w = cvtpk(cv[i][6] * rstd * gc1[2], cv[i][7] * rstd * gc1[3]);
            *(u32x4*)(MX + (size_t)(row0 + rl) * DM + 512 + ch0) = w4; }
    }
#endif
#ifndef P2_SKIP_ATT
    LAS bf16x8* qlds = (LAS bf16x8*)(F.lds + 4096 + head * 4096) + lane;
    {
        const bf16_t* Qp = Q + (size_t)(row0 + l31) * 512 + head * 64 + hi * 8;
#pragma unroll
        for (int s = 0; s < 4; ++s) qlds[s * 64] = *(const bf16x8*)(Qp + s * 16);
    }
    f32x16 o[2];
#pragma unroll
    for (int d = 0; d < 2; ++d)
#pragma unroll
        for (int r = 0; r < 16; ++r) o[d][r] = 0.f;
    float carry = 0.f;
    const int pi = (l31 & 0x13) | ((l31 & 4) << 1) | ((l31 & 8) >> 1);
    const __amdgpu_buffer_rsrc_t rsK = __builtin_amdgcn_make_buffer_rsrc((void*)(KB + (size_t)b * TPAD * 512), (short)0, TPAD * 512 * 2, 0x00020000);
    const __amdgpu_buffer_rsrc_t rsV = __builtin_amdgcn_make_buffer_rsrc((void*)(VT + (size_t)b * TPAD), (short)0, (511 * NB * TPAD + TPAD) * 2, 0x00020000);
    const int voffK = (pi * 512 + head * 64 + hi * 8) * 2;
    const int voffV = ((head * 64 + l31) * (NB * TPAD) + hi * 8) * 2;
    const int P0 = QOFF + 32 * qb, qpos = P0 + l31;
    for (int start = P0 - 32; ; start -= 64) {
        bf16x8 kf[2][4];
#pragma unroll
        for (int kb = 0; kb < 2; ++kb)
#pragma unroll
            for (int s = 0; s < 4; ++s) kf[kb][s] = __builtin_bit_cast(bf16x8, __builtin_amdgcn_raw_buffer_load_b128(rsK, voffK + kb * 32768 + s * 32, start * 1024, 0));
        bf16x8 vf[2][2][2];
#pragma unroll
        for (int d = 0; d < 2; ++d)
#pragma unroll
            for (int kb = 0; kb < 2; ++kb)
#pragma unroll
                for (int s2 = 0; s2 < 2; ++s2) vf[d][kb][s2] = __builtin_bit_cast(bf16x8, __builtin_amdgcn_raw_buffer_load_b128(rsV, voffV + d * (32 * NB * TPAD * 2) + kb * 64 + s2 * 32, start * 2, 0));
        const bool lastt = start <= KPAD;
        const bool edge = (start == P0 - 32) || lastt;
        f32x16 s0, s1;
#pragma unroll
        for (int r = 0; r < 16; ++r) { s0[r] = 0.f; s1[r] = 0.f; }
#pragma unroll
        for (int s = 0; s < 4; ++s) { const bf16x8 qf = qlds[s * 64]; s0 = MFMA32(kf[0][s], qf, s0); s1 = MFMA32(kf[1][s], qf, s1); }
        bf16x8 pf[2][2];
        if (edge) sb_tile<true>(s0, s1, carry, start + 8 * hi, qpos, hi0, pf);
        else sb_tile<false>(s0, s1, carry, start + 8 * hi, qpos, hi0, pf);
#pragma unroll
        for (int d = 0; d < 2; ++d)
#pragma unroll
            for (int kb = 0; kb < 2; ++kb)
#pragma unroll
                for (int s2 = 0; s2 < 2; ++s2) o[d] = MFMA32(vf[d][kb][s2], pf[kb][s2], o[d]);
        if (lastt || __all(carry < EXIT_THR)) break;
    }
    int lane2 = lane; asm volatile("" : "+v"(lane2));
    const int l31b = lane2 & 31, hib = lane2 >> 5;
    {
        float ss = 0.f;
#pragma unroll
        for (int d = 0; d < 2; ++d)
#pragma unroll
            for (int r = 0; r < 16; ++r) ss += o[d][r] * o[d][r];
        ss += __shfl_xor(ss, 32);
        if (hib == 0) ssA[head * 32 + l31b] = ss;
    }
    __syncthreads();
    {
        float tot = 0.f;
#pragma unroll
        for (int h = 0; h < 8; ++h) tot += ssA[h * 32 + l31b];
        const float rstd = 1.0f / sqrtf(tot * (1.0f / AW) + RMS_EPS);
        bf16_t* orow = MX + (size_t)(row0 + l31b) * DM + head * 64 + 4 * hib;
#pragma unroll
        for (int d = 0; d < 2; ++d)
#pragma unroll
            for (int g = 0; g < 4; ++g) { const f32x4 ga = *(const f32x4*)(F.g_attn + head * 64 + 32 * d + 8 * g + 4 * hib);
                u32x2 w; w.x = cvtpk(o[d][4 * g] * rstd * ga[0], o[d][4 * g + 1] * rstd * ga[1]); w.y = cvtpk(o[d][4 * g + 2] * rstd * ga[2], o[d][4 * g + 3] * rstd * ga[3]);
                *(u32x2*)(orow + 32 * d + 8 * g) = w; }
    }
    __syncthreads();
#endif
}

__device__ __forceinline__ void p4_router(Frame& F) {
    LAS unsigned char* img = F.lds;
    LAS int* hist = (LAS int*)(F.lds + 65536);
    for (int idx = F.tid; idx < 64 * 2 * 32; idx += 512) { const int s = idx >> 6, h = (idx >> 5) & 1, e = idx & 31; const float* wp = F.w_router + (size_t)(16 * s + 8 * h) * NE + e;
        u32x4 w; w.x = cvtpk(wp[0], wp[NE]); w.y = cvtpk(wp[2 * NE], wp[3 * NE]); w.z = cvtpk(wp[4 * NE], wp[5 * NE]); w.w = cvtpk(wp[6 * NE], wp[7 * NE]);
        *(LAS u32x4*)(img + idx * 16) = w; }
    if (F.tid < 32) hist[F.tid] = 0;
    __syncthreads();
    const bf16_t* A2 = wsp<bf16_t>(F, WS_A); const float* ssp = wsp<float>(F, WS_SSP); float* rstd2 = wsp<float>(F, WS_RSTD2);
    int* tope = wsp<int>(F, WS_TOPE); float* gate = wsp<float>(F, WS_GATE); int* cnt = wsp<int>(F, WS_CNT);
    const int wg = F.vcu;
    if (F.wave < 4) {
        const int l31 = F.lane & 31, hi = F.lane >> 5, row = wg * 128 + F.wave * 32 + l31;
        f32x16 acc;
#pragma unroll
        for (int r = 0; r < 16; ++r) acc[r] = 0.f;
        const bf16_t* ap = A2 + (size_t)row * DM + 8 * hi;
#pragma unroll 8
        for (int s = 0; s < 64; ++s) { const bf16x8 a = *(const LAS bf16x8*)(img + ((s * 2 + hi) * 32 + l31) * 16); const bf16x8 bq = *(const bf16x8*)(ap + 16 * s); acc = MFMA32(a, bq, acc); }
        float ss = 0.f;
#pragma unroll
        for (int q = 0; q < 4; ++q) { const f32x4 p4 = *(const f32x4*)(ssp + (size_t)row * 16 + 4 * q); ss += (p4[0] + p4[1]) + (p4[2] + p4[3]); }
        const float rstd = 1.0f / sqrtf(ss * (1.0f / DM) + RMS_EPS);
        float lg[16];
#pragma unroll
        for (int r = 0; r < 16; ++r) lg[r] = acc[r] * rstd + F.b_router[(r & 3) + 8 * (r >> 2) + 4 * hi];
        float cvv[8]; int cei[8];
#pragma unroll
        for (int k = 0; k < 4; ++k) { float best = -INFINITY; int bi = 0;
#pragma unroll
            for (int r = 0; r < 16; ++r) { const bool gtb = lg[r] > best; best = gtb ? lg[r] : best; bi = gtb ? r : bi; }
#pragma unroll
            for (int r = 0; r < 16; ++r) lg[r] = (r == bi) ? -INFINITY : lg[r];
            cvv[k] = best; cei[k] = (bi & 3) + 8 * (bi >> 2) + 4 * hi; }
#pragma unroll
        for (int k = 0; k < 4; ++k) { cvv[4 + k] = __shfl_xor(cvv[k], 32); cei[4 + k] = __shfl_xor(cei[k], 32); }
        float tv[4]; int te[4];
#pragma unroll
        for (int k = 0; k < 4; ++k) { float best = -INFINITY; int be = 1 << 30, bi = 0;
#pragma unroll
            for (int c = 0; c < 8; ++c) { const bool better = (cvv[c] > best) || (cvv[c] == best && cei[c] < be); best = better ? cvv[c] : best; be = better ? cei[c] : be; bi = better ? c : bi; }
#pragma unroll
            for (int c = 0; c < 8; ++c) { const bool hit = (c == bi); cvv[c] = hit ? -INFINITY : cvv[c]; cei[c] = hit ? (1 << 30) : cei[c]; }
            tv[k] = best; te[k] = be; }
        const float e1 = ex2((tv[1] - tv[0]) * LOG2E), e2 = ex2((tv[2] - tv[0]) * LOG2E), e3 = ex2((tv[3] - tv[0]) * LOG2E);
        const float inv = 1.0f / (1.0f + e1 + e2 + e3);
        if (hi == 0) {
            rstd2[row] = rstd;
            *(i32x4*)(tope + (size_t)row * 4) = (i32x4){te[0], te[1], te[2], te[3]};
            *(f32x4*)(gate + (size_t)row * 4) = (f32x4){inv, e1 * inv, e2 * inv, e3 * inv};
#pragma unroll
            for (int k = 0; k < 4; ++k) atomicAdd((int*)(hist + te[k]), 1);
        }
    }
    __syncthreads();
    if (F.tid < 32) cnt[wg * 32 + F.tid] = hist[F.tid];
    __syncthreads();
}

__device__ __forceinline__ void p5_scatter(Frame& F) {
    LAS int* tot = (LAS int*)F.lds; LAS int* pre = tot + 32; LAS int* ctr = tot + 64; LAS int* pstart = tot + 96;
    const int* cnt = wsp<int>(F, WS_CNT); const int wg = F.vcu;
    if (F.tid < 64) tot[F.tid] = 0;
    __syncthreads();
    { const int e = F.tid & 31, j = F.tid >> 5; int t = 0, p = 0;
        for (int w = j; w < 256; w += 16) { const int c = ld_i(cnt + w * 32 + e); t += c; p += (w < wg) ? c : 0; }
        atomicAdd((int*)(tot + e), t); atomicAdd((int*)(pre + e), p); }
    __syncthreads();
    if (F.tid == 0) { int run = 0; for (int e = 0; e < 32; ++e) { pstart[e] = run; run += (tot[e] + 255) & ~255; } pstart[32] = run; }
    __syncthreads();
    if (F.tid < 32) ctr[F.tid] = pstart[F.tid] + pre[F.tid];
    int* slot_tok = wsp<int>(F, WS_SLOTTOK); float* slot_gate = wsp<float>(F, WS_SLOTGATE); float* slot_rstd = wsp<float>(F, WS_SLOTRSTD);
    int* tile_e = wsp<int>(F, WS_TILEE);
    if (wg == 0) {
        if (F.tid < 32) { for (int rt = pstart[F.tid] >> 8; rt < (pstart[F.tid + 1] >> 8); ++rt) tile_e[rt] = F.tid; }
        if (F.tid == 0) tile_e[CAP_TILES] = pstart[32] >> 8;
    }
    if (wg < 32) { const int e = wg; for (int s = pstart[e] + tot[e] + F.tid; s < pstart[e + 1]; s += 512) { slot_tok[s] = 0; slot_gate[s] = 0.f; slot_rstd[s] = 0.f; } }
    __syncthreads();
    { const int tok = wg * 128 + (F.tid >> 2), k = F.tid & 3;
        const int e = ld_i(wsp<int>(F, WS_TOPE) + tok * 4 + k);
        const int slot = atomicAdd((int*)(ctr + e), 1);
        slot_tok[slot] = tok; slot_gate[slot] = ld_f(wsp<float>(F, WS_GATE) + tok * 4 + k); slot_rstd[slot] = ld_f(wsp<float>(F, WS_RSTD2) + tok);
        wsp<int>(F, WS_TOKSLOT)[tok * 4 + k] = slot; }
    __syncthreads();
}

__device__ __forceinline__ void p8_combine(Frame& F) {
    const int gw = F.vcu * NWAVES + F.wave, NGW = F.G * NWAVES;
    const bf16_t* ys = wsp<bf16_t>(F, WS_YS); const int* tokslot = wsp<int>(F, WS_TOKSLOT);
    f32x4 gf[2][2];
#pragma unroll
    for (int j = 0; j < 2; ++j) { gf[j][0] = *(const f32x4*)(F.g_final + 512 * j + 8 * F.lane); gf[j][1] = *(const f32x4*)(F.g_final + 512 * j + 8 * F.lane + 4); }
    for (int m = gw; m < NTOK; m += NGW) {
        int sl[4];
#pragma unroll
        for (int k = 0; k < 4; ++k) sl[k] = ld_i(tokslot + (size_t)m * 4 + k);
        float* hrow = F.out + (size_t)m * DM + 8 * F.lane;
        f32x4 v[2][2]; float ss = 0.f;
#pragma unroll
        for (int j = 0; j < 2; ++j) { v[j][0] = *(const f32x4*)(hrow + 512 * j); v[j][1] = *(const f32x4*)(hrow + 512 * j + 4);
#pragma unroll
            for (int k = 0; k < 4; ++k) { const u32x4 y = *(const u32x4*)(ys + (size_t)sl[k] * DM + 512 * j + 8 * F.lane);
                v[j][0][0] += bflo(y.x); v[j][0][1] += bfhi(y.x); v[j][0][2] += bflo(y.y); v[j][0][3] += bfhi(y.y);
                v[j][1][0] += bflo(y.z); v[j][1][1] += bfhi(y.z); v[j][1][2] += bflo(y.w); v[j][1][3] += bfhi(y.w); }
#pragma unroll
            for (int q = 0; q < 2; ++q) ss += (v[j][q][0] * v[j][q][0] + v[j][q][1] * v[j][q][1]) + (v[j][q][2] * v[j][q][2] + v[j][q][3] * v[j][q][3]); }
        const float rstd = 1.0f / sqrtf(wave_sum(ss) * (1.0f / DM) + RMS_EPS);
#pragma unroll
        for (int j = 0; j < 2; ++j) { *(f32x4*)(hrow + 512 * j) = v[j][0] * rstd * gf[j][0]; *(f32x4*)(hrow + 512 * j + 4) = v[j][1] * rstd * gf[j][1]; }
    }
}

__device__ __forceinline__ void run_p1(Frame& F) {
    { pg8::SchedPlain S; S.init(wsp<bf16_t>(F, WS_A), wsp<bf16_t>(F, WS_WIN), NTOK, 2560, F.G, (int)blockIdx.x);
      EpiProj E{wsp<bf16_t>(F, WS_Q), wsp<bf16_t>(F, WS_KB), wsp<bf16_t>(F, WS_CB), wsp<bf16_t>(F, WS_CC), wsp<bf16_t>(F, WS_CX), wsp<float>(F, WS_RSTD1)};
      pg8::gemm_phase<EpiProj, pg8::SchedPlain, false>(F.lds, S, E); }
    { pg8::SchedPlain S; S.init(wsp<bf16_t>(F, WS_WIN) + (size_t)2560 * DM, wsp<bf16_t>(F, WS_A), 512, NTOK, F.G, (int)blockIdx.x);
      EpiVt E{wsp<bf16_t>(F, WS_VT), wsp<float>(F, WS_RSTD1)};
      pg8::gemm_phase<EpiVt, pg8::SchedPlain, false>(F.lds, S, E); }
}
__device__ __forceinline__ void run_p2(Frame& F) {
    for (int u = F.vcu; u < NB * (SEQ / 32); u += F.G) p2_unit(F, u >> 7, u & 127);
}
__device__ __forceinline__ void run_p3(Frame& F) {
    pg8::SchedPlain S; S.init(wsp<bf16_t>(F, WS_MIXED), wsp<bf16_t>(F, WS_WOUT), NTOK, DM, F.G, (int)blockIdx.x);
    EpiOut E{F.x, F.out, wsp<bf16_t>(F, WS_A), wsp<unsigned char>(F, WS_A8), wsp<float>(F, WS_SSP), F.g_ffn};
    pg8::gemm_phase<EpiOut, pg8::SchedPlain, false>(F.lds, S, E);
}
__device__ __forceinline__ void run_p6(Frame& F) {
    pg8::SchedGrouped<1024> S; S.A = (const char*)wsp<unsigned char>(F, WS_A8); S.Bt = (const char*)wsp<unsigned char>(F, WS_WGU); S.estep = (size_t)2048 * 1024; S.nN = 8; S.G = F.G; S.c = F.vcu;
    S.tile_e = wsp<int>(F, WS_TILEE); S.slot_tok = wsp<int>(F, WS_SLOTTOK); S.ntiles = __builtin_amdgcn_readfirstlane(ld_i(S.tile_e + CAP_TILES));
    EpiGU E{wsp<unsigned char>(F, WS_HID), F.b_gu, wsp<float>(F, WS_SLOTRSTD)};
    pg8::gemm_phase<EpiGU, pg8::SchedGrouped<1024>, true, true>(F.lds, S, E);
}
__device__ __forceinline__ void run_p7(Frame& F) {
    pg8::SchedGrouped<1024> S; S.A = (const char*)wsp<unsigned char>(F, WS_HID); S.Bt = (const char*)wsp<unsigned char>(F, WS_WD); S.estep = (size_t)1024 * 1024; S.nN = 4; S.G = F.G; S.c = F.vcu;
    S.tile_e = wsp<int>(F, WS_TILEE); S.slot_tok = wsp<int>(F, WS_SLOTTOK); S.ntiles = __builtin_amdgcn_readfirstlane(ld_i(S.tile_e + CAP_TILES));
    EpiDown E{wsp<bf16_t>(F, WS_YS), F.b_down, wsp<float>(F, WS_SLOTGATE)};
    pg8::gemm_phase<EpiDown, pg8::SchedGrouped<1024>, false, true>(F.lds, S, E);
}

constexpr int N_PHASES = 9;
__global__ void __launch_bounds__(NWAVES * 64, 2) fwd(Args args) {
    extern __shared__ __attribute__((aligned(16))) unsigned char lds_raw[];
    Frame F;
    F.lds = (LAS unsigned char*)lds_raw;
    F.tid = threadIdx.x; F.lane = F.tid & 63; F.wave = __builtin_amdgcn_readfirstlane(F.tid >> 6);
    F.G = gridDim.x; { const int bx = blockIdx.x; F.vcu = (F.G % 8 == 0) ? (bx % 8) * (F.G / 8) + bx / 8 : bx; }
    F.ws = args.ws; F.ctl = (gu32*)(args.ws + WS_CTL); F.out = args.out;
    F.x = args.in[0]; F.meta = args.in[1]; F.g_mix = args.in[2]; F.w_in = args.in[3]; F.g_attn = args.in[4]; F.conv_w = args.in[5]; F.conv_b = args.in[6]; F.g_conv = args.in[7];
    F.w_out = args.in[8]; F.g_ffn = args.in[9]; F.w_router = args.in[10]; F.b_router = args.in[11]; F.w_gu = args.in[12]; F.b_gu = args.in[13]; F.w_down = args.in[14]; F.b_down = args.in[15]; F.g_final = args.in[16];
    volatile LAS unsigned* MISC = (volatile LAS unsigned*)(F.lds + MISC_OFF);
    for (int u = F.tid; u < (LDS_BYTES - LDSCTL_OFF) / 4; u += NWAVES * 64) ((LAS unsigned*)(F.lds + LDSCTL_OFF))[u] = 0u;
    __syncthreads();
    const int lo = args.ph_lo, hi = args.ph_hi;
    const bool multi = (hi - lo) > 1;
    XcdBarrier bar; bar.bar = (unsigned*)(F.ctl + CW_BAR); bar.x = 0; bar.st = nullptr;
    if (multi) bar = xcd_barrier_post((unsigned*)(F.ctl + CW_BAR), MISC + 8);
#ifndef PH_MASK
#define PH_MASK 0x1ff
#endif
#define IN(k) (((PH_MASK >> (k)) & 1) && lo <= (k) && (k) < hi)
#define SEAM(k) do { if (IN(k) && IN((k) + 1)) xcd_barrier(bar); } while (0)
#ifndef DUP_MASK
#define DUP_MASK 0
#endif
#define DUPK(k) ((((DUP_MASK) >> (k)) & 1) != 0)

    if (IN(0)) { p0_prologue(F); if (DUPK(0)) { xcd_barrier(bar); p0_prologue(F); } }
    SEAM(0);
    if (IN(1)) { run_p1(F); if (DUPK(1)) { xcd_barrier(bar); run_p1(F); } }
    SEAM(1);
    if (IN(2)) { run_p2(F); if (DUPK(2)) { xcd_barrier(bar); run_p2(F); } }
    SEAM(2);
    if (IN(3)) { run_p3(F); if (DUPK(3)) { xcd_barrier(bar); run_p3(F); } }
    SEAM(3);
    if (IN(4)) { p4_router(F); if (DUPK(4)) { xcd_barrier(bar); p4_router(F); } }
    SEAM(4);
    if (IN(5)) { p5_scatter(F); if (DUPK(5)) { xcd_barrier(bar); p5_scatter(F); } }
    SEAM(5);
    if (IN(6)) { run_p6(F); if (DUPK(6)) { xcd_barrier(bar); run_p6(F); } }
    SEAM(6);
    if (IN(7)) { run_p7(F); if (DUPK(7)) { xcd_barrier(bar); run_p7(F); } }
    SEAM(7);
    if (IN(8)) { p8_combine(F); }
#undef IN
#undef SEAM
}

#ifndef MK_N_LAUNCHES
#define MK_N_LAUNCHES 1
#endif
extern "C" void kernel_launch(void* const* d_in, const int* in_sizes, int n_in, void* d_out, int out_size, void* d_ws, size_t ws_size, hipStream_t stream) {
    static int grid = 0;
    if (grid == 0) {
        if (n_in != 17 || out_size != NTOK * DM || ws_size < WS_END) { fprintf(stderr, "kernel_launch: unexpected problem (n_in %d out %d ws %zu)\n", n_in, out_size, ws_size); grid = -1; return; }
        int dev = 0, cus = 0, per_cu = 0;
        if (hipGetDevice(&dev) != hipSuccess || hipDeviceGetAttribute(&cus, hipDeviceAttributeMultiprocessorCount, dev) != hipSuccess) { grid = -1; return; }
        if (hipFuncSetAttribute((const void*)fwd, hipFuncAttributeMaxDynamicSharedMemorySize, LDS_BYTES) != hipSuccess) { fprintf(stderr, "kernel_launch: hipFuncSetAttribute failed\n"); grid = -1; return; }
        if (hipOccupancyMaxActiveBlocksPerMultiprocessor(&per_cu, (const void*)fwd, NWAVES * 64, LDS_BYTES) != hipSuccess || per_cu < 1) { fprintf(stderr, "kernel_launch: occupancy query says %d\n", per_cu); }
        (void)hipGetLastError();
        grid = cus;
        if (grid != 256) fprintf(stderr, "kernel_launch: %d CUs (built for 256)\n", grid);
    }
    if (grid < 0) return;
    (void)hipMemsetAsync((char*)d_ws + WS_CTL, 0, CTL_ZERO_BYTES, stream);
    Args a{};
    for (int i = 0; i < 17; ++i) a.in[i] = (const float*)d_in[i];
    a.out = (float*)d_out; a.ws = (unsigned char*)d_ws;
    if (MK_N_LAUNCHES == 1) { a.ph_lo = 0; a.ph_hi = N_PHASES; hipLaunchKernelGGL(fwd, dim3(grid), dim3(NWAVES * 64), LDS_BYTES, stream, a); }
    else for (int p = 0; p < N_PHASES; ++p) { a.ph_lo = p; a.ph_hi = p + 1; hipLaunchKernelGGL(fwd, dim3(grid), dim3(NWAVES * 64), LDS_BYTES, stream, a); }
    const hipError_t le = hipPeekAtLastError();
    if (le != hipSuccess) fprintf(stderr, "kernel_launch: launch failed: %s\n", hipGetErrorName(le));
}
```

```cpp
#include <hip/hip_runtime.h>
#include <cstdio>
#include <cstdint>

#define GAS __attribute__((address_space(1)))
#define LAS __attribute__((address_space(3)))
typedef unsigned short bf16_t;
typedef short bf16x8 __attribute__((ext_vector_type(8)));
typedef float f32x2 __attribute__((ext_vector_type(2)));
typedef float f32x4 __attribute__((ext_vector_type(4)));
typedef float f32x16 __attribute__((ext_vector_type(16)));
typedef unsigned u32x2 __attribute__((ext_vector_type(2)));
typedef unsigned u32x4 __attribute__((ext_vector_type(4)));
typedef int i32x4 __attribute__((ext_vector_type(4)));
typedef int i32x8 __attribute__((ext_vector_type(8)));
typedef __bf16 bf16x2_t __attribute__((ext_vector_type(2)));
typedef GAS unsigned gu32;
#define RLX_AGENT __ATOMIC_RELAXED, __HIP_MEMORY_SCOPE_AGENT

constexpr int DM = 1024, NB = 8, SEQ = 4096, NTOK = NB * SEQ;
constexpr int NMETA = 16, KPAD = 48, TPAD = KPAD + NMETA + SEQ;
constexpr int QOFF = KPAD + NMETA;
constexpr int AW = 512, NH = 8, HD = 64;
constexpr int NE = 32, TOPK = 4, FF = 1024;
constexpr int CAP_TILES = 544, CAP = CAP_TILES * 256;
constexpr float RMS_EPS = 1e-6f;
constexpr float LOG2E = 1.4426950408889634f;
constexpr float QSCALE = 0.125f * LOG2E;
constexpr float EXIT_THR = -152.0f;
constexpr int NWAVES = 8;
constexpr float YSCALE = 16.0f, YINV = 1.0f / 16.0f;
constexpr float WSCALE = 32.0f, WINV = 1.0f / 32.0f;

constexpr size_t MiB = 1u << 20, KiB = 1u << 10;
constexpr size_t WS_CTL = 0, CTL_ZERO_BYTES = 64 * KiB;
constexpr size_t WS_RSTD1 = 1 * MiB, WS_RSTD2 = WS_RSTD1 + 128 * KiB, WS_CNT = WS_RSTD2 + 128 * KiB, WS_TILEE = WS_CNT + 64 * KiB, WS_META = WS_TILEE + 64 * KiB;
constexpr size_t WS_TOPE = 2 * MiB, WS_GATE = WS_TOPE + 512 * KiB, WS_TOKSLOT = 3 * MiB;
constexpr size_t WS_SLOTTOK = 4 * MiB, WS_SLOTGATE = 5 * MiB, WS_SLOTRSTD = 6 * MiB;
constexpr size_t WS_SSP = 8 * MiB;
constexpr size_t WS_WIN = 10 * MiB, WS_WGU = 16 * MiB, WS_WD = 144 * MiB, WS_A = 208 * MiB;
constexpr size_t WS_HID = 272 * MiB;
constexpr size_t WS_Q = 272 * MiB, WS_KB = 304 * MiB, WS_VT = 337 * MiB, WS_CB = 370 * MiB, WS_CC = 402 * MiB, WS_CX = 434 * MiB, WS_MIXED = 466 * MiB;
constexpr size_t WS_YS = 544 * MiB, WS_WOUT = 816 * MiB, WS_A8 = 820 * MiB, WS_END = 852 * MiB;
static_assert(WS_MIXED + 64 * MiB <= WS_HID + (size_t)CAP * 2048 && WS_HID + (size_t)CAP * 2048 <= WS_YS && WS_YS + (size_t)CAP * 2048 <= WS_WOUT, "ws map");
static_assert((size_t)NB * TPAD * 512 * 2 <= 33 * MiB, "K/Vt size");
constexpr int CW_TMO = 0, CW_BAR = 1024;

constexpr int RING_BYTES = 131072, LDSCTL_OFF = RING_BYTES, MISC_OFF = LDSCTL_OFF + 320, LDS_BYTES = 147456;

__device__ __forceinline__ unsigned cvtpk(float lo, float hi) { f32x2 v = {lo, hi}; bf16x2_t b = __builtin_convertvector(v, bf16x2_t); return __builtin_bit_cast(unsigned, b); }
__device__ __forceinline__ unsigned pk4_fp8(float a, float b, float c, float d) { int w = 0; w = __builtin_amdgcn_cvt_pk_fp8_f32(a, b, w, false); w = __builtin_amdgcn_cvt_pk_fp8_f32(c, d, w, true); return (unsigned)w; }
__device__ __forceinline__ f32x2 fp8lo(unsigned w) { return __builtin_amdgcn_cvt_pk_f32_fp8((int)w, false); }
__device__ __forceinline__ f32x2 fp8hi(unsigned w) { return __builtin_amdgcn_cvt_pk_f32_fp8((int)w, true); }
__device__ __forceinline__ float bflo(unsigned u) { return __builtin_bit_cast(float, u << 16); }
__device__ __forceinline__ float bfhi(unsigned u) { return __builtin_bit_cast(float, u & 0xffff0000u); }
__device__ __forceinline__ float ex2(float x) { return __builtin_amdgcn_exp2f(x); }
__device__ __forceinline__ float lg2(float x) { return __builtin_amdgcn_logf(x); }
__device__ __forceinline__ int ld_i(const int* p) { return __hip_atomic_load(p, RLX_AGENT); }
__device__ __forceinline__ float ld_f(const float* p) { return __builtin_bit_cast(float, __hip_atomic_load((const int*)p, RLX_AGENT)); }
__device__ __forceinline__ float wave_sum(float v) {
#pragma unroll
    for (int o = 1; o < 64; o <<= 1) v += __shfl_xor(v, o);
    return v;
}
#define LDS_WAIT() asm volatile("s_waitcnt lgkmcnt(0)" ::: "memory")
#define VM_WAIT() asm volatile("s_waitcnt vmcnt(0)" ::: "memory")

namespace pg8 {
constexpr int BM = 256, BK = 64, HALF = 128, HTB = HALF * BK * 2, STAGE_BYTES = 8 * HTB, NXCD = 8, WGM = 8, GK = 1024;
__host__ __device__ __forceinline__ int lds_byte(int r, int c) { const int st = (r >> 4) * 2 + (c >> 5), rr = r & 15, cc = c & 31, ob = rr * 64 + cc * 2; return st * 1024 + (ob ^ (((ob >> 9) & 1) << 5)); }
__host__ __device__ __forceinline__ void stage_rc(int b, int& R, int& C) { const int st = b / 1024, sb = b % 1024, swz = sb ^ (((sb >> 9) & 1) << 5); R = (st >> 1) * 16 + swz / 64; C = (st & 1) * 32 + (swz % 64) / 2; }
__host__ __device__ __forceinline__ int perm32(int rho) { const int n = rho >> 4, i = rho & 15; return 8 * (i >> 2) + 4 * n + (i & 3); }
struct Unit { int pm, pn, e; };

struct SchedPlain {
    const char* A; const char* Bt; int nM, nN, nwg, G, c; static constexpr int RB = 2048;
    __device__ void init(const void* A_, const void* Bt_, int M, int N, int G_, int c_) { A = (const char*)A_; Bt = (const char*)Bt_; nM = M / BM; nN = N / BM; nwg = nM * nN; G = G_; c = c_; }
    __device__ __forceinline__ bool next(int i, Unit& u) const {
        const long L = (long)i * G + c; if (L >= nwg) return false;
        int wgid = (int)L; { const int q = nwg / NXCD, r = nwg % NXCD, xcd = wgid % NXCD, off = wgid / NXCD; wgid = (xcd < r ? xcd * (q + 1) : r * (q + 1) + (xcd - r) * q) + off; }
        const int nig = WGM * nN, gid = wgid / nig, fm = gid * WGM, gsz = (nM - fm) < WGM ? (nM - fm) : WGM;
        u.pm = fm + ((wgid % nig) % gsz); u.pn = (wgid % nig) / gsz; u.e = 0; return true;
    }
    __device__ __forceinline__ unsigned a_tile(const Unit& u) const { return (unsigned)u.pm * (unsigned)(BM * RB); }
    __device__ __forceinline__ unsigned b_tile(const Unit& u) const { return (unsigned)u.pn * (unsigned)(BM * RB); }
    __device__ __forceinline__ unsigned tok_off(int) const { return 0u; }
    __device__ __forceinline__ unsigned tok_lds(int, int) const { return 0u; }
    __device__ __forceinline__ void tok_dma(int, int, int, int) const {}
};
template <int RB_> struct SchedGrouped {
    static constexpr int RB = RB_;
    const char* A; const char* Bt; size_t estep; int nN, G, c, ntiles; const int* tile_e; const int* slot_tok;
    LAS int* ltile;
    LAS int* ltok;
    int rep;
    __device__ __forceinline__ void setup() const { for (int i = threadIdx.x; i < ntiles; i += NWAVES * 64) ltile[i] = ld_i(tile_e + i); __syncthreads(); }
    __device__ __forceinline__ bool next(int i, Unit& u) const {
        const int tot = ntiles * nN, nmy = (c < tot) ? (tot - c + G - 1) / G : 0; if (i >= nmy * rep) return false;
        const int L = (i % nmy) * G + c;
        u.pm = L / nN; u.pn = L % nN; u.e = __builtin_amdgcn_readfirstlane(ltile[u.pm]); return true;
    }
    __device__ __forceinline__ unsigned a_tile(const Unit& u) const { return (unsigned)u.pm * (unsigned)(BM * RB); }
    __device__ __forceinline__ unsigned b_tile(const Unit& u) const { return (unsigned)u.e * (unsigned)estep + (unsigned)u.pn * (unsigned)(BM * RB); }
    __device__ __forceinline__ unsigned tok_off(int row) const { return (unsigned)ld_i(slot_tok + row) * (unsigned)RB; }
    __device__ __forceinline__ unsigned tok_lds(int par, int r) const { return (unsigned)ltok[par * 256 + r] * (unsigned)RB; }
    __device__ __forceinline__ void tok_dma(int par, int pm, int wid, int lane) const {
        const __amdgpu_buffer_rsrc_t rsT = __builtin_amdgcn_make_buffer_rsrc((void*)slot_tok, (short)0, CAP * 4, 0x00020000);
        __builtin_amdgcn_raw_ptr_buffer_load_lds(rsT, (LAS void*)(ltok + par * 256 + wid * 64), 4, lane * 4, (pm * 256 + wid * 64) * 4, 0, 0);
    }
};

template <class Epi, class Sched, bool GATHER, bool FP8 = false>
__device__ __forceinline__ void gemm_phase(LAS unsigned char* lds, const Sched& S, const Epi& E) {
    constexpr int RB = Sched::RB, nt = RB / 128;
    const int tid = threadIdx.x, wid = __builtin_amdgcn_readfirstlane(tid >> 6), lane = tid & 63, wr = wid >> 2, wc = wid & 3, fr = lane & 15, fq = lane >> 4;
    unsigned voffA[2], voffB[2], stC2[2]; int stR[2];
#pragma unroll
    for (int i = 0; i < 2; ++i) { int R, C; stage_rc(tid * 16 + i * 8192, R, C); const int Rb = (R & ~31) + perm32(R & 31);
        voffA[i] = (unsigned)(R * RB + C * 2); voffB[i] = (unsigned)(Rb * RB + C * 2); stR[i] = R; stC2[i] = (unsigned)C * 2u; }
    constexpr unsigned kstep = 128u, hstep = (unsigned)(HALF * RB);
    const __amdgpu_buffer_rsrc_t rsA = __builtin_amdgcn_make_buffer_rsrc((void*)S.A, (short)0, 0x7fffff00, 0x00020000), rsB = __builtin_amdgcn_make_buffer_rsrc((void*)S.Bt, (short)0, 0x7fffff00, 0x00020000);
    const unsigned ldsw = (unsigned)wid * 1024u;
    const int aoff = lds_byte(wr * 64 + fr, fq * 8), boff = lds_byte(wc * 32 + fr, fq * 8);
#define PG8_SA(b, h) (((b) * 2 + (h)) * HTB)
#define PG8_SB(b, h) ((4 + (b) * 2 + (h)) * HTB)
#define PG8_STAGE2(bufoff, rs, soff, o0, o1) do { \
        __builtin_amdgcn_raw_ptr_buffer_load_lds(rs, (LAS void*)(lds + (bufoff) + ldsw), 16, (int)(o0), (int)(soff), 0, 0); \
        __builtin_amdgcn_raw_ptr_buffer_load_lds(rs, (LAS void*)(lds + (bufoff) + ldsw + 8192), 16, (int)(o1), (int)(soff), 0, 0); } while (0)
#define PG8_STAGE_B(bufoff, soff) PG8_STAGE2(bufoff, rsB, soff, voffB[0], voffB[1])
#define PG8_STAGE_A(bufoff, usenext, h, koff) do { if constexpr (GATHER) { \
            const unsigned _o0 = (usenext) ? ng[h][0] : cg[h][0], _o1 = (usenext) ? ng[h][1] : cg[h][1]; PG8_STAGE2(bufoff, rsA, (koff), _o0, _o1); } \
        else { PG8_STAGE2(bufoff, rsA, ((usenext) ? nA : cA) + (unsigned)(h) * hstep + (koff), voffA[0], voffA[1]); } } while (0)
#define PG8_LDA(dst, b, h) do { _Pragma("unroll") for (int m = 0; m < 4; ++m) _Pragma("unroll") for (int k = 0; k < 2; ++k) dst[m][k] = *(const LAS bf16x8*)(lds + PG8_SA(b, h) + aoff + m * 2048 + k * 1024); } while (0)
#define PG8_LDB(dst, b, h) do { _Pragma("unroll") for (int n = 0; n < 2; ++n) _Pragma("unroll") for (int k = 0; k < 2; ++k) dst[n][k] = *(const LAS bf16x8*)(lds + PG8_SB(b, h) + boff + n * 2048 + k * 1024); } while (0)
#define PG8_MMA(ai, bj, At, Bt) do { __builtin_amdgcn_s_setprio(1); _Pragma("unroll") for (int m = 0; m < 4; ++m) _Pragma("unroll") for (int n = 0; n < 2; ++n) { \
        if constexpr (FP8) { const i32x8 bb_ = __builtin_shufflevector(__builtin_bit_cast(i32x4, Bt[n][0]), __builtin_bit_cast(i32x4, Bt[n][1]), 0, 1, 2, 3, 4, 5, 6, 7); \
            const i32x8 aa_ = __builtin_shufflevector(__builtin_bit_cast(i32x4, At[m][0]), __builtin_bit_cast(i32x4, At[m][1]), 0, 1, 2, 3, 4, 5, 6, 7); \
            asm volatile("v_mfma_scale_f32_16x16x128_f8f6f4 %0, %1, %2, %0, %3, %3 op_sel_hi:[0,0,0]" : "+v"(acc[ai][bj][m][n]) : "v"(bb_), "v"(aa_), "v"(scl8)); } \
        else { _Pragma("unroll") for (int k = 0; k < 2; ++k) acc[ai][bj][m][n] = __builtin_amdgcn_mfma_f32_16x16x32_bf16(Bt[n][k], At[m][k], acc[ai][bj][m][n], 0, 0, 0); } } \
        __builtin_amdgcn_s_setprio(0); } while (0)
#define PG8_MFMA_DRAIN() do { if constexpr (FP8) asm volatile("s_nop 7\n\ts_nop 7" ::: "memory"); } while (0)
#define PG8_WAIT_V(n) asm volatile("s_waitcnt vmcnt(" #n ")" ::: "memory")
#define PG8_WAIT_L(n) asm volatile("s_waitcnt lgkmcnt(" #n ")" ::: "memory")
#define PG8_BAR __builtin_amdgcn_s_barrier()
#define PG8_SCHED __builtin_amdgcn_sched_barrier(0)
    Unit cur, nxt; int ui = 0;
    if (!S.next(0, cur)) return;
    f32x4 acc[2][2][4][2];
#pragma unroll
    for (int a = 0; a < 2; ++a)
#pragma unroll
        for (int b = 0; b < 2; ++b)
#pragma unroll
            for (int m = 0; m < 4; ++m)
#pragma unroll
                for (int n = 0; n < 2; ++n) acc[a][b][m][n] = (f32x4){0.f, 0.f, 0.f, 0.f};
    bf16x8 At[4][2], B0[2][2], B1[2][2];
    int scl8 = 0x7f7f7f7f; asm volatile("" : "+v"(scl8));
    unsigned cA = S.a_tile(cur), cB = S.b_tile(cur), nA = cA;
    unsigned cg[2][2], ng[2][2];
    if constexpr (GATHER) {
#pragma unroll
        for (int h = 0; h < 2; ++h)
#pragma unroll
            for (int i = 0; i < 2; ++i) { cg[h][i] = S.tok_off(cur.pm * BM + h * HALF + stR[i]) + stC2[i]; ng[h][i] = cg[h][i]; }
    } else {
#pragma unroll
        for (int h = 0; h < 2; ++h)
#pragma unroll
            for (int i = 0; i < 2; ++i) { cg[h][i] = 0u; ng[h][i] = 0u; }
    }
    PG8_STAGE_B(PG8_SB(0, 0), cB); PG8_STAGE_B(PG8_SB(0, 1), cB + hstep); PG8_STAGE_A(PG8_SA(0, 0), false, 0, 0); PG8_STAGE_A(PG8_SA(0, 1), false, 1, 0);
    if (wr == 1) PG8_BAR;
    PG8_WAIT_V(2); PG8_BAR;
    PG8_STAGE_B(PG8_SB(1, 0), cB + kstep); PG8_STAGE_A(PG8_SA(1, 0), false, 0, kstep); PG8_STAGE_B(PG8_SB(1, 1), cB + hstep + kstep);
    PG8_WAIT_V(6); PG8_BAR;
    for (;;) {
        const bool has_next = S.next(ui + 1, nxt);
        nA = has_next ? S.a_tile(nxt) : cA; const unsigned nB = has_next ? S.b_tile(nxt) : cB;
#pragma unroll 1
        for (int t = 0; t < nt; t += 2) {
            const bool last = (t == nt - 2);
            const unsigned koff1 = (unsigned)(t + 1) * kstep, koff2 = last ? 0u : (unsigned)(t + 2) * kstep, koff3 = koff2 + kstep;
            const unsigned b2 = last ? nB : cB + (unsigned)(t + 2) * kstep, b3 = b2 + kstep;
            if constexpr (GATHER) {
                if (t == nt - 4 && has_next && wid < 4) S.tok_dma((ui + 1) & 1, nxt.pm, wid, lane);
                if (last && has_next) {
#pragma unroll
                    for (int h = 0; h < 2; ++h)
#pragma unroll
                        for (int i = 0; i < 2; ++i) ng[h][i] = S.tok_lds((ui + 1) & 1, h * HALF + stR[i]) + stC2[i]; } }
            PG8_LDB(B0, 0, 0); PG8_LDB(B1, 0, 1); PG8_SCHED; PG8_LDA(At, 0, 0); PG8_STAGE_A(PG8_SA(1, 1), false, 1, koff1);
            PG8_WAIT_V(8); PG8_WAIT_L(0); PG8_BAR; PG8_MMA(0, 0, At, B0); PG8_MMA(0, 1, At, B1); PG8_BAR; PG8_SCHED;
            PG8_LDA(At, 0, 1); PG8_STAGE_B(PG8_SB(0, 0), b2); PG8_STAGE_B(PG8_SB(0, 1), b2 + hstep); PG8_STAGE_A(PG8_SA(0, 0), last, 0, koff2);
            PG8_WAIT_V(8); PG8_WAIT_L(0); PG8_BAR; PG8_MMA(1, 0, At, B0); PG8_MMA(1, 1, At, B1); PG8_BAR; PG8_SCHED;
            PG8_LDB(B0, 1, 0); PG8_LDB(B1, 1, 1); PG8_SCHED; PG8_LDA(At, 1, 0); PG8_STAGE_A(PG8_SA(0, 1), last, 1, koff2);
            PG8_WAIT_V(8); PG8_WAIT_L(0); PG8_BAR; PG8_MMA(0, 0, At, B0); PG8_MMA(0, 1, At, B1); PG8_BAR; PG8_SCHED;
            PG8_LDA(At, 1, 1); PG8_STAGE_B(PG8_SB(1, 0), b3); PG8_STAGE_B(PG8_SB(1, 1), b3 + hstep); PG8_STAGE_A(PG8_SA(1, 0), last, 0, koff3);
            PG8_WAIT_V(8); PG8_WAIT_L(0); PG8_BAR; PG8_MMA(1, 0, At, B0); PG8_MMA(1, 1, At, B1); PG8_BAR; PG8_SCHED;
        }
        if (wr == 0) PG8_BAR;
        PG8_MFMA_DRAIN();
        E(acc, cur, wr, wc, fr, fq);
        if (!has_next) break;
#pragma unroll
        for (int a = 0; a < 2; ++a)
#pragma unroll
            for (int b = 0; b < 2; ++b)
#pragma unroll
                for (int m = 0; m < 4; ++m)
#pragma unroll
                    for (int n = 0; n < 2; ++n) acc[a][b][m][n] = (f32x4){0.f, 0.f, 0.f, 0.f};
        cur = nxt; cA = nA; cB = nB; ++ui;
#pragma unroll
        for (int h = 0; h < 2; ++h)
#pragma unroll
            for (int i = 0; i < 2; ++i) cg[h][i] = ng[h][i];
        if (wr == 1) PG8_BAR;
    }
    PG8_WAIT_V(0);
    PG8_BAR;
#undef PG8_SA
#undef PG8_SB
#undef PG8_STAGE2
#undef PG8_STAGE_B
#undef PG8_STAGE_A
#undef PG8_LDA
#undef PG8_LDB
#undef PG8_MMA
#undef PG8_MFMA_DRAIN
#undef PG8_WAIT_V
#undef PG8_WAIT_L
#undef PG8_BAR
#undef PG8_SCHED
}
}

#define XB_TMO      128
#define XB_XCNT(j)  (256  + 64 * (j))
#define XB_XSUB(j)  (1280 + 64 * (j))
#define XB_XGEN(j)  (2304 + 64 * (j))
#define XB_TOP      3328
#define XB_TOPGEN   3392
#define XCD_BAR_WORDS 3456
#define XB_SPIN_CAP (1u << 18)

__device__ __forceinline__ unsigned xb_ld(unsigned* p)              { return __hip_atomic_load(p, __ATOMIC_RELAXED, __HIP_MEMORY_SCOPE_AGENT); }
__device__ __forceinline__ unsigned xb_add(unsigned* p, unsigned v) { return __hip_atomic_fetch_add(p, v, __ATOMIC_RELAXED, __HIP_MEMORY_SCOPE_AGENT); }
__device__ __forceinline__ unsigned xb_xcc_id() { return (unsigned)__builtin_amdgcn_s_getreg((3 << 11) | 20) & 0xFu; }
#define XB_SPIN(cond, bar) do { unsigned _sp = 0; while (cond) { __builtin_amdgcn_s_sleep(1); \
    if ((++_sp & 255u) == 0u) { if (xb_ld(&(bar)[XB_TMO])) break; if (_sp > XB_SPIN_CAP) { atomicAdd(&(bar)[XB_TMO], 1u); break; } } } } while (0)

struct XcdBarrier {
    unsigned* bar; unsigned x;
    volatile LAS unsigned* st;
};

__device__ __forceinline__ XcdBarrier xcd_barrier_post(unsigned* bar, volatile LAS unsigned* st) {
    XcdBarrier b; b.bar = bar; b.x = xb_xcc_id(); b.st = st;
    if (threadIdx.x == 0) (void)xb_add(&bar[XB_XCNT(b.x)], 1u);
    return b;
}
__device__ __forceinline__ void xcd_barrier_complete(unsigned* bar, unsigned x, unsigned& nloc, unsigned& nx) {
    const unsigned G = gridDim.x * gridDim.y * gridDim.z;
    unsigned sum, cnt, mine, sp = 0u;
    for (;;) {
        sum = 0u; cnt = 0u; mine = 0u;
#pragma unroll
        for (unsigned j = 0; j < 16; ++j) { const unsigned c = xb_ld(&bar[XB_XCNT(j)]); sum += c; cnt += (c > 0u) ? 1u : 0u; mine = (j == x) ? c : mine; }
        if (sum == G) break;
        __builtin_amdgcn_s_sleep(1);
        if ((++sp & 255u) == 0u) { if (xb_ld(&bar[XB_TMO])) break; if (sp > XB_SPIN_CAP) { atomicAdd(&bar[XB_TMO], 1u); break; } }
    }
    nloc = mine > 0u ? mine : 1u; nx = cnt > 0u ? cnt : 1u;
}

__device__ __forceinline__ void xcd_barrier(const XcdBarrier& b) {
    asm volatile("s_waitcnt vmcnt(0)" ::: "memory");
    __syncthreads();
    if (threadIdx.x == 0) {
        unsigned* bar = b.bar;
        __builtin_amdgcn_s_waitcnt(0);
        unsigned nloc = b.st[0], nx = b.st[1];
        if (nloc == 0u) { xcd_barrier_complete(bar, b.x, nloc, nx); b.st[0] = nloc; b.st[1] = nx; }
        const unsigned old = xb_add(&bar[XB_XSUB(b.x)], 1u);
        const unsigned gen = old / nloc;
        if (old + 1u == (gen + 1u) * nloc) {
            __builtin_amdgcn_fence(__ATOMIC_RELEASE, "agent");
            asm volatile("s_waitcnt vmcnt(0)" ::: "memory");
            const unsigned og = xb_add(&bar[XB_TOP], 1u);
            const unsigned tg = og / nx;
            if (og + 1u == (tg + 1u) * nx) xb_add(&bar[XB_TOPGEN], 1u);
            else XB_SPIN(xb_ld(&bar[XB_TOPGEN]) == tg, bar);
            __builtin_amdgcn_fence(__ATOMIC_ACQUIRE, "agent");
            xb_add(&bar[XB_XGEN(b.x)], 1u);
            asm volatile("s_waitcnt vmcnt(0)" ::: "memory");
        } else {
            XB_SPIN(xb_ld(&bar[XB_XGEN(b.x)]) == gen, bar);
            __builtin_amdgcn_fence(__ATOMIC_ACQUIRE, "agent");
            asm volatile("s_waitcnt vmcnt(0)" ::: "memory");
        }
    }
    __syncthreads();
}

typedef f32x4 AccT[2][2][4][2];
struct EpiProj {
    bf16_t *Q, *KB, *CB, *CC, *CX; const float* rstd1;
    __device__ __forceinline__ void operator()(const AccT& acc, const pg8::Unit& u, int wr, int wc, int fr, int fq) const {
        const int sec = u.pn >> 1, row0 = u.pm * 256 + wr * 64 + fr, col0 = (u.pn & 1) * 256 + wc * 32 + 8 * fq;
        bf16_t* base = sec == 0 ? Q : sec == 1 ? KB : sec == 2 ? CB : sec == 3 ? CC : CX;
        const int radd = (sec == 1) ? 64 * ((u.pm >> 4) + 1) : 0;
        const float sc0 = (sec == 0) ? QSCALE : 1.0f;
        float rsv[2][4];
#pragma unroll
        for (int ai = 0; ai < 2; ++ai)
#pragma unroll
            for (int m = 0; m < 4; ++m) rsv[ai][m] = rstd1[row0 + ai * 128 + m * 16];
#pragma unroll
        for (int ai = 0; ai < 2; ++ai)
#pragma unroll
            for (int m = 0; m < 4; ++m) { const int r = row0 + ai * 128 + m * 16; const float sc = rsv[ai][m] * sc0;
                bf16_t* rowp = base + (size_t)(r + radd) * 512 + col0;
#pragma unroll
                for (int bj = 0; bj < 2; ++bj) { const f32x4 v0 = acc[ai][bj][m][0] * sc, v1 = acc[ai][bj][m][1] * sc;
                    u32x4 w; w.x = cvtpk(v0[0], v0[1]); w.y = cvtpk(v0[2], v0[3]); w.z = cvtpk(v1[0], v1[1]); w.w = cvtpk(v1[2], v1[3]);
                    *(u32x4*)(rowp + bj * 128) = w; } }
    }
};
struct EpiVt {
    bf16_t* VT; const float* rstd1;
    __device__ __forceinline__ void operator()(const AccT& acc, const pg8::Unit& u, int wr, int wc, int fr, int fq) const {
        const int row0 = u.pm * 256 + wr * 64 + fr, col0 = u.pn * 256 + wc * 32 + 8 * fq;
        f32x4 rs[2][2];
#pragma unroll
        for (int bj = 0; bj < 2; ++bj)
#pragma unroll
            for (int n = 0; n < 2; ++n) rs[bj][n] = *(const f32x4*)(rstd1 + col0 + bj * 128 + 4 * n);
        const int dcol0 = col0 + 64 * ((u.pn >> 4) + 1);
#pragma unroll
        for (int ai = 0; ai < 2; ++ai)
#pragma unroll
            for (int m = 0; m < 4; ++m) { bf16_t* rowp = VT + (size_t)(row0 + ai * 128 + m * 16) * (size_t)(NB * TPAD) + dcol0;
#pragma unroll
                for (int bj = 0; bj < 2; ++bj) { const f32x4 v0 = acc[ai][bj][m][0] * rs[bj][0], v1 = acc[ai][bj][m][1] * rs[bj][1];
                    u32x4 w; w.x = cvtpk(v0[0], v0[1]); w.y = cvtpk(v0[2], v0[3]); w.z = cvtpk(v1[0], v1[1]); w.w = cvtpk(v1[2], v1[3]);
                    *(u32x4*)(rowp + bj * 128) = w; } }
    }
};
struct EpiOut {
    const float* x; bf16_t* H1; unsigned char* A8; float* ssp; const float* gffn;
    __device__ __forceinline__ void operator()(const AccT& acc, const pg8::Unit& u, int wr, int wc, int fr, int fq) const {
        const int row0 = u.pm * 256 + wr * 64 + fr, col0 = u.pn * 256 + wc * 32 + 8 * fq;
        f32x4 g[2][2];
#pragma unroll
        for (int bj = 0; bj < 2; ++bj)
#pragma unroll
            for (int n = 0; n < 2; ++n) g[bj][n] = *(const f32x4*)(gffn + col0 + bj * 128 + 4 * n);
#pragma unroll
        for (int ai = 0; ai < 2; ++ai)
#pragma unroll
            for (int m = 0; m < 4; ++m) { const int r = row0 + ai * 128 + m * 16; const size_t ro = (size_t)r * DM + col0; float ss = 0.f;
#pragma unroll
                for (int bj = 0; bj < 2; ++bj) {
                    const f32x4 v0 = acc[ai][bj][m][0] + *(const f32x4*)(x + ro + bj * 128), v1 = acc[ai][bj][m][1] + *(const f32x4*)(x + ro + bj * 128 + 4);
                    ss += (v0[0] * v0[0] + v0[1] * v0[1]) + (v0[2] * v0[2] + v0[3] * v0[3]) + (v1[0] * v1[0] + v1[1] * v1[1]) + (v1[2] * v1[2] + v1[3] * v1[3]);
                    u32x4 w; w.x = cvtpk(v0[0], v0[1]); w.y = cvtpk(v0[2], v0[3]); w.z = cvtpk(v1[0], v1[1]); w.w = cvtpk(v1[2], v1[3]);
                    *(u32x4*)(H1 + ro + bj * 128) = w;
                    const f32x4 a0 = v0 * g[bj][0], a1 = v1 * g[bj][1];
                    u32x2 w8; w8.x = pk4_fp8(a0[0], a0[1], a0[2], a0[3]); w8.y = pk4_fp8(a1[0], a1[1], a1[2], a1[3]);
                    *(u32x2*)(A8 + ro + bj * 128) = w8; }
                ss += __shfl_xor(ss, 16); ss += __shfl_xor(ss, 32);
                if (fq == 0) ssp[(size_t)r * 16 + u.pn * 4 + wc] = ss; }
    }
};
struct EpiGU {
    unsigned char* hid; const float* bgu; const float* slot_rstd;
    __device__ __forceinline__ void operator()(const AccT& acc, const pg8::Unit& u, int wr, int wc, int fr, int fq) const {
        const int row0 = u.pm * 256 + wr * 64 + fr, colr = u.pn * 128 + wc * 32 + 8 * fq;
        const float* bg = bgu + (size_t)u.e * 2048 + colr;
        const f32x4 bg0 = *(const f32x4*)(bg), bg1 = *(const f32x4*)(bg + 4), bl0 = *(const f32x4*)(bg + 1024), bl1 = *(const f32x4*)(bg + 1028);
        float rsv[2][4];
#pragma unroll
        for (int ai = 0; ai < 2; ++ai)
#pragma unroll
            for (int m = 0; m < 4; ++m) rsv[ai][m] = slot_rstd[row0 + ai * 128 + m * 16];
#pragma unroll
        for (int ai = 0; ai < 2; ++ai)
#pragma unroll
            for (int m = 0; m < 4; ++m) { const int r = row0 + ai * 128 + m * 16; const float rs = rsv[ai][m] * WINV;
                float hv[8];
#pragma unroll
                for (int n = 0; n < 2; ++n)
#pragma unroll
                    for (int i = 0; i < 4; ++i) {
                        float gt = acc[ai][0][m][n][i] * rs + (n ? bg1[i] : bg0[i]), ln = acc[ai][1][m][n][i] * rs + (n ? bl1[i] : bl0[i]);
                        gt = fminf(gt, 7.0f); ln = fminf(fmaxf(ln, -7.0f), 7.0f);
                        const float sg = __builtin_amdgcn_rcpf(1.0f + ex2(gt * (-1.702f * LOG2E)));
                        hv[n * 4 + i] = (ln + 1.0f) * (gt * sg); }
                u32x2 w; w.x = pk4_fp8(hv[0], hv[1], hv[2], hv[3]); w.y = pk4_fp8(hv[4], hv[5], hv[6], hv[7]);
                *(u32x2*)(hid + (size_t)r * FF + colr) = w; }
    }
};
struct EpiDown {
    unsigned char* ys; const float* bd; const float* slot_gate;
    __device__ __forceinline__ void operator()(const AccT& acc, const pg8::Unit& u, int wr, int wc, int fr, int fq) const {
        const int row0 = u.pm * 256 + wr * 64 + fr, col0 = u.pn * 256 + wc * 32 + 8 * fq;
        f32x4 bv[2][2];
#pragma unroll
        for (int bj = 0; bj < 2; ++bj)
#pragma unroll
            for (int n = 0; n < 2; ++n) bv[bj][n] = *(const f32x4*)(bd + (size_t)u.e * DM + col0 + bj * 128 + 4 * n);
        float gtv[2][4];
#pragma unroll
        for (int ai = 0; ai < 2; ++ai)
#pragma unroll
            for (int m = 0; m < 4; ++m) gtv[ai][m] = slot_gate[row0 + ai * 128 + m * 16] * YSCALE;
#pragma unroll
        for (int ai = 0; ai < 2; ++ai)
#pragma unroll
            for (int m = 0; m < 4; ++m) { const int r = row0 + ai * 128 + m * 16; const float gt = gtv[ai][m];
                unsigned char* rowp = ys + (size_t)r * DM + col0;
#pragma unroll
                for (int bj = 0; bj < 2; ++bj) { const f32x4 v0 = (acc[ai][bj][m][0] * WINV + bv[bj][0]) * gt, v1 = (acc[ai][bj][m][1] * WINV + bv[bj][1]) * gt;
                    u32x2 w; w.x = pk4_fp8(v0[0], v0[1], v0[2], v0[3]); w.y = pk4_fp8(v1[0], v1[1], v1[2], v1[3]);
                    *(u32x2*)(rowp + bj * 128) = w; } }
    }
};

struct Args { const float* in[17]; float* out; unsigned char* ws; int ph_lo, ph_hi; };
struct Frame {
    LAS unsigned char* lds; gu32* ctl; int tid, lane, wave, vcu, G;
    const float *x, *meta, *g_mix, *w_in, *g_attn, *conv_w, *conv_b, *g_conv, *w_out, *g_ffn, *w_router, *b_router, *w_gu, *b_gu, *w_down, *b_down, *g_final;
    float* out; unsigned char* ws;
};
template <class T> __device__ __forceinline__ T* wsp(const Frame& F, size_t off) { return (T*)(F.ws + off); }

__device__ __forceinline__ void p0_transpose_item(const float* W, int ldw, int k0, int n0, bf16_t* WT, int Kd, int drow0, LAS unsigned* scr, int lane) {
    const int ks = lane >> 4, n4 = lane & 15;
    f32x4 va[8], vb[8];
    const float* src = W + (size_t)(k0 + 2 * ks) * ldw + n0 + 4 * n4;
#pragma unroll
    for (int i = 0; i < 8; ++i) { va[i] = *(const f32x4*)(src + (size_t)(8 * i) * ldw); vb[i] = *(const f32x4*)(src + (size_t)(8 * i + 1) * ldw); }
#pragma unroll
    for (int i = 0; i < 8; ++i)
#pragma unroll
        for (int j = 0; j < 4; ++j) scr[(4 * n4 + j) * 33 + 4 * i + ks] = cvtpk(va[i][j], vb[i][j]);
    LDS_WAIT(); asm volatile("" ::: "memory");
    const int ns = lane >> 3, c = lane & 7;
#pragma unroll
    for (int r = 0; r < 8; ++r) { const int n = 8 * r + ns; const LAS unsigned* t = scr + n * 33 + 4 * c;
        u32x4 o; o.x = t[0]; o.y = t[1]; o.z = t[2]; o.w = t[3];
        *(u32x4*)(WT + (size_t)(drow0 + n) * Kd + k0 + 8 * c) = o; }
    LDS_WAIT(); asm volatile("" ::: "memory");
}
__device__ __forceinline__ void p0_transpose_item8(const float* W, int ldw, int k0, int n0, unsigned char* WT8, int Kd, int drow0, LAS unsigned* scr, int lane) {
    const int ks = lane >> 4, n4 = lane & 15;
#pragma unroll
    for (int h = 0; h < 2; ++h) {
        f32x4 v[4][4];
        const float* src = W + (size_t)(k0 + 64 * h + 4 * ks) * ldw + n0 + 4 * n4;
#pragma unroll
        for (int i = 0; i < 4; ++i)
#pragma unroll
            for (int q = 0; q < 4; ++q) v[i][q] = *(const f32x4*)(src + (size_t)(16 * i + q) * ldw);
#pragma unroll
        for (int i = 0; i < 4; ++i)
#pragma unroll
            for (int j = 0; j < 4; ++j) scr[(4 * n4 + j) * 33 + 16 * h + 4 * i + ks] = pk4_fp8(v[i][0][j] * WSCALE, v[i][1][j] * WSCALE, v[i][2][j] * WSCALE, v[i][3][j] * WSCALE);
    }
    LDS_WAIT(); asm volatile("" ::: "memory");
    const int ns = lane >> 3, c = lane & 7;
#pragma unroll
    for (int r = 0; r < 8; ++r) { const int n = 8 * r + ns; const LAS unsigned* t = scr + n * 33 + 4 * c;
        u32x4 o; o.x = t[0]; o.y = t[1]; o.z = t[2]; o.w = t[3];
        *(u32x4*)(WT8 + (size_t)(drow0 + n) * Kd + k0 + 16 * c) = o; }
    LDS_WAIT(); asm volatile("" ::: "memory");
}
__device__ __forceinline__ void p0_meta_job(Frame& F, int mw) {
    LAS float* nm = (LAS float*)F.lds;
    LAS float* part = (LAS float*)(F.lds + 65536);
    for (int t = F.wave * 2; t < F.wave * 2 + 2; ++t) {
        float v[16]; float ss = 0.f;
#pragma unroll
        for (int j = 0; j < 16; ++j) { v[j] = F.meta[t * DM + j * 64 + F.lane]; ss += v[j] * v[j]; }
        const float rstd = 1.0f / sqrtf(wave_sum(ss) * (1.0f / DM) + RMS_EPS);
#pragma unroll
        for (int j = 0; j < 16; ++j) { const int k = j * 64 + F.lane; nm[k * 16 + t] = v[j] * rstd * F.g_mix[k]; }
    }
    __syncthreads();
    const int kq = F.tid >> 7, c = F.tid & 127, j = mw * 128 + c, sec4 = j >> 9, jc = j & 511;
    const int ocol = (sec4 == 0 ? 512 : sec4 == 1 ? 1024 : sec4 == 2 ? 2048 : 2560) + jc;
    float acc[16];
#pragma unroll
    for (int t = 0; t < 16; ++t) acc[t] = 0.f;
    for (int kk = kq * 256; kk < kq * 256 + 256; kk += 16) {
        float wv[16];
#pragma unroll
        for (int u = 0; u < 16; ++u) wv[u] = F.w_in[(size_t)(kk + u) * 3072 + ocol];
#pragma unroll
        for (int u = 0; u < 16; ++u) { const float w = wv[u];
            const LAS f32x4* nv = (const LAS f32x4*)(nm + (kk + u) * 16);
#pragma unroll
            for (int q = 0; q < 4; ++q) { const f32x4 n4 = nv[q]; acc[4 * q] += w * n4[0]; acc[4 * q + 1] += w * n4[1]; acc[4 * q + 2] += w * n4[2]; acc[4 * q + 3] += w * n4[3]; } }
    }
#pragma unroll
    for (int t = 0; t < 16; ++t) part[(kq * 128 + c) * 16 + t] = acc[t];
    __syncthreads();
    {
        const int tq = F.tid >> 7;
        bf16_t* KB = wsp<bf16_t>(F, WS_KB); bf16_t* VT = wsp<bf16_t>(F, WS_VT); float* MT = wsp<float>(F, WS_META);
#pragma unroll
        for (int tt = 0; tt < 4; ++tt) { const int t = 4 * tq + tt;
            const float v = (part[(0 * 128 + c) * 16 + t] + part[(1 * 128 + c) * 16 + t]) + (part[(2 * 128 + c) * 16 + t] + part[(3 * 128 + c) * 16 + t]);
            const bf16_t bv = (bf16_t)(cvtpk(v, 0.f) & 0xffffu);
            if (sec4 == 0) { for (int b = 0; b < NB; ++b) KB[(size_t)(b * TPAD + KPAD + t) * 512 + jc] = bv; }
            else if (sec4 == 1) { for (int b = 0; b < NB; ++b) VT[(size_t)jc * (NB * TPAD) + b * TPAD + KPAD + t] = bv; }
            else if (t >= 14) MT[((sec4 - 2) * 2 + (t - 14)) * 512 + jc] = v;
        }
    }
    __syncthreads();
}
__device__ __forceinline__ void p0_prologue(Frame& F) {
    constexpr int NMW = 16;
    if (F.vcu < NMW) {
        p0_meta_job(F, F.vcu);
        bf16_t* KB = wsp<bf16_t>(F, WS_KB); bf16_t* VT = wsp<bf16_t>(F, WS_VT);
        const int gt = F.vcu * 512 + F.tid, NT = NMW * 512;
        for (int i = gt; i < NB * KPAD * 64; i += NT) { const int b = i / (KPAD * 64), r = i % (KPAD * 64); *(u32x4*)(KB + (size_t)(b * TPAD) * 512 + (size_t)r * 8) = (u32x4){0u, 0u, 0u, 0u}; }
        for (int i = gt; i < 512 * NB * 6; i += NT) { const int ch = i / (NB * 6), r = i % (NB * 6), b = r / 6, q = r % 6; *(u32x4*)(VT + (size_t)ch * (NB * TPAD) + b * TPAD + q * 8) = (u32x4){0u, 0u, 0u, 0u}; }
        return;
    }
    const int gw = (F.vcu - NMW) * NWAVES + F.wave, NGW = (F.G - NMW) * NWAVES;
    {
        float* rstd1 = wsp<float>(F, WS_RSTD1); bf16_t* A1 = wsp<bf16_t>(F, WS_A);
        f32x4 g4[4];
#pragma unroll
        for (int j = 0; j < 4; ++j) g4[j] = *(const f32x4*)(F.g_mix + 256 * j + 4 * F.lane);
        for (int m = gw; m < NTOK; m += NGW) {
            const f32x4* xr = (const f32x4*)(F.x + (size_t)m * DM) + F.lane;
            f32x4 v[4]; float s = 0.f;
#pragma unroll
            for (int j = 0; j < 4; ++j) { v[j] = xr[64 * j]; s += (v[j][0] * v[j][0] + v[j][1] * v[j][1]) + (v[j][2] * v[j][2] + v[j][3] * v[j][3]); }
            s = wave_sum(s);
            if (F.lane == 0) rstd1[m] = 1.0f / sqrtf(s * (1.0f / DM) + RMS_EPS);
            u32x2* o8 = (u32x2*)(A1 + (size_t)m * DM) + F.lane;
#pragma unroll
            for (int j = 0; j < 4; ++j) { const f32x4 a = v[j] * g4[j]; u32x2 o; o.x = cvtpk(a[0], a[1]); o.y = cvtpk(a[2], a[3]); o8[64 * j] = o; }
        }
    }
    {
        LAS unsigned* scr = (LAS unsigned*)(F.lds + F.wave * 8704);
        constexpr int I_IN = 16 * 48, I_OUT = 16 * 16, I_GU = 32 * 8 * 32, I_D = 32 * 8 * 16, NITEMS = I_IN + I_OUT + I_GU + I_D;
        bf16_t* WIN = wsp<bf16_t>(F, WS_WIN); bf16_t* WOUT = wsp<bf16_t>(F, WS_WOUT); unsigned char* WGU = wsp<unsigned char>(F, WS_WGU); unsigned char* WD = wsp<unsigned char>(F, WS_WD);
        for (int it = gw; it < NITEMS; it += NGW) {
            int r = it;
            if (r < I_IN) { const int kb = r / 48, nb = r % 48, n0 = 64 * nb, sec = n0 >> 9;
                const int dsec = sec == 0 ? 0 : sec == 1 ? 1 : sec == 2 ? 5 : sec - 1;
                p0_transpose_item(F.w_in, 3072, 64 * kb, n0, WIN, DM, dsec * 512 + (n0 & 511), scr, F.lane); continue; }
            r -= I_IN;
            if (r < I_OUT) { const int kb = r / 16, nb = r % 16; p0_transpose_item(F.w_out, 1024, 64 * kb, 64 * nb, WOUT, DM, 64 * nb, scr, F.lane); continue; }
            r -= I_OUT;
            if (r < I_GU) { const int e = r / 256, q = r % 256, kb = q / 32, nb = q % 32, n0 = 64 * nb, c = n0 & 1023;
                const int drow = (c >> 7) * 256 + (n0 >= 1024 ? 128 : 0) + (c & 127);
                p0_transpose_item8(F.w_gu + (size_t)e * 1024 * 2048, 2048, 128 * kb, n0, WGU + (size_t)e * 2048 * 1024, DM, drow, scr, F.lane); continue; }
            r -= I_GU;
            { const int e = r / 128, q = r % 128, kb = q / 16, nb = q % 16;
                p0_transpose_item8(F.w_down + (size_t)e * 1024 * 1024, 1024, 128 * kb, 64 * nb, WD + (size_t)e * 1024 * 1024, FF, 64 * nb, scr, F.lane); }
        }
    }
}

template <bool EDGE>
__device__ __forceinline__ void sb_tile(f32x16& s0, f32x16& s1, float& carry, int kp0  , int qpos, bool hi0, bf16x8 (&pf)[2][2]) {
    float R[4];
#pragma unroll
    for (int q = 0; q < 4; ++q) {
        float S = 0.f;
#pragma unroll
        for (int i = 7; i >= 0; --i) {
            const int r = (q & 1) * 8 + i;
            const float z = (q < 2) ? s0[r] : s1[r];
            const float L = lg2(1.0f + ex2(-fabsf(z)));
            float sp = fmaxf(z, 0.f) + L; float ls = z - sp;
            if (EDGE) { const int kp = kp0 + 16 * q + i; const bool valid = (kp < qpos) && (kp >= KPAD); sp = valid ? sp : 0.f; ls = valid ? ls : -INFINITY; }
            const float m = ls - S; S += sp;
            if (q < 2) s0[r] = m; else s1[r] = m;
        }
        R[q] = S;
        __builtin_amdgcn_sched_barrier(0);
    }
    const float P0 = __shfl_xor(R[0], 32), P1 = __shfl_xor(R[1], 32), P2 = __shfl_xor(R[2], 32), P3 = __shfl_xor(R[3], 32);
    const float T0 = R[0] + P0, T1 = R[1] + P1, T2 = R[2] + P2, T3 = R[3] + P3;
    const float b3 = carry - (hi0 ? P3 : 0.f), b2 = carry - (T3 + (hi0 ? P2 : 0.f)), b1 = carry - ((T3 + T2) + (hi0 ? P1 : 0.f)), b0 = carry - ((T3 + T2 + T1) + (hi0 ? P0 : 0.f));
#pragma unroll
    for (int i = 0; i < 8; ++i) { s0[i] = ex2(s0[i] + b0); s0[8 + i] = ex2(s0[8 + i] + b1); s1[i] = ex2(s1[i] + b2); s1[8 + i] = ex2(s1[8 + i] + b3); }
    carry -= (T0 + T1) + (T2 + T3);
    u32x4 w;
    w.x = cvtpk(s0[0], s0[1]); w.y = cvtpk(s0[2], s0[3]); w.z = cvtpk(s0[4], s0[5]); w.w = cvtpk(s0[6], s0[7]); pf[0][0] = __builtin_bit_cast(bf16x8, w);
    w.x = cvtpk(s0[8], s0[9]); w.y = cvtpk(s0[10], s0[11]); w.z = cvtpk(s0[12], s0[13]); w.w = cvtpk(s0[14], s0[15]); pf[0][1] = __builtin_bit_cast(bf16x8, w);
    w.x = cvtpk(s1[0], s1[1]); w.y = cvtpk(s1[2], s1[3]); w.z = cvtpk(s1[4], s1[5]); w.w = cvtpk(s1[6], s1[7]); pf[1][0] = __builtin_bit_cast(bf16x8, w);
    w.x = cvtpk(s1[8], s1[9]); w.y = cvtpk(s1[10], s1[11]); w.z = cvtpk(s1[12], s1[13]); w.w = cvtpk(s1[14], s1[15]); pf[1][1] = __builtin_bit_cast(bf16x8, w);
}
#define MFMA32(a, b, c) __builtin_amdgcn_mfma_f32_32x32x16_bf16((a), (b), (c), 0, 0, 0)
__device__ __forceinline__ void p2_unit(Frame& F, int b, int qb) {
    int lane_ = F.lane, head_ = F.wave;
    asm volatile("" : "+v"(lane_), "+s"(head_));
    const int lane = lane_, head = head_, l31 = lane & 31, hi = lane >> 5; const bool hi0 = hi == 0;
    const bf16_t* Q = wsp<bf16_t>(F, WS_Q); const bf16_t* KB = wsp<bf16_t>(F, WS_KB); const bf16_t* VT = wsp<bf16_t>(F, WS_VT);
    bf16_t* MX = wsp<bf16_t>(F, WS_MIXED);
    LAS float* ssA = (LAS float*)F.lds;
    LAS float* ssC = (LAS float*)(F.lds + 1024);
    const int row0 = b * SEQ + qb * 32;
#ifndef P2_SKIP_CONV
    {
        const int cgp = lane & 7, rg = lane >> 3, ch0 = head * 64 + cgp * 8;
        const bf16_t* CB = wsp<bf16_t>(F, WS_CB); const bf16_t* CC = wsp<bf16_t>(F, WS_CC); const bf16_t* CX = wsp<bf16_t>(F, WS_CX); const float* MT = wsp<float>(F, WS_META);
        float cv[4][8];
        {
            float w0[8], w1[8], w2[8], bs[8], u2[8], u1[8];
#pragma unroll
            for (int k = 0; k < 8; ++k) { w0[k] = F.conv_w[ch0 + k]; w1[k] = F.conv_w[512 + ch0 + k]; w2[k] = F.conv_w[1024 + ch0 + k]; bs[k] = F.conv_b[ch0 + k]; u2[k] = 0.f; u1[k] = 0.f; }
#pragma unroll
            for (int i = -2; i < 4; ++i) {
                const int sl = qb * 32 + rg * 4 + i;
                float u[8];
                if (sl >= 0) {
                    const size_t ro = (size_t)(b * SEQ + sl) * 512 + ch0;
                    const u32x4 c4 = *(const u32x4*)(CC + ro), x4 = *(const u32x4*)(CX + ro);
                    u[0] = bflo(c4.x) * bflo(x4.x); u[1] = bfhi(c4.x) * bfhi(x4.x); u[2] = bflo(c4.y) * bflo(x4.y); u[3] = bfhi(c4.y) * bfhi(x4.y);
                    u[4] = bflo(c4.z) * bflo(x4.z); u[5] = bfhi(c4.z) * bfhi(x4.z); u[6] = bflo(c4.w) * bflo(x4.w); u[7] = bfhi(c4.w) * bfhi(x4.w);
                } else {
                    const int mt = 2 + sl;
                    const f32x4 c0 = *(const f32x4*)(MT + mt * 512 + ch0), c1 = *(const f32x4*)(MT + mt * 512 + ch0 + 4), x0 = *(const f32x4*)(MT + (2 + mt) * 512 + ch0), x1 = *(const f32x4*)(MT + (2 + mt) * 512 + ch0 + 4);
#pragma unroll
                    for (int k = 0; k < 4; ++k) { u[k] = c0[k] * x0[k]; u[4 + k] = c1[k] * x1[k]; }
                }
                if (i >= 0) {
                    const u32x4 b4 = *(const u32x4*)(CB + (size_t)(b * SEQ + sl) * 512 + ch0);
                    const float cbv[8] = {bflo(b4.x), bfhi(b4.x), bflo(b4.y), bfhi(b4.y), bflo(b4.z), bfhi(b4.z), bflo(b4.w), bfhi(b4.w)};
#pragma unroll
                    for (int k = 0; k < 8; ++k) cv[i < 0 ? 0 : i][k] = cbv[k] * (w0[k] * u2[k] + w1[k] * u1[k] + w2[k] * u[k] + bs[k]);
                }
#pragma unroll
                for (int k = 0; k < 8; ++k) { u2[k] = u1[k]; u1[k] = u[k]; }
            }
        }
#pragma unroll
        for (int i = 0; i < 4; ++i) { float ss = 0.f;
#pragma unroll
            for (int k = 0; k < 8; ++k) ss += cv[i][k] * cv[i][k];
            ss += __shfl_xor(ss, 1); ss += __shfl_xor(ss, 2); ss += __shfl_xor(ss, 4);
            if (cgp == 0) ssC[head * 32 + rg * 4 + i] = ss; }
        __syncthreads();
        const f32x4 gc0 = *(const f32x4*)(F.g_conv + ch0), gc1 = *(const f32x4*)(F.g_conv + ch0 + 4);
#pragma unroll
        for (int i = 0; i < 4; ++i) { const int rl = rg * 4 + i; float tot = 0.f;
#pragma unroll
            for (int w = 0; w < 8; ++w) tot += ssC[w * 32 + rl];
            const float rstd = 1.0f / sqrtf(tot * (1.0f / AW) + RMS_EPS);
            u32x4 w4; w4.x = cvtpk(cv[i][0] * rstd * gc0[0], cv[i][1] * rstd * gc0[1]); w4.y = cvtpk(cv[i][2] * rstd * gc0[2], cv[i][3] * rstd * gc0[3]);
            w4.z = cvtpk(cv[i][4] * rstd * gc1[0], cv[i][5] * rstd * gc1[1]); w4.w = cvtpk(cv[i][6] * rstd * gc1[2], cv[i][7] * rstd * gc1[3]);
            *(u32x4*)(MX + (size_t)(row0 + rl) * DM + 512 + ch0) = w4; }
    }
#endif
#ifndef P2_SKIP_ATT
    LAS bf16x8* qlds = (LAS bf16x8*)(F.lds + 4096 + head * 4096) + lane;
    {
        const bf16_t* Qp = Q + (size_t)(row0 + l31) * 512 + head * 64 + hi * 8;
#pragma unroll
        for (int s = 0; s < 4; ++s) qlds[s * 64] = *(const bf16x8*)(Qp + s * 16);
    }
    f32x16 o[2];
#pragma unroll
    for (int d = 0; d < 2; ++d)
#pragma unroll
        for (int r = 0; r < 16; ++r) o[d][r] = 0.f;
    float carry = 0.f;
    const int pi = (l31 & 0x13) | ((l31 & 4) << 1) | ((l31 & 8) >> 1);
    const __amdgpu_buffer_rsrc_t rsK = __builtin_amdgcn_make_buffer_rsrc((void*)(KB + (size_t)b * TPAD * 512), (short)0, TPAD * 512 * 2, 0x00020000);
    const __amdgpu_buffer_rsrc_t rsV = __builtin_amdgcn_make_buffer_rsrc((void*)(VT + (size_t)b * TPAD), (short)0, (511 * NB * TPAD + TPAD) * 2, 0x00020000);
    const int voffK = (pi * 512 + head * 64 + hi * 8) * 2;
    const int voffV = ((head * 64 + l31) * (NB * TPAD) + hi * 8) * 2;
    const int P0 = QOFF + 32 * qb, qpos = P0 + l31;
    for (int start = P0 - 32; ; start -= 64) {
        bf16x8 kf[2][4];
#pragma unroll
        for (int kb = 0; kb < 2; ++kb)
#pragma unroll
            for (int s = 0; s < 4; ++s) kf[kb][s] = __builtin_bit_cast(bf16x8, __builtin_amdgcn_raw_buffer_load_b128(rsK, voffK + kb * 32768 + s * 32, start * 1024, 0));
        bf16x8 vf[2][2][2];
#pragma unroll
        for (int d = 0; d < 2; ++d)
#pragma unroll
            for (int kb = 0; kb < 2; ++kb)
#pragma unroll
                for (int s2 = 0; s2 < 2; ++s2) vf[d][kb][s2] = __builtin_bit_cast(bf16x8, __builtin_amdgcn_raw_buffer_load_b128(rsV, voffV + d * (32 * NB * TPAD * 2) + kb * 64 + s2 * 32, start * 2, 0));
        const bool lastt = start <= KPAD;
        const bool edge = (start == P0 - 32) || lastt;
        f32x16 s0, s1;
#pragma unroll
        for (int r = 0; r < 16; ++r) { s0[r] = 0.f; s1[r] = 0.f; }
#pragma unroll
        for (int s = 0; s < 4; ++s) { const bf16x8 qf = qlds[s * 64]; s0 = MFMA32(kf[0][s], qf, s0); s1 = MFMA32(kf[1][s], qf, s1); }
        bf16x8 pf[2][2];
        if (edge) sb_tile<true>(s0, s1, carry, start + 8 * hi, qpos, hi0, pf);
        else sb_tile<false>(s0, s1, carry, start + 8 * hi, qpos, hi0, pf);
#pragma unroll
        for (int d = 0; d < 2; ++d)
#pragma unroll
            for (int kb = 0; kb < 2; ++kb)
#pragma unroll
                for (int s2 = 0; s2 < 2; ++s2) o[d] = MFMA32(vf[d][kb][s2], pf[kb][s2], o[d]);
        if (lastt || __all(carry < EXIT_THR)) break;
    }
    int lane2 = lane; asm volatile("" : "+v"(lane2));
    const int l31b = lane2 & 31, hib = lane2 >> 5;
    {
        float ss = 0.f;
#pragma unroll
        for (int d = 0; d < 2; ++d)
#pragma unroll
            for (int r = 0; r < 16; ++r) ss += o[d][r] * o[d][r];
        ss += __shfl_xor(ss, 32);
        if (hib == 0) ssA[head * 32 + l31b] = ss;
    }
    __syncthreads();
    {
        float tot = 0.f;
#pragma unroll
        for (int h = 0; h < 8; ++h) tot += ssA[h * 32 + l31b];
        const float rstd = 1.0f / sqrtf(tot * (1.0f / AW) + RMS_EPS);
        bf16_t* orow = MX + (size_t)(row0 + l31b) * DM + head * 64 + 4 * hib;
#pragma unroll
        for (int d = 0; d < 2; ++d)
#pragma unroll
            for (int g = 0; g < 4; ++g) { const f32x4 ga = *(const f32x4*)(F.g_attn + head * 64 + 32 * d + 8 * g + 4 * hib);
                u32x2 w; w.x = cvtpk(o[d][4 * g] * rstd * ga[0], o[d][4 * g + 1] * rstd * ga[1]); w.y = cvtpk(o[d][4 * g + 2] * rstd * ga[2], o[d][4 * g + 3] * rstd * ga[3]);
                *(u32x2*)(orow + 32 * d + 8 * g) = w; }
    }
    __syncthreads();
#endif
}

__device__ __forceinline__ void p4_router(Frame& F) {
    LAS unsigned char* img = F.lds;
    LAS int* hist = (LAS int*)(F.lds + 65536);
    for (int idx = F.tid; idx < 64 * 2 * 32; idx += 512) { const int s = idx >> 6, h = (idx >> 5) & 1, e = idx & 31; const int k0 = 16 * s + 8 * h; const float* wp = F.w_router + (size_t)k0 * NE + e; const float* gp = F.g_ffn + k0;
        u32x4 w; w.x = cvtpk(wp[0] * gp[0], wp[NE] * gp[1]); w.y = cvtpk(wp[2 * NE] * gp[2], wp[3 * NE] * gp[3]); w.z = cvtpk(wp[4 * NE] * gp[4], wp[5 * NE] * gp[5]); w.w = cvtpk(wp[6 * NE] * gp[6], wp[7 * NE] * gp[7]);
        *(LAS u32x4*)(img + idx * 16) = w; }
    if (F.tid < 32) hist[F.tid] = 0;
    __syncthreads();
    const bf16_t* A2 = wsp<bf16_t>(F, WS_A); const float* ssp = wsp<float>(F, WS_SSP); float* rstd2 = wsp<float>(F, WS_RSTD2);
    int* tope = wsp<int>(F, WS_TOPE); float* gate = wsp<float>(F, WS_GATE); int* cnt = wsp<int>(F, WS_CNT);
    const int wg = F.vcu;
    if (F.wave < 4) {
        const int l31 = F.lane & 31, hi = F.lane >> 5, row = wg * 128 + F.wave * 32 + l31;
        f32x16 acc;
#pragma unroll
        for (int r = 0; r < 16; ++r) acc[r] = 0.f;
        const bf16_t* ap = A2 + (size_t)row * DM + 8 * hi;
#pragma unroll 8
        for (int s = 0; s < 64; ++s) { const bf16x8 a = *(const LAS bf16x8*)(img + ((s * 2 + hi) * 32 + l31) * 16); const bf16x8 bq = *(const bf16x8*)(ap + 16 * s); acc = MFMA32(a, bq, acc); }
        float ss = 0.f;
#pragma unroll
        for (int q = 0; q < 4; ++q) { const f32x4 p4 = *(const f32x4*)(ssp + (size_t)row * 16 + 4 * q); ss += (p4[0] + p4[1]) + (p4[2] + p4[3]); }
        const float rstd = 1.0f / sqrtf(ss * (1.0f / DM) + RMS_EPS);
        float lg[16];
#pragma unroll
        for (int r = 0; r < 16; ++r) lg[r] = acc[r] * rstd + F.b_router[(r & 3) + 8 * (r >> 2) + 4 * hi];
        float cvv[8]; int cei[8];
#pragma unroll
        for (int k = 0; k < 4; ++k) { float best = -INFINITY; int bi = 0;
#pragma unroll
            for (int r = 0; r < 16; ++r) { const bool gtb = lg[r] > best; best = gtb ? lg[r] : best; bi = gtb ? r : bi; }
#pragma unroll
            for (int r = 0; r < 16; ++r) lg[r] = (r == bi) ? -INFINITY : lg[r];
            cvv[k] = best; cei[k] = (bi & 3) + 8 * (bi >> 2) + 4 * hi; }
#pragma unroll
        for (int k = 0; k < 4; ++k) { cvv[4 + k] = __shfl_xor(cvv[k], 32); cei[4 + k] = __shfl_xor(cei[k], 32); }
        float tv[4]; int te[4];
#pragma unroll
        for (int k = 0; k < 4; ++k) { float best = -INFINITY; int be = 1 << 30, bi = 0;
#pragma unroll
            for (int c = 0; c < 8; ++c) { const bool better = (cvv[c] > best) || (cvv[c] == best && cei[c] < be); best = better ? cvv[c] : best; be = better ? cei[c] : be; bi = better ? c : bi; }
#pragma unroll
            for (int c = 0; c < 8; ++c) { const bool hit = (c == bi); cvv[c] = hit ? -INFINITY : cvv[c]; cei[c] = hit ? (1 << 30) : cei[c]; }
            tv[k] = best; te[k] = be; }
        const float e1 = ex2((tv[1] - tv[0]) * LOG2E), e2 = ex2((tv[2] - tv[0]) * LOG2E), e3 = ex2((tv[3] - tv[0]) * LOG2E);
        const float inv = 1.0f / (1.0f + e1 + e2 + e3);
        if (hi == 0) {
            rstd2[row] = rstd;
            *(i32x4*)(tope + (size_t)row * 4) = (i32x4){te[0], te[1], te[2], te[3]};
            *(f32x4*)(gate + (size_t)row * 4) = (f32x4){inv, e1 * inv, e2 * inv, e3 * inv};
#pragma unroll
            for (int k = 0; k < 4; ++k) atomicAdd((int*)(hist + te[k]), 1);
        }
    }
    __syncthreads();
    if (F.tid < 32) cnt[wg * 32 + F.tid] = hist[F.tid];
    __syncthreads();
}

__device__ __forceinline__ void p5_scatter(Frame& F) {
    LAS int* tot = (LAS int*)F.lds; LAS int* pre = tot + 32; LAS int* ctr = tot + 64; LAS int* pstart = tot + 96;
    const int* cnt = wsp<int>(F, WS_CNT); const int wg = F.vcu;
    if (F.tid < 64) tot[F.tid] = 0;
    __syncthreads();
    { const int e = F.tid & 31, j = F.tid >> 5; int t = 0, p = 0;
        for (int w = j; w < 256; w += 16) { const int c = ld_i(cnt + w * 32 + e); t += c; p += (w < wg) ? c : 0; }
        atomicAdd((int*)(tot + e), t); atomicAdd((int*)(pre + e), p); }
    __syncthreads();
    if (F.tid == 0) { int run = 0; for (int e = 0; e < 32; ++e) { pstart[e] = run; run += (tot[e] + 255) & ~255; } pstart[32] = run; }
    __syncthreads();
    if (F.tid < 32) ctr[F.tid] = pstart[F.tid] + pre[F.tid];
    int* slot_tok = wsp<int>(F, WS_SLOTTOK); float* slot_gate = wsp<float>(F, WS_SLOTGATE); float* slot_rstd = wsp<float>(F, WS_SLOTRSTD);
    int* tile_e = wsp<int>(F, WS_TILEE);
    if (wg == 0) {
        if (F.tid < 32) { for (int rt = pstart[F.tid] >> 8; rt < (pstart[F.tid + 1] >> 8); ++rt) tile_e[rt] = F.tid; }
        if (F.tid == 0) tile_e[CAP_TILES] = pstart[32] >> 8;
    }
    if (wg < 32) { const int e = wg; for (int s = pstart[e] + tot[e] + F.tid; s < pstart[e + 1]; s += 512) { slot_tok[s] = 0; slot_gate[s] = 0.f; slot_rstd[s] = 0.f; } }
    __syncthreads();
    { const int tok = wg * 128 + (F.tid >> 2), k = F.tid & 3;
        const int e = ld_i(wsp<int>(F, WS_TOPE) + tok * 4 + k);
        const int slot = atomicAdd((int*)(ctr + e), 1);
        slot_tok[slot] = tok; slot_gate[slot] = ld_f(wsp<float>(F, WS_GATE) + tok * 4 + k); slot_rstd[slot] = ld_f(wsp<float>(F, WS_RSTD2) + tok);
        wsp<int>(F, WS_TOKSLOT)[tok * 4 + k] = slot; }
    __syncthreads();
}

__device__ __forceinline__ void p8_combine(Frame& F, float* dst) {
    const int gw = F.vcu * NWAVES + F.wave, NGW = F.G * NWAVES;
    const unsigned char* ys = wsp<unsigned char>(F, WS_YS); const int* tokslot = wsp<int>(F, WS_TOKSLOT); const bf16_t* H1 = wsp<bf16_t>(F, WS_A);
    f32x4 gf[2][2];
#pragma unroll
    for (int j = 0; j < 2; ++j) { gf[j][0] = *(const f32x4*)(F.g_final + 512 * j + 8 * F.lane); gf[j][1] = *(const f32x4*)(F.g_final + 512 * j + 8 * F.lane + 4); }
    for (int m0 = gw; m0 < NTOK; m0 += 16 * NGW) {
        const int mrow = m0 + (F.lane >> 2) * NGW;
        const int myslot = (mrow < NTOK) ? ld_i(tokslot + (size_t)mrow * 4 + (F.lane & 3)) : 0;
#pragma unroll 1
        for (int r = 0; r < 16; r += 2) {
            const int ma = m0 + r * NGW, mb = ma + NGW;
            if (ma >= NTOK) break;
            const bool hasb = mb < NTOK; const int mbb = hasb ? mb : ma;
            int sa[4], sb[4];
#pragma unroll
            for (int k = 0; k < 4; ++k) { sa[k] = __builtin_amdgcn_readfirstlane(__shfl(myslot, 4 * r + k)); sb[k] = __builtin_amdgcn_readfirstlane(__shfl(myslot, 4 * r + 4 + k)); }
            u32x4 ha[2], hb[2]; u32x2 ya[2][4], yb[2][4];
#pragma unroll
            for (int j = 0; j < 2; ++j) { ha[j] = *(const u32x4*)(H1 + (size_t)ma * DM + 512 * j + 8 * F.lane); hb[j] = *(const u32x4*)(H1 + (size_t)mbb * DM + 512 * j + 8 * F.lane);
#pragma unroll
                for (int k = 0; k < 4; ++k) { ya[j][k] = *(const u32x2*)(ys + (size_t)sa[k] * DM + 512 * j + 8 * F.lane); yb[j][k] = *(const u32x2*)(ys + (size_t)sb[k] * DM + 512 * j + 8 * F.lane); } }
            f32x4 va[2][2], vb[2][2]; float ssa = 0.f, ssb = 0.f;
#pragma unroll
            for (int j = 0; j < 2; ++j) {
                f32x4 ea0 = {0.f, 0.f, 0.f, 0.f}, ea1 = ea0, eb0 = ea0, eb1 = ea0;
#pragma unroll
                for (int k = 0; k < 4; ++k) { const u32x2 y = ya[j][k], z = yb[j][k];
                    const f32x2 y0 = fp8lo(y.x), y1 = fp8hi(y.x), y2 = fp8lo(y.y), y3 = fp8hi(y.y), z0 = fp8lo(z.x), z1 = fp8hi(z.x), z2 = fp8lo(z.y), z3 = fp8hi(z.y);
                    ea0[0] += y0[0]; ea0[1] += y0[1]; ea0[2] += y1[0]; ea0[3] += y1[1]; ea1[0] += y2[0]; ea1[1] += y2[1]; ea1[2] += y3[0]; ea1[3] += y3[1];
                    eb0[0] += z0[0]; eb0[1] += z0[1]; eb0[2] += z1[0]; eb0[3] += z1[1]; eb1[0] += z2[0]; eb1[1] += z2[1]; eb1[2] += z3[0]; eb1[3] += z3[1]; }
                va[j][0] = (f32x4){bflo(ha[j].x), bfhi(ha[j].x), bflo(ha[j].y), bfhi(ha[j].y)} + ea0 * YINV; va[j][1] = (f32x4){bflo(ha[j].z), bfhi(ha[j].z), bflo(ha[j].w), bfhi(ha[j].w)} + ea1 * YINV;
                vb[j][0] = (f32x4){bflo(hb[j].x), bfhi(hb[j].x), bflo(hb[j].y), bfhi(hb[j].y)} + eb0 * YINV; vb[j][1] = (f32x4){bflo(hb[j].z), bfhi(hb[j].z), bflo(hb[j].w), bfhi(hb[j].w)} + eb1 * YINV;
#pragma unroll
                for (int q = 0; q < 2; ++q) { ssa += (va[j][q][0] * va[j][q][0] + va[j][q][1] * va[j][q][1]) + (va[j][q][2] * va[j][q][2] + va[j][q][3] * va[j][q][3]);
                    ssb += (vb[j][q][0] * vb[j][q][0] + vb[j][q][1] * vb[j][q][1]) + (vb[j][q][2] * vb[j][q][2] + vb[j][q][3] * vb[j][q][3]); } }
            const float ra = 1.0f / sqrtf(wave_sum(ssa) * (1.0f / DM) + RMS_EPS), rb = 1.0f / sqrtf(wave_sum(ssb) * (1.0f / DM) + RMS_EPS);
            float* oa = dst + (size_t)ma * DM + 8 * F.lane; float* ob = dst + (size_t)mbb * DM + 8 * F.lane;
#pragma unroll
            for (int j = 0; j < 2; ++j) { *(f32x4*)(oa + 512 * j) = va[j][0] * ra * gf[j][0]; *(f32x4*)(oa + 512 * j + 4) = va[j][1] * ra * gf[j][1]; }
            if (hasb) {
#pragma unroll
                for (int j = 0; j < 2; ++j) { *(f32x4*)(ob + 512 * j) = vb[j][0] * rb * gf[j][0]; *(f32x4*)(ob + 512 * j + 4) = vb[j][1] * rb * gf[j][1]; } }
        }
    }
}

#ifndef REP6
#define REP6 1
#endif
#ifndef REP7
#define REP7 1
#endif
__device__ __forceinline__ void run_p1(Frame& F) {
    { pg8::SchedPlain S; S.init(wsp<bf16_t>(F, WS_A), wsp<bf16_t>(F, WS_WIN), NTOK, 2560, F.G, (int)blockIdx.x);
      EpiProj E{wsp<bf16_t>(F, WS_Q), wsp<bf16_t>(F, WS_KB), wsp<bf16_t>(F, WS_CB), wsp<bf16_t>(F, WS_CC), wsp<bf16_t>(F, WS_CX), wsp<float>(F, WS_RSTD1)};
      pg8::gemm_phase<EpiProj, pg8::SchedPlain, false>(F.lds, S, E); }
    { pg8::SchedPlain S; S.init(wsp<bf16_t>(F, WS_WIN) + (size_t)2560 * DM, wsp<bf16_t>(F, WS_A), 512, NTOK, F.G, (int)blockIdx.x);
      EpiVt E{wsp<bf16_t>(F, WS_VT), wsp<float>(F, WS_RSTD1)};
      pg8::gemm_phase<EpiVt, pg8::SchedPlain, false>(F.lds, S, E); }
}
__device__ __forceinline__ void run_p2(Frame& F) {
    for (int u = F.vcu; u < NB * (SEQ / 32); u += F.G) p2_unit(F, u >> 7, u & 127);
}
__device__ __forceinline__ void run_p3(Frame& F) {
    pg8::SchedPlain S; S.init(wsp<bf16_t>(F, WS_MIXED), wsp<bf16_t>(F, WS_WOUT), NTOK, DM, F.G, (int)blockIdx.x);
    EpiOut E{F.x, wsp<bf16_t>(F, WS_A), wsp<unsigned char>(F, WS_A8), wsp<float>(F, WS_SSP), F.g_ffn};
    pg8::gemm_phase<EpiOut, pg8::SchedPlain, false>(F.lds, S, E);
}
__device__ __forceinline__ void run_p6(Frame& F) {
    pg8::SchedGrouped<1024> S; S.A = (const char*)wsp<unsigned char>(F, WS_A8); S.Bt = (const char*)wsp<unsigned char>(F, WS_WGU); S.estep = (size_t)2048 * 1024; S.nN = 8; S.G = F.G; S.c = F.vcu; S.rep = REP6;
    S.tile_e = wsp<int>(F, WS_TILEE); S.slot_tok = wsp<int>(F, WS_SLOTTOK); S.ntiles = __builtin_amdgcn_readfirstlane(ld_i(S.tile_e + CAP_TILES));
    S.ltile = (LAS int*)(F.lds + RING_BYTES + 1024); S.ltok = (LAS int*)(F.lds + RING_BYTES + 4096); S.setup();
    EpiGU E{wsp<unsigned char>(F, WS_HID), F.b_gu, wsp<float>(F, WS_SLOTRSTD)};
    pg8::gemm_phase<EpiGU, pg8::SchedGrouped<1024>, true, true>(F.lds, S, E);
}
__device__ __forceinline__ void run_p7(Frame& F) {
    pg8::SchedGrouped<1024> S; S.A = (const char*)wsp<unsigned char>(F, WS_HID); S.Bt = (const char*)wsp<unsigned char>(F, WS_WD); S.estep = (size_t)1024 * 1024; S.nN = 4; S.G = F.G; S.c = F.vcu; S.rep = REP7;
    S.tile_e = wsp<int>(F, WS_TILEE); S.slot_tok = wsp<int>(F, WS_SLOTTOK); S.ntiles = __builtin_amdgcn_readfirstlane(ld_i(S.tile_e + CAP_TILES));
    S.ltile = (LAS int*)(F.lds + RING_BYTES + 1024); S.ltok = (LAS int*)(F.lds + RING_BYTES + 4096); S.setup();
    EpiDown E{wsp<unsigned char>(F, WS_YS), F.b_down, wsp<float>(F, WS_SLOTGATE)};
    pg8::gemm_phase<EpiDown, pg8::SchedGrouped<1024>, false, true>(F.lds, S, E);
}

constexpr int N_PHASES = 9;
__global__ void __launch_bounds__(NWAVES * 64, 2) fwd(Args args) {
    extern __shared__ __attribute__((aligned(16))) unsigned char lds_raw[];
    Frame F;
    F.lds = (LAS unsigned char*)lds_raw;
    F.tid = threadIdx.x; F.lane = F.tid & 63; F.wave = __builtin_amdgcn_readfirstlane(F.tid >> 6);
    F.G = gridDim.x; { const int bx = blockIdx.x; F.vcu = (F.G % 8 == 0) ? (bx % 8) * (F.G / 8) + bx / 8 : bx; }
    F.ws = args.ws; F.ctl = (gu32*)(args.ws + WS_CTL); F.out = args.out;
    F.x = args.in[0]; F.meta = args.in[1]; F.g_mix = args.in[2]; F.w_in = args.in[3]; F.g_attn = args.in[4]; F.conv_w = args.in[5]; F.conv_b = args.in[6]; F.g_conv = args.in[7];
    F.w_out = args.in[8]; F.g_ffn = args.in[9]; F.w_router = args.in[10]; F.b_router = args.in[11]; F.w_gu = args.in[12]; F.b_gu = args.in[13]; F.w_down = args.in[14]; F.b_down = args.in[15]; F.g_final = args.in[16];
    volatile LAS unsigned* MISC = (volatile LAS unsigned*)(F.lds + MISC_OFF);
    for (int u = F.tid; u < (LDS_BYTES - LDSCTL_OFF) / 4; u += NWAVES * 64) ((LAS unsigned*)(F.lds + LDSCTL_OFF))[u] = 0u;
    __syncthreads();
    const int lo = args.ph_lo, hi = args.ph_hi;
    const bool multi = (hi - lo) > 1;
    XcdBarrier bar; bar.bar = (unsigned*)(F.ctl + CW_BAR); bar.x = 0; bar.st = nullptr;
    if (multi) bar = xcd_barrier_post((unsigned*)(F.ctl + CW_BAR), MISC + 8);
#ifndef PH_MASK
#define PH_MASK 0x1ff
#endif
#define IN(k) (((PH_MASK >> (k)) & 1) && lo <= (k) && (k) < hi)
#define SEAM(k) do { if (IN(k) && IN((k) + 1)) xcd_barrier(bar); } while (0)
#ifndef DUP_MASK
#define DUP_MASK 0
#endif
#define DUPK(k) ((((DUP_MASK) >> (k)) & 1) != 0)

    if (IN(0)) { p0_prologue(F); if (DUPK(0)) { xcd_barrier(bar); p0_prologue(F); } }
    SEAM(0);
    if (IN(1)) { run_p1(F); if (DUPK(1)) { xcd_barrier(bar); run_p1(F); } }
    SEAM(1);
    if (IN(2)) { run_p2(F); if (DUPK(2)) { xcd_barrier(bar); run_p2(F); } }
    SEAM(2);
    if (IN(3)) { run_p3(F); if (DUPK(3)) { xcd_barrier(bar); run_p3(F); } }
    SEAM(3);
#ifdef XTRA_BAR
    for (int xb_ = 0; xb_ < XTRA_BAR; ++xb_) xcd_barrier(bar);
#endif
    if (IN(4)) { p4_router(F); if (DUPK(4)) { xcd_barrier(bar); p4_router(F); } }
    SEAM(4);
    if (IN(5)) { p5_scatter(F); if (DUPK(5)) { xcd_barrier(bar); p5_scatter(F); } }
    SEAM(5);
    if (IN(6)) { run_p6(F); if (DUPK(6)) { xcd_barrier(bar); run_p6(F); } }
    SEAM(6);
#ifdef DUP7_LOOP
    if (IN(7)) { for (int rep_ = 0; rep_ < 2; ++rep_) { if (rep_) xcd_barrier(bar); run_p7(F); } }
#else
    if (IN(7)) { run_p7(F); if (DUPK(7)) { xcd_barrier(bar); run_p7(F); } }
#endif
    SEAM(7);
    if (IN(8)) { if (DUPK(8)) { p8_combine(F, wsp<float>(F, WS_HID)); xcd_barrier(bar); } p8_combine(F, F.out); }
#undef IN
#undef SEAM
}

#ifndef MK_N_LAUNCHES
#define MK_N_LAUNCHES 1
#endif
extern "C" void kernel_launch(void* const* d_in, const int* in_sizes, int n_in, void* d_out, int out_size, void* d_ws, size_t ws_size, hipStream_t stream) {
    static int grid = 0;
    if (grid == 0) {
        if (n_in != 17 || out_size != NTOK * DM || ws_size < WS_END) { fprintf(stderr, "kernel_launch: unexpected problem (n_in %d out %d ws %zu)\n", n_in, out_size, ws_size); grid = -1; return; }
        int dev = 0, cus = 0, per_cu = 0;
        if (hipGetDevice(&dev) != hipSuccess || hipDeviceGetAttribute(&cus, hipDeviceAttributeMultiprocessorCount, dev) != hipSuccess) { grid = -1; return; }
        if (hipFuncSetAttribute((const void*)fwd, hipFuncAttributeMaxDynamicSharedMemorySize, LDS_BYTES) != hipSuccess) { fprintf(stderr, "kernel_launch: hipFuncSetAttribute failed\n"); grid = -1; return; }
        if (hipOccupancyMaxActiveBlocksPerMultiprocessor(&per_cu, (const void*)fwd, NWAVES * 64, LDS_BYTES) != hipSuccess || per_cu < 1) { fprintf(stderr, "kernel_launch: occupancy query says %d\n", per_cu); }
        (void)hipGetLastError();
        grid = cus;
        if (grid != 256) fprintf(stderr, "kernel_launch: %d CUs (built for 256)\n", grid);
    }
    if (grid < 0) return;
    (void)hipMemsetAsync((char*)d_ws + WS_CTL, 0, CTL_ZERO_BYTES, stream);
    Args a{};
    for (int i = 0; i < 17; ++i) a.in[i] = (const float*)d_in[i];
    a.out = (float*)d_out; a.ws = (unsigned char*)d_ws;
    if (MK_N_LAUNCHES == 1) { a.ph_lo = 0; a.ph_hi = N_PHASES; hipLaunchKernelGGL(fwd, dim3(grid), dim3(NWAVES * 64), LDS_BYTES, stream, a); }
    else for (int p = 0; p < N_PHASES; ++p) { a.ph_lo = p; a.ph_hi = p + 1; hipLaunchKernelGGL(fwd, dim3(grid), dim3(NWAVES * 64), LDS_BYTES, stream, a); }
    const hipError_t le = hipPeekAtLastError();
    if (le != hipSuccess) fprintf(stderr, "kernel_launch: launch failed: %s\n", hipGetErrorName(le));
}
```

```cpp
#include <hip/hip_runtime.h>
#include <cstdio>
#include <cstdint>

#define GAS __attribute__((address_space(1)))
#define LAS __attribute__((address_space(3)))
typedef unsigned short bf16_t;
typedef short bf16x8 __attribute__((ext_vector_type(8)));
typedef float f32x2 __attribute__((ext_vector_type(2)));
typedef float f32x4 __attribute__((ext_vector_type(4)));
typedef float f32x16 __attribute__((ext_vector_type(16)));
typedef unsigned u32x2 __attribute__((ext_vector_type(2)));
typedef unsigned u32x4 __attribute__((ext_vector_type(4)));
typedef int i32x4 __attribute__((ext_vector_type(4)));
typedef int i32x8 __attribute__((ext_vector_type(8)));
typedef __bf16 bf16x2_t __attribute__((ext_vector_type(2)));
typedef GAS unsigned gu32;
#define RLX_AGENT __ATOMIC_RELAXED, __HIP_MEMORY_SCOPE_AGENT

constexpr int DM = 1024, NB = 8, SEQ = 4096, NTOK = NB * SEQ;
constexpr int NMETA = 16, KPAD = 48, TPAD = KPAD + NMETA + SEQ;
constexpr int QOFF = KPAD + NMETA;
constexpr int AW = 512, NH = 8, HD = 64;
constexpr int NE = 32, TOPK = 4, FF = 1024;
constexpr int CAP_TILES = 544, CAP = CAP_TILES * 256;
constexpr float RMS_EPS = 1e-6f;
constexpr float LOG2E = 1.4426950408889634f;
constexpr float QSCALE = 0.125f * LOG2E;
#ifndef EXIT_THR_VAL
#define EXIT_THR_VAL 5.421010862427522e-20f
#endif
constexpr float EXIT_THR = EXIT_THR_VAL;
constexpr int NWAVES = 8;
constexpr float YSCALE = 16.0f, YINV = 1.0f / 16.0f;
constexpr float WSCALE = 32.0f, WINV = 1.0f / 32.0f;

constexpr size_t MiB = 1u << 20, KiB = 1u << 10;
constexpr size_t WS_CTL = 0, CTL_ZERO_BYTES = 64 * KiB;
constexpr size_t WS_RSTD1 = 1 * MiB, WS_RSTD2 = WS_RSTD1 + 128 * KiB, WS_CNT = WS_RSTD2 + 128 * KiB, WS_TILEE = WS_CNT + 64 * KiB, WS_META = WS_TILEE + 64 * KiB;
constexpr size_t WS_TOPE = 2 * MiB, WS_GATE = WS_TOPE + 512 * KiB, WS_TOKSLOT = 3 * MiB;
constexpr size_t WS_SLOTTOK = 4 * MiB, WS_SLOTGATE = 5 * MiB, WS_SLOTRSTD = 6 * MiB;
constexpr size_t WS_SSP = 8 * MiB;
constexpr size_t WS_WIN = 10 * MiB, WS_WGU = 16 * MiB, WS_WD = 144 * MiB, WS_A = 208 * MiB;
constexpr size_t WS_HID = 272 * MiB;
constexpr size_t WS_Q = 272 * MiB, WS_KB = 304 * MiB, WS_VT = 337 * MiB, WS_CB = 370 * MiB, WS_CC = 402 * MiB, WS_CX = 434 * MiB, WS_MIXED = 466 * MiB;
constexpr size_t WS_YS = 544 * MiB, WS_WOUT = 816 * MiB, WS_A8 = 820 * MiB, WS_END = 852 * MiB;
static_assert(WS_MIXED + 64 * MiB <= WS_HID + (size_t)CAP * 2048 && WS_HID + (size_t)CAP * 2048 <= WS_YS && WS_YS + (size_t)CAP * 2048 <= WS_WOUT, "ws map");
static_assert((size_t)NB * TPAD * 512 * 2 <= 33 * MiB, "K/Vt size");
constexpr int CW_TMO = 0, CW_QCONV = 64, CW_QATT = 128, CW_BAR = 1024;

constexpr int RING_BYTES = 131072, LDSCTL_OFF = RING_BYTES, MISC_OFF = LDSCTL_OFF + 320, P2_SS_OFF = 147456, LDS_BYTES = 151552;

__device__ __forceinline__ unsigned cvtpk(float lo, float hi) { f32x2 v = {lo, hi}; bf16x2_t b = __builtin_convertvector(v, bf16x2_t); return __builtin_bit_cast(unsigned, b); }
__device__ __forceinline__ unsigned pk4_fp8(float a, float b, float c, float d) { int w = 0; w = __builtin_amdgcn_cvt_pk_fp8_f32(a, b, w, false); w = __builtin_amdgcn_cvt_pk_fp8_f32(c, d, w, true); return (unsigned)w; }
__device__ __forceinline__ f32x2 fp8lo(unsigned w) { return __builtin_amdgcn_cvt_pk_f32_fp8((int)w, false); }
__device__ __forceinline__ f32x2 fp8hi(unsigned w) { return __builtin_amdgcn_cvt_pk_f32_fp8((int)w, true); }
__device__ __forceinline__ float bflo(unsigned u) { return __builtin_bit_cast(float, u << 16); }
__device__ __forceinline__ float bfhi(unsigned u) { return __builtin_bit_cast(float, u & 0xffff0000u); }
__device__ __forceinline__ float ex2(float x) { return __builtin_amdgcn_exp2f(x); }
__device__ __forceinline__ float lg2(float x) { return __builtin_amdgcn_logf(x); }
__device__ __forceinline__ int ld_i(const int* p) { return __hip_atomic_load(p, RLX_AGENT); }
__device__ __forceinline__ float ld_f(const float* p) { return __builtin_bit_cast(float, __hip_atomic_load((const int*)p, RLX_AGENT)); }
__device__ __forceinline__ float wave_sum(float v) {
#pragma unroll
    for (int o = 1; o < 64; o <<= 1) v += __shfl_xor(v, o);
    return v;
}
#define LDS_WAIT() asm volatile("s_waitcnt lgkmcnt(0)" ::: "memory")
#define VM_WAIT() asm volatile("s_waitcnt vmcnt(0)" ::: "memory")

namespace pg8 {
constexpr int BM = 256, BK = 64, HALF = 128, HTB = HALF * BK * 2, STAGE_BYTES = 8 * HTB, NXCD = 8, WGM = 8, GK = 1024;
__host__ __device__ __forceinline__ int lds_byte(int r, int c) { const int st = (r >> 4) * 2 + (c >> 5), rr = r & 15, cc = c & 31, ob = rr * 64 + cc * 2; return st * 1024 + (ob ^ (((ob >> 9) & 1) << 5)); }
__host__ __device__ __forceinline__ void stage_rc(int b, int& R, int& C) { const int st = b / 1024, sb = b % 1024, swz = sb ^ (((sb >> 9) & 1) << 5); R = (st >> 1) * 16 + swz / 64; C = (st & 1) * 32 + (swz % 64) / 2; }
__host__ __device__ __forceinline__ int perm32(int rho) { const int n = rho >> 4, i = rho & 15; return 8 * (i >> 2) + 4 * n + (i & 3); }
struct Unit { int pm, pn, e; };

struct SchedPlain {
    const char* A; const char* Bt; int nM, nN, nwg, G, c, rep = 1; static constexpr int RB = 2048;
    __device__ void init(const void* A_, const void* Bt_, int M, int N, int G_, int c_) { A = (const char*)A_; Bt = (const char*)Bt_; nM = M / BM; nN = N / BM; nwg = nM * nN; G = G_; c = c_; }
    __device__ __forceinline__ bool next(int i, Unit& u) const {
        const int nmy = (c < nwg) ? (nwg - c + G - 1) / G : 0; if (i >= nmy * rep) return false;
        const long L = (long)(i % nmy) * G + c;
        int wgid = (int)L; { const int q = nwg / NXCD, r = nwg % NXCD, xcd = wgid % NXCD, off = wgid / NXCD; wgid = (xcd < r ? xcd * (q + 1) : r * (q + 1) + (xcd - r) * q) + off; }
        const int nig = WGM * nN, gid = wgid / nig, fm = gid * WGM, gsz = (nM - fm) < WGM ? (nM - fm) : WGM;
        u.pm = fm + ((wgid % nig) % gsz); u.pn = (wgid % nig) / gsz; u.e = (i >= nmy) ? 1 : 0; return true;
    }
    __device__ __forceinline__ unsigned a_tile(const Unit& u) const { return (unsigned)u.pm * (unsigned)(BM * RB); }
    __device__ __forceinline__ unsigned b_tile(const Unit& u) const { return (unsigned)u.pn * (unsigned)(BM * RB); }
    __device__ __forceinline__ unsigned tok_off(int) const { return 0u; }
    __device__ __forceinline__ unsigned tok_lds(int, int) const { return 0u; }
    __device__ __forceinline__ void tok_dma(int, int, int, int) const {}
};
template <int RB_> struct SchedGrouped {
    static constexpr int RB = RB_;
    const char* A; const char* Bt; size_t estep; int nN, G, c, ntiles; const int* tile_e; const int* slot_tok;
    LAS int* ltile;
    LAS int* ltok;
    int rep;
    __device__ __forceinline__ void setup() const { if (threadIdx.x < 33) ltile[threadIdx.x] = ld_i(tile_e + CAP_TILES + 1 + threadIdx.x); __syncthreads(); }
    __device__ __forceinline__ bool next(int i, Unit& u) const {
        const int g = c >> 5, w = c & 31;
        const int t0 = ltile[g], t1 = ltile[g + 1], t2 = ltile[g + 8], t3 = ltile[g + 9], t4 = ltile[g + 16], t5 = ltile[g + 17], t6 = ltile[g + 24], t7 = ltile[g + 25];
        const int n0 = (t1 - t0) * nN, n1 = (t3 - t2) * nN, n2 = (t5 - t4) * nN, n3 = (t7 - t6) * nN, tot = n0 + n1 + n2 + n3;
        const int nmy = (w < tot) ? (tot - w + 31) / 32 : 0; if (i >= nmy * rep) return false;
        int l = (i % nmy) * 32 + w, e, tb;
        if (l < n0) { e = g; tb = t0; } else if (l < n0 + n1) { l -= n0; e = g + 8; tb = t2; } else if (l < n0 + n1 + n2) { l -= n0 + n1; e = g + 16; tb = t4; } else { l -= n0 + n1 + n2; e = g + 24; tb = t6; }
        u.pm = __builtin_amdgcn_readfirstlane(tb + l / nN); u.pn = __builtin_amdgcn_readfirstlane(l % nN); u.e = __builtin_amdgcn_readfirstlane(e); return true;
    }
    __device__ __forceinline__ unsigned a_tile(const Unit& u) const { return (unsigned)u.pm * (unsigned)(BM * RB); }
    __device__ __forceinline__ unsigned b_tile(const Unit& u) const { return (unsigned)u.e * (unsigned)estep + (unsigned)u.pn * (unsigned)(BM * RB); }
    __device__ __forceinline__ unsigned tok_off(int row) const { return (unsigned)ld_i(slot_tok + row) * (unsigned)RB; }
    __device__ __forceinline__ unsigned tok_lds(int par, int r) const { return (unsigned)ltok[par * 256 + r] * (unsigned)RB; }
    __device__ __forceinline__ void tok_dma(int par, int pm, int wid, int lane) const {
        const __amdgpu_buffer_rsrc_t rsT = __builtin_amdgcn_make_buffer_rsrc((void*)slot_tok, (short)0, CAP * 4, 0x00020000);
        __builtin_amdgcn_raw_ptr_buffer_load_lds(rsT, (LAS void*)(ltok + par * 256 + wid * 64), 4, lane * 4, (pm * 256 + wid * 64) * 4, 0, 0);
    }
};

template <class Epi, class Sched, bool GATHER, bool FP8 = false, bool ALIGN_EPI = true>
__device__ __forceinline__ void gemm_phase(LAS unsigned char* lds, const Sched& S, const Epi& E) {
    constexpr int RB = Sched::RB, nt = RB / 128;
    const int tid = threadIdx.x, wid = __builtin_amdgcn_readfirstlane(tid >> 6), lane = tid & 63, wr = wid >> 2, wc = wid & 3, fr = lane & 15, fq = lane >> 4;
    unsigned voffA[2], voffB[2], stC2[2]; int stR[2];
#pragma unroll
    for (int i = 0; i < 2; ++i) { int R, C; stage_rc(tid * 16 + i * 8192, R, C); const int Rb = (R & ~31) + perm32(R & 31);
        voffA[i] = (unsigned)(R * RB + C * 2); voffB[i] = (unsigned)(Rb * RB + C * 2); stR[i] = R; stC2[i] = (unsigned)C * 2u; }
    constexpr unsigned kstep = 128u, hstep = (unsigned)(HALF * RB);
    const __amdgpu_buffer_rsrc_t rsA = __builtin_amdgcn_make_buffer_rsrc((void*)S.A, (short)0, 0x7fffff00, 0x00020000), rsB = __builtin_amdgcn_make_buffer_rsrc((void*)S.Bt, (short)0, 0x7fffff00, 0x00020000);
    const unsigned ldsw = (unsigned)wid * 1024u;
    const int aoff = lds_byte(wr * 64 + fr, fq * 8), boff = lds_byte(wc * 32 + fr, fq * 8);
#define PG8_SA(b, h) (((b) * 2 + (h)) * HTB)
#define PG8_SB(b, h) ((4 + (b) * 2 + (h)) * HTB)
#define PG8_STAGE2(bufoff, rs, soff, o0, o1) do { \
        __builtin_amdgcn_raw_ptr_buffer_load_lds(rs, (LAS void*)(lds + (bufoff) + ldsw), 16, (int)(o0), (int)(soff), 0, 0); \
        __builtin_amdgcn_raw_ptr_buffer_load_lds(rs, (LAS void*)(lds + (bufoff) + ldsw + 8192), 16, (int)(o1), (int)(soff), 0, 0); } while (0)
#define PG8_STAGE_B(bufoff, soff) PG8_STAGE2(bufoff, rsB, soff, voffB[0], voffB[1])
#define PG8_STAGE_A(bufoff, usenext, h, koff) do { if constexpr (GATHER) { \
            const unsigned _o0 = (usenext) ? ng[h][0] : cg[h][0], _o1 = (usenext) ? ng[h][1] : cg[h][1]; PG8_STAGE2(bufoff, rsA, (koff), _o0, _o1); } \
        else { PG8_STAGE2(bufoff, rsA, ((usenext) ? nA : cA) + (unsigned)(h) * hstep + (koff), voffA[0], voffA[1]); } } while (0)
#define PG8_LDA(dst, b, h) do { _Pragma("unroll") for (int m = 0; m < 4; ++m) _Pragma("unroll") for (int k = 0; k < 2; ++k) dst[m][k] = *(const LAS bf16x8*)(lds + PG8_SA(b, h) + aoff + m * 2048 + k * 1024); } while (0)
#define PG8_LDB(dst, b, h) do { _Pragma("unroll") for (int n = 0; n < 2; ++n) _Pragma("unroll") for (int k = 0; k < 2; ++k) dst[n][k] = *(const LAS bf16x8*)(lds + PG8_SB(b, h) + boff + n * 2048 + k * 1024); } while (0)
#define PG8_MMA(ai, bj, At, Bt) do { __builtin_amdgcn_s_setprio(1); _Pragma("unroll") for (int m = 0; m < 4; ++m) _Pragma("unroll") for (int n = 0; n < 2; ++n) { \
        if constexpr (FP8) { const i32x8 bb_ = __builtin_shufflevector(__builtin_bit_cast(i32x4, Bt[n][0]), __builtin_bit_cast(i32x4, Bt[n][1]), 0, 1, 2, 3, 4, 5, 6, 7); \
            const i32x8 aa_ = __builtin_shufflevector(__builtin_bit_cast(i32x4, At[m][0]), __builtin_bit_cast(i32x4, At[m][1]), 0, 1, 2, 3, 4, 5, 6, 7); \
            asm volatile("v_mfma_scale_f32_16x16x128_f8f6f4 %0, %1, %2, %0, %3, %3 op_sel_hi:[0,0,0]" : "+v"(acc[ai][bj][m][n]) : "v"(bb_), "v"(aa_), "v"(scl8)); } \
        else { _Pragma("unroll") for (int k = 0; k < 2; ++k) acc[ai][bj][m][n] = __builtin_amdgcn_mfma_f32_16x16x32_bf16(Bt[n][k], At[m][k], acc[ai][bj][m][n], 0, 0, 0); } } \
        __builtin_amdgcn_s_setprio(0); } while (0)
#define PG8_MFMA_DRAIN() do { if constexpr (FP8) asm volatile("s_nop 7\n\ts_nop 7" ::: "memory"); } while (0)
#define PG8_WAIT_V(n) asm volatile("s_waitcnt vmcnt(" #n ")" ::: "memory")
#define PG8_WAIT_L(n) asm volatile("s_waitcnt lgkmcnt(" #n ")" ::: "memory")
#define PG8_BAR __builtin_amdgcn_s_barrier()
#define PG8_SCHED __builtin_amdgcn_sched_barrier(0)
    Unit cur, nxt; int ui = 0;
    if (!S.next(0, cur)) return;
    f32x4 acc[2][2][4][2];
    if constexpr (Epi::HAS_INIT) E.init(acc, cur, wr, wc, fr, fq); else {
#pragma unroll
    for (int a = 0; a < 2; ++a)
#pragma unroll
        for (int b = 0; b < 2; ++b)
#pragma unroll
            for (int m = 0; m < 4; ++m)
#pragma unroll
                for (int n = 0; n < 2; ++n) acc[a][b][m][n] = (f32x4){0.f, 0.f, 0.f, 0.f};
    }
    bf16x8 At[4][2], B0[2][2], B1[2][2];
    int scl8 = 0x7f7f7f7f; asm volatile("" : "+v"(scl8));
    unsigned cA = S.a_tile(cur), cB = S.b_tile(cur), nA = cA;
    unsigned cg[2][2], ng[2][2];
    if constexpr (GATHER) {
#pragma unroll
        for (int h = 0; h < 2; ++h)
#pragma unroll
            for (int i = 0; i < 2; ++i) { cg[h][i] = S.tok_off(cur.pm * BM + h * HALF + stR[i]) + stC2[i]; ng[h][i] = cg[h][i]; }
    } else {
#pragma unroll
        for (int h = 0; h < 2; ++h)
#pragma unroll
            for (int i = 0; i < 2; ++i) { cg[h][i] = 0u; ng[h][i] = 0u; }
    }
    PG8_STAGE_B(PG8_SB(0, 0), cB); PG8_STAGE_B(PG8_SB(0, 1), cB + hstep); PG8_STAGE_A(PG8_SA(0, 0), false, 0, 0); PG8_STAGE_A(PG8_SA(0, 1), false, 1, 0);
    if (wr == 1) PG8_BAR;
    PG8_WAIT_V(2); PG8_BAR;
    PG8_STAGE_B(PG8_SB(1, 0), cB + kstep); PG8_STAGE_A(PG8_SA(1, 0), false, 0, kstep); PG8_STAGE_B(PG8_SB(1, 1), cB + hstep + kstep);
    PG8_WAIT_V(6); PG8_BAR;
    for (;;) {
        const bool has_next = S.next(ui + 1, nxt);
        nA = has_next ? S.a_tile(nxt) : cA; const unsigned nB = has_next ? S.b_tile(nxt) : cB;
#pragma unroll 1
        for (int t = 0; t < nt; t += 2) {
            const bool last = (t == nt - 2);
            const unsigned koff1 = (unsigned)(t + 1) * kstep, koff2 = last ? 0u : (unsigned)(t + 2) * kstep, koff3 = koff2 + kstep;
            const unsigned b2 = last ? nB : cB + (unsigned)(t + 2) * kstep, b3 = b2 + kstep;
            if constexpr (GATHER) {
                if (t == nt - 4 && has_next && wid < 4) S.tok_dma((ui + 1) & 1, nxt.pm, wid, lane);
                if (last && has_next) {
#pragma unroll
                    for (int h = 0; h < 2; ++h)
#pragma unroll
                        for (int i = 0; i < 2; ++i) ng[h][i] = S.tok_lds((ui + 1) & 1, h * HALF + stR[i]) + stC2[i]; } }
            PG8_LDB(B0, 0, 0); PG8_LDB(B1, 0, 1); PG8_SCHED; PG8_LDA(At, 0, 0); PG8_STAGE_A(PG8_SA(1, 1), false, 1, koff1);
            PG8_WAIT_V(8); PG8_WAIT_L(0); PG8_BAR; PG8_MMA(0, 0, At, B0); PG8_MMA(0, 1, At, B1); PG8_BAR; PG8_SCHED;
            PG8_LDA(At, 0, 1); PG8_STAGE_B(PG8_SB(0, 0), b2); PG8_STAGE_B(PG8_SB(0, 1), b2 + hstep); PG8_STAGE_A(PG8_SA(0, 0), last, 0, koff2);
            PG8_WAIT_V(8); PG8_WAIT_L(0); PG8_BAR; PG8_MMA(1, 0, At, B0); PG8_MMA(1, 1, At, B1); PG8_BAR; PG8_SCHED;
            PG8_LDB(B0, 1, 0); PG8_LDB(B1, 1, 1); PG8_SCHED; PG8_LDA(At, 1, 0); PG8_STAGE_A(PG8_SA(0, 1), last, 1, koff2);
            PG8_WAIT_V(8); PG8_WAIT_L(0); PG8_BAR; PG8_MMA(0, 0, At, B0); PG8_MMA(0, 1, At, B1); PG8_BAR; PG8_SCHED;
            PG8_LDA(At, 1, 1); PG8_STAGE_B(PG8_SB(1, 0), b3); PG8_STAGE_B(PG8_SB(1, 1), b3 + hstep); PG8_STAGE_A(PG8_SA(1, 0), last, 0, koff3);
            PG8_WAIT_V(8); PG8_WAIT_L(0); PG8_BAR; PG8_MMA(1, 0, At, B0); PG8_MMA(1, 1, At, B1); PG8_BAR; PG8_SCHED;
        }
        if constexpr (ALIGN_EPI) { if (wr == 0) PG8_BAR; }
        PG8_MFMA_DRAIN();
        E(acc, cur, wr, wc, fr, fq);
        if (!has_next) break;
        if constexpr (Epi::HAS_INIT) E.init(acc, nxt, wr, wc, fr, fq); else {
#pragma unroll
        for (int a = 0; a < 2; ++a)
#pragma unroll
            for (int b = 0; b < 2; ++b)
#pragma unroll
                for (int m = 0; m < 4; ++m)
#pragma unroll
                    for (int n = 0; n < 2; ++n) acc[a][b][m][n] = (f32x4){0.f, 0.f, 0.f, 0.f};
        }
        cur = nxt; cA = nA; cB = nB; ++ui;
#pragma unroll
        for (int h = 0; h < 2; ++h)
#pragma unroll
            for (int i = 0; i < 2; ++i) cg[h][i] = ng[h][i];
        if constexpr (ALIGN_EPI) { if (wr == 1) PG8_BAR; }
    }
    PG8_WAIT_V(0);
    if constexpr (!ALIGN_EPI) { if (wr == 0) PG8_BAR; }
    PG8_BAR;
#undef PG8_SA
#undef PG8_SB
#undef PG8_STAGE2
#undef PG8_STAGE_B
#undef PG8_STAGE_A
#undef PG8_LDA
#undef PG8_LDB
#undef PG8_MMA
#undef PG8_MFMA_DRAIN
#undef PG8_WAIT_V
#undef PG8_WAIT_L
#undef PG8_BAR
#undef PG8_SCHED
}
}

#define XB_TMO      128
#define XB_XCNT(j)  (256  + 64 * (j))
#define XB_XSUB(j)  (1280 + 64 * (j))
#define XB_XGEN(j)  (2304 + 64 * (j))
#define XB_TOP      3328
#define XB_TOPGEN   3392
#define XCD_BAR_WORDS 3456
#define XB_SPIN_CAP (1u << 18)

__device__ __forceinline__ unsigned xb_ld(unsigned* p)              { return __hip_atomic_load(p, __ATOMIC_RELAXED, __HIP_MEMORY_SCOPE_AGENT); }
__device__ __forceinline__ unsigned xb_add(unsigned* p, unsigned v) { return __hip_atomic_fetch_add(p, v, __ATOMIC_RELAXED, __HIP_MEMORY_SCOPE_AGENT); }
__device__ __forceinline__ unsigned xb_xcc_id() { return (unsigned)__builtin_amdgcn_s_getreg((3 << 11) | 20) & 0xFu; }
#define XB_SPIN(cond, bar) do { unsigned _sp = 0; while (cond) { __builtin_amdgcn_s_sleep(1); \
    if ((++_sp & 255u) == 0u) { if (xb_ld(&(bar)[XB_TMO])) break; if (_sp > XB_SPIN_CAP) { atomicAdd(&(bar)[XB_TMO], 1u); break; } } } } while (0)

struct XcdBarrier {
    unsigned* bar; unsigned x;
    volatile LAS unsigned* st;
};

__device__ __forceinline__ XcdBarrier xcd_barrier_post(unsigned* bar, volatile LAS unsigned* st) {
    XcdBarrier b; b.bar = bar; b.x = xb_xcc_id(); b.st = st;
    if (threadIdx.x == 0) (void)xb_add(&bar[XB_XCNT(b.x)], 1u);
    return b;
}
__device__ __forceinline__ void xcd_barrier_complete(unsigned* bar, unsigned x, unsigned& nloc, unsigned& nx) {
    const unsigned G = gridDim.x * gridDim.y * gridDim.z;
    unsigned sum, cnt, mine, sp = 0u;
    for (;;) {
        sum = 0u; cnt = 0u; mine = 0u;
#pragma unroll
        for (unsigned j = 0; j < 16; ++j) { const unsigned c = xb_ld(&bar[XB_XCNT(j)]); sum += c; cnt += (c > 0u) ? 1u : 0u; mine = (j == x) ? c : mine; }
        if (sum == G) break;
        __builtin_amdgcn_s_sleep(1);
        if ((++sp & 255u) == 0u) { if (xb_ld(&bar[XB_TMO])) break; if (sp > XB_SPIN_CAP) { atomicAdd(&bar[XB_TMO], 1u); break; } }
    }
    nloc = mine > 0u ? mine : 1u; nx = cnt > 0u ? cnt : 1u;
}

__device__ __forceinline__ void xcd_barrier(const XcdBarrier& b) {
    asm volatile("s_waitcnt vmcnt(0)" ::: "memory");
    __syncthreads();
    if (threadIdx.x == 0) {
        unsigned* bar = b.bar;
        __builtin_amdgcn_s_waitcnt(0);
        unsigned nloc = b.st[0], nx = b.st[1];
        if (nloc == 0u) { xcd_barrier_complete(bar, b.x, nloc, nx); b.st[0] = nloc; b.st[1] = nx; }
        const unsigned old = xb_add(&bar[XB_XSUB(b.x)], 1u);
        const unsigned gen = old / nloc;
        if (old + 1u == (gen + 1u) * nloc) {
            __builtin_amdgcn_fence(__ATOMIC_RELEASE, "agent");
            asm volatile("s_waitcnt vmcnt(0)" ::: "memory");
            const unsigned og = xb_add(&bar[XB_TOP], 1u);
            const unsigned tg = og / nx;
            if (og + 1u == (tg + 1u) * nx) xb_add(&bar[XB_TOPGEN], 1u);
            else XB_SPIN(xb_ld(&bar[XB_TOPGEN]) == tg, bar);
            __builtin_amdgcn_fence(__ATOMIC_ACQUIRE, "agent");
            xb_add(&bar[XB_XGEN(b.x)], 1u);
            asm volatile("s_waitcnt vmcnt(0)" ::: "memory");
        } else {
            XB_SPIN(xb_ld(&bar[XB_XGEN(b.x)]) == gen, bar);
            __builtin_amdgcn_fence(__ATOMIC_ACQUIRE, "agent");
            asm volatile("s_waitcnt vmcnt(0)" ::: "memory");
        }
    }
    __syncthreads();
}

typedef f32x4 AccT[2][2][4][2];
struct EpiProj {
    static constexpr bool HAS_INIT = false;
    bf16_t *Q, *KB, *CB, *CC, *CX; const float* rstd1;
    __device__ __forceinline__ void operator()(const AccT& acc, const pg8::Unit& u, int wr, int wc, int fr, int fq) const {
        const int sec = u.pn >> 1, row0 = u.pm * 256 + wr * 64 + fr, col0 = (u.pn & 1) * 256 + wc * 32 + 8 * fq;
        bf16_t* base = sec == 0 ? Q : sec == 1 ? KB : sec == 2 ? CB : sec == 3 ? CC : CX;
        const int radd = (sec == 1) ? 64 * ((u.pm >> 4) + 1) : 0;
        const float sc0 = (sec == 0) ? QSCALE : 1.0f;
        float rsv[2][4];
#pragma unroll
        for (int ai = 0; ai < 2; ++ai)
#pragma unroll
            for (int m = 0; m < 4; ++m) rsv[ai][m] = rstd1[row0 + ai * 128 + m * 16];
#pragma unroll
        for (int ai = 0; ai < 2; ++ai)
#pragma unroll
            for (int m = 0; m < 4; ++m) { const int r = row0 + ai * 128 + m * 16; const float sc = rsv[ai][m] * sc0;
                bf16_t* rowp = base + (size_t)(r + radd) * 512 + col0;
#pragma unroll
                for (int bj = 0; bj < 2; ++bj) { const f32x4 v0 = acc[ai][bj][m][0] * sc, v1 = acc[ai][bj][m][1] * sc;
                    u32x4 w; w.x = cvtpk(v0[0], v0[1]); w.y = cvtpk(v0[2], v0[3]); w.z = cvtpk(v1[0], v1[1]); w.w = cvtpk(v1[2], v1[3]);
                    *(u32x4*)(rowp + bj * 128) = w; } }
    }
};
struct EpiVt {
    static constexpr bool HAS_INIT = false;
    bf16_t* VT; const float* rstd1;
    __device__ __forceinline__ void operator()(const AccT& acc, const pg8::Unit& u, int wr, int wc, int fr, int fq) const {
        const int row0 = u.pm * 256 + wr * 64 + fr, col0 = u.pn * 256 + wc * 32 + 8 * fq;
        f32x4 rs[2][2];
#pragma unroll
        for (int bj = 0; bj < 2; ++bj)
#pragma unroll
            for (int n = 0; n < 2; ++n) rs[bj][n] = *(const f32x4*)(rstd1 + col0 + bj * 128 + 4 * n);
        const int dcol0 = col0 + 64 * ((u.pn >> 4) + 1);
#pragma unroll
        for (int ai = 0; ai < 2; ++ai)
#pragma unroll
            for (int m = 0; m < 4; ++m) { bf16_t* rowp = VT + (size_t)(row0 + ai * 128 + m * 16) * (size_t)(NB * TPAD) + dcol0;
#pragma unroll
                for (int bj = 0; bj < 2; ++bj) { const f32x4 v0 = acc[ai][bj][m][0] * rs[bj][0], v1 = acc[ai][bj][m][1] * rs[bj][1];
                    u32x4 w; w.x = cvtpk(v0[0], v0[1]); w.y = cvtpk(v0[2], v0[3]); w.z = cvtpk(v1[0], v1[1]); w.w = cvtpk(v1[2], v1[3]);
                    *(u32x4*)(rowp + bj * 128) = w; } }
    }
};
struct EpiOut {
    static constexpr bool HAS_INIT = false;
    const float* x; bf16_t* H1; unsigned char* A8; float* ssp; const float* gffn;
    __device__ __forceinline__ void init(AccT&, const pg8::Unit&, int, int, int, int) const {}
    __device__ __forceinline__ void operator()(const AccT& acc, const pg8::Unit& u, int wr, int wc, int fr, int fq) const {
        const int row0 = u.pm * 256 + wr * 64 + fr, col0 = u.pn * 256 + wc * 32 + 8 * fq;
        f32x4 g[2][2];
#pragma unroll
        for (int bj = 0; bj < 2; ++bj)
#pragma unroll
            for (int n = 0; n < 2; ++n) g[bj][n] = *(const f32x4*)(gffn + col0 + bj * 128 + 4 * n);
        f32x4 xc[2][2], xn[2][2];
        { const size_t ro = (size_t)row0 * DM + col0;
#pragma unroll
          for (int bj = 0; bj < 2; ++bj) { xc[bj][0] = *(const f32x4*)(x + ro + bj * 128); xc[bj][1] = *(const f32x4*)(x + ro + bj * 128 + 4); } }
#pragma unroll
        for (int gi = 0; gi < 8; ++gi) { const int ai = gi >> 2, m = gi & 3;
            if (gi < 7) { const int r2 = row0 + ((gi + 1) >> 2) * 128 + ((gi + 1) & 3) * 16; const size_t ro2 = (size_t)r2 * DM + col0;
#pragma unroll
                for (int bj = 0; bj < 2; ++bj) { xn[bj][0] = *(const f32x4*)(x + ro2 + bj * 128); xn[bj][1] = *(const f32x4*)(x + ro2 + bj * 128 + 4); } }
            asm volatile("" ::: "memory");
            const int r = row0 + ai * 128 + m * 16; const size_t ro = (size_t)r * DM + col0; float ss = 0.f;
#pragma unroll
            for (int bj = 0; bj < 2; ++bj) {
                const f32x4 v0 = acc[ai][bj][m][0] + xc[bj][0], v1 = acc[ai][bj][m][1] + xc[bj][1];
                ss += (v0[0] * v0[0] + v0[1] * v0[1]) + (v0[2] * v0[2] + v0[3] * v0[3]) + (v1[0] * v1[0] + v1[1] * v1[1]) + (v1[2] * v1[2] + v1[3] * v1[3]);
                u32x4 w; w.x = cvtpk(v0[0], v0[1]); w.y = cvtpk(v0[2], v0[3]); w.z = cvtpk(v1[0], v1[1]); w.w = cvtpk(v1[2], v1[3]);
                *(u32x4*)(H1 + ro + bj * 128) = w;
                const f32x4 a0 = v0 * g[bj][0], a1 = v1 * g[bj][1];
                u32x2 w8; w8.x = pk4_fp8(a0[0], a0[1], a0[2], a0[3]); w8.y = pk4_fp8(a1[0], a1[1], a1[2], a1[3]);
                *(u32x2*)(A8 + ro + bj * 128) = w8; }
            ss += __shfl_xor(ss, 16); ss += __shfl_xor(ss, 32);
            if (fq == 0) ssp[(size_t)r * 16 + u.pn * 4 + wc] = ss;
            asm volatile("" ::: "memory");
#pragma unroll
            for (int bj = 0; bj < 2; ++bj) { xc[bj][0] = xn[bj][0]; xc[bj][1] = xn[bj][1]; }
        }
    }
};
struct EpiGU {
    static constexpr bool HAS_INIT = false;
    unsigned char* hid; const float* bgu; const float* slot_rstd;
    __device__ __forceinline__ void operator()(const AccT& acc, const pg8::Unit& u, int wr, int wc, int fr, int fq) const {
        const int row0 = u.pm * 256 + wr * 64 + fr, colr = u.pn * 128 + wc * 32 + 8 * fq;
        const float* bg = bgu + (size_t)u.e * 2048 + colr;
        const f32x4 bg0 = *(const f32x4*)(bg), bg1 = *(const f32x4*)(bg + 4), bl0 = *(const f32x4*)(bg + 1024), bl1 = *(const f32x4*)(bg + 1028);
        float rsv[2][4];
#pragma unroll
        for (int ai = 0; ai < 2; ++ai)
#pragma unroll
            for (int m = 0; m < 4; ++m) rsv[ai][m] = slot_rstd[row0 + ai * 128 + m * 16];
#pragma unroll
        for (int ai = 0; ai < 2; ++ai)
#pragma unroll
            for (int m = 0; m < 4; ++m) { const int r = row0 + ai * 128 + m * 16; const float rs = rsv[ai][m] * WINV;
                float hv[8];
#pragma unroll
                for (int n = 0; n < 2; ++n)
#pragma unroll
                    for (int i = 0; i < 4; ++i) {
                        float gt = acc[ai][0][m][n][i] * rs + (n ? bg1[i] : bg0[i]), ln = acc[ai][1][m][n][i] * rs + (n ? bl1[i] : bl0[i]);
                        gt = fminf(gt, 7.0f); ln = fminf(fmaxf(ln, -7.0f), 7.0f);
                        const float sg = __builtin_amdgcn_rcpf(1.0f + ex2(gt * (-1.702f * LOG2E)));
                        hv[n * 4 + i] = (ln + 1.0f) * (gt * sg); }
                u32x2 w; w.x = pk4_fp8(hv[0], hv[1], hv[2], hv[3]); w.y = pk4_fp8(hv[4], hv[5], hv[6], hv[7]);
                *(u32x2*)(hid + (size_t)r * FF + colr) = w; }
    }
};
struct EpiDown {
    static constexpr bool HAS_INIT = false;
    unsigned char* ys; const float* bd; const float* slot_gate;
    __device__ __forceinline__ void operator()(const AccT& acc, const pg8::Unit& u, int wr, int wc, int fr, int fq) const {
        const int row0 = u.pm * 256 + wr * 64 + fr, col0 = u.pn * 256 + wc * 32 + 8 * fq;
        f32x4 bv[2][2];
#pragma unroll
        for (int bj = 0; bj < 2; ++bj)
#pragma unroll
            for (int n = 0; n < 2; ++n) bv[bj][n] = *(const f32x4*)(bd + (size_t)u.e * DM + col0 + bj * 128 + 4 * n);
        float gtv[2][4];
#pragma unroll
        for (int ai = 0; ai < 2; ++ai)
#pragma unroll
            for (int m = 0; m < 4; ++m) gtv[ai][m] = slot_gate[row0 + ai * 128 + m * 16] * YSCALE;
#pragma unroll
        for (int ai = 0; ai < 2; ++ai)
#pragma unroll
            for (int m = 0; m < 4; ++m) { const int r = row0 + ai * 128 + m * 16; const float gt = gtv[ai][m];
                unsigned char* rowp = ys + (size_t)r * DM + col0;
#pragma unroll
                for (int bj = 0; bj < 2; ++bj) { const f32x4 v0 = (acc[ai][bj][m][0] * WINV + bv[bj][0]) * gt, v1 = (acc[ai][bj][m][1] * WINV + bv[bj][1]) * gt;
                    u32x2 w; w.x = pk4_fp8(v0[0], v0[1], v0[2], v0[3]); w.y = pk4_fp8(v1[0], v1[1], v1[2], v1[3]);
                    *(u32x2*)(rowp + bj * 128) = w; } }
    }
};

struct Args { const float* in[17]; float* out; unsigned char* ws; int ph_lo, ph_hi; };
struct Frame {
    LAS unsigned char* lds; gu32* ctl; int tid, lane, wave, vcu, G;
    const float *x, *meta, *g_mix, *w_in, *g_attn, *conv_w, *conv_b, *g_conv, *w_out, *g_ffn, *w_router, *b_router, *w_gu, *b_gu, *w_down, *b_down, *g_final;
    float* out; unsigned char* ws;
};
template <class T> __device__ __forceinline__ T* wsp(const Frame& F, size_t off) { return (T*)(F.ws + off); }

__device__ __forceinline__ void p0_transpose_item(const float* W, int ldw, int k0, int n0, bf16_t* WT, int Kd, int drow0, LAS unsigned* scr, int lane) {
    const int ks = lane >> 4, n4 = lane & 15;
    f32x4 va[8], vb[8];
    const float* src = W + (size_t)(k0 + 2 * ks) * ldw + n0 + 4 * n4;
#pragma unroll
    for (int i = 0; i < 8; ++i) { va[i] = *(const f32x4*)(src + (size_t)(8 * i) * ldw); vb[i] = *(const f32x4*)(src + (size_t)(8 * i + 1) * ldw); }
#pragma unroll
    for (int i = 0; i < 8; ++i)
#pragma unroll
        for (int j = 0; j < 4; ++j) scr[(4 * n4 + j) * 33 + 4 * i + ks] = cvtpk(va[i][j], vb[i][j]);
    LDS_WAIT(); asm volatile("" ::: "memory");
    const int ns = lane >> 3, c = lane & 7;
#pragma unroll
    for (int r = 0; r < 8; ++r) { const int n = 8 * r + ns; const LAS unsigned* t = scr + n * 33 + 4 * c;
        u32x4 o; o.x = t[0]; o.y = t[1]; o.z = t[2]; o.w = t[3];
        *(u32x4*)(WT + (size_t)(drow0 + n) * Kd + k0 + 8 * c) = o; }
    LDS_WAIT(); asm volatile("" ::: "memory");
}
__device__ __forceinline__ void p0_transpose_item8(const float* W, int ldw, int k0, int n0, unsigned char* WT8, int Kd, int drow0, LAS unsigned* scr, int lane) {
    const int ks = lane >> 4, n4 = lane & 15;
#pragma unroll
    for (int h = 0; h < 2; ++h) {
        f32x4 v[4][4];
        const float* src = W + (size_t)(k0 + 64 * h + 4 * ks) * ldw + n0 + 4 * n4;
#pragma unroll
        for (int i = 0; i < 4; ++i)
#pragma unroll
            for (int q = 0; q < 4; ++q) v[i][q] = *(const f32x4*)(src + (size_t)(16 * i + q) * ldw);
#pragma unroll
        for (int i = 0; i < 4; ++i)
#pragma unroll
            for (int j = 0; j < 4; ++j) scr[(4 * n4 + j) * 33 + 16 * h + 4 * i + ks] = pk4_fp8(v[i][0][j] * WSCALE, v[i][1][j] * WSCALE, v[i][2][j] * WSCALE, v[i][3][j] * WSCALE);
    }
    LDS_WAIT(); asm volatile("" ::: "memory");
    const int ns = lane >> 3, c = lane & 7;
#pragma unroll
    for (int r = 0; r < 8; ++r) { const int n = 8 * r + ns; const LAS unsigned* t = scr + n * 33 + 4 * c;
        u32x4 o; o.x = t[0]; o.y = t[1]; o.z = t[2]; o.w = t[3];
        *(u32x4*)(WT8 + (size_t)(drow0 + n) * Kd + k0 + 16 * c) = o; }
    LDS_WAIT(); asm volatile("" ::: "memory");
}
__device__ __forceinline__ void p0_meta_job(Frame& F, int mw) {
    LAS float* nm = (LAS float*)F.lds;
    LAS float* part = (LAS float*)(F.lds + 65536);
    for (int t = F.wave * 2; t < F.wave * 2 + 2; ++t) {
        float v[16]; float ss = 0.f;
#pragma unroll
        for (int j = 0; j < 16; ++j) { v[j] = F.meta[t * DM + j * 64 + F.lane]; ss += v[j] * v[j]; }
        const float rstd = 1.0f / sqrtf(wave_sum(ss) * (1.0f / DM) + RMS_EPS);
#pragma unroll
        for (int j = 0; j < 16; ++j) { const int k = j * 64 + F.lane; nm[k * 16 + t] = v[j] * rstd * F.g_mix[k]; }
    }
    __syncthreads();
    const int kq = F.tid >> 7, c = F.tid & 127, j = mw * 128 + c, sec4 = j >> 9, jc = j & 511;
    const int ocol = (sec4 == 0 ? 512 : sec4 == 1 ? 1024 : sec4 == 2 ? 2048 : 2560) + jc;
    float acc[16];
#pragma unroll
    for (int t = 0; t < 16; ++t) acc[t] = 0.f;
    for (int kk = kq * 256; kk < kq * 256 + 256; kk += 16) {
        float wv[16];
#pragma unroll
        for (int u = 0; u < 16; ++u) wv[u] = F.w_in[(size_t)(kk + u) * 3072 + ocol];
#pragma unroll
        for (int u = 0; u < 16; ++u) { const float w = wv[u];
            const LAS f32x4* nv = (const LAS f32x4*)(nm + (kk + u) * 16);
#pragma unroll
            for (int q = 0; q < 4; ++q) { const f32x4 n4 = nv[q]; acc[4 * q] += w * n4[0]; acc[4 * q + 1] += w * n4[1]; acc[4 * q + 2] += w * n4[2]; acc[4 * q + 3] += w * n4[3]; } }
    }
#pragma unroll
    for (int t = 0; t < 16; ++t) part[(kq * 128 + c) * 16 + t] = acc[t];
    __syncthreads();
    {
        const int tq = F.tid >> 7;
        bf16_t* KB = wsp<bf16_t>(F, WS_KB); bf16_t* VT = wsp<bf16_t>(F, WS_VT); float* MT = wsp<float>(F, WS_META);
#pragma unroll
        for (int tt = 0; tt < 4; ++tt) { const int t = 4 * tq + tt;
            const float v = (part[(0 * 128 + c) * 16 + t] + part[(1 * 128 + c) * 16 + t]) + (part[(2 * 128 + c) * 16 + t] + part[(3 * 128 + c) * 16 + t]);
            const bf16_t bv = (bf16_t)(cvtpk(v, 0.f) & 0xffffu);
            if (sec4 == 0) { for (int b = 0; b < NB; ++b) KB[(size_t)(b * TPAD + KPAD + t) * 512 + jc] = bv; }
            else if (sec4 == 1) { for (int b = 0; b < NB; ++b) VT[(size_t)jc * (NB * TPAD) + b * TPAD + KPAD + t] = bv; }
            else if (t >= 14) MT[((sec4 - 2) * 2 + (t - 14)) * 512 + jc] = v;
        }
    }
    __syncthreads();
}
__device__ __forceinline__ void p0_prologue(Frame& F) {
    constexpr int NMW = 16;
    if (F.vcu < NMW) {
        p0_meta_job(F, F.vcu);
        bf16_t* KB = wsp<bf16_t>(F, WS_KB); bf16_t* VT = wsp<bf16_t>(F, WS_VT);
        const int gt = F.vcu * 512 + F.tid, NT = NMW * 512;
        for (int i = gt; i < NB * KPAD * 64; i += NT) { const int b = i / (KPAD * 64), r = i % (KPAD * 64); *(u32x4*)(KB + (size_t)(b * TPAD) * 512 + (size_t)r * 8) = (u32x4){0u, 0u, 0u, 0u}; }
        for (int i = gt; i < 512 * NB * 6; i += NT) { const int ch = i / (NB * 6), r = i % (NB * 6), b = r / 6, q = r % 6; *(u32x4*)(VT + (size_t)ch * (NB * TPAD) + b * TPAD + q * 8) = (u32x4){0u, 0u, 0u, 0u}; }
        return;
    }
    const int gw = (F.vcu - NMW) * NWAVES + F.wave, NGW = (F.G - NMW) * NWAVES;
    {
        float* rstd1 = wsp<float>(F, WS_RSTD1); bf16_t* A1 = wsp<bf16_t>(F, WS_A);
        f32x4 g4[4];
#pragma unroll
        for (int j = 0; j < 4; ++j) g4[j] = *(const f32x4*)(F.g_mix + 256 * j + 4 * F.lane);
        for (int m = gw; m < NTOK; m += NGW) {
            const f32x4* xr = (const f32x4*)(F.x + (size_t)m * DM) + F.lane;
            f32x4 v[4]; float s = 0.f;
#pragma unroll
            for (int j = 0; j < 4; ++j) { v[j] = xr[64 * j]; s += (v[j][0] * v[j][0] + v[j][1] * v[j][1]) + (v[j][2] * v[j][2] + v[j][3] * v[j][3]); }
            s = wave_sum(s);
            if (F.lane == 0) rstd1[m] = 1.0f / sqrtf(s * (1.0f / DM) + RMS_EPS);
            u32x2* o8 = (u32x2*)(A1 + (size_t)m * DM) + F.lane;
#pragma unroll
            for (int j = 0; j < 4; ++j) { const f32x4 a = v[j] * g4[j]; u32x2 o; o.x = cvtpk(a[0], a[1]); o.y = cvtpk(a[2], a[3]); o8[64 * j] = o; }
        }
    }
    {
        LAS unsigned* scr = (LAS unsigned*)(F.lds + F.wave * 8704);
        constexpr int I_IN = 16 * 48, I_OUT = 16 * 16, I_GU = 32 * 8 * 32, I_D = 32 * 8 * 16, NITEMS = I_IN + I_OUT + I_GU + I_D;
        bf16_t* WIN = wsp<bf16_t>(F, WS_WIN); bf16_t* WOUT = wsp<bf16_t>(F, WS_WOUT); unsigned char* WGU = wsp<unsigned char>(F, WS_WGU); unsigned char* WD = wsp<unsigned char>(F, WS_WD);
        for (int it = gw; it < NITEMS; it += NGW) {
            int r = it;
            if (r < I_IN) { const int kb = r / 48, nb = r % 48, n0 = 64 * nb, sec = n0 >> 9;
                const int dsec = sec == 0 ? 0 : sec == 1 ? 1 : sec == 2 ? 5 : sec - 1;
                p0_transpose_item(F.w_in, 3072, 64 * kb, n0, WIN, DM, dsec * 512 + (n0 & 511), scr, F.lane); continue; }
            r -= I_IN;
            if (r < I_OUT) { const int kb = r / 16, nb = r % 16; p0_transpose_item(F.w_out, 1024, 64 * kb, 64 * nb, WOUT, DM, 64 * nb, scr, F.lane); continue; }
            r -= I_OUT;
            if (r < I_GU) { const int e = r / 256, q = r % 256, kb = q / 32, nb = q % 32, n0 = 64 * nb, c = n0 & 1023;
                const int drow = (c >> 7) * 256 + (n0 >= 1024 ? 128 : 0) + (c & 127);
                p0_transpose_item8(F.w_gu + (size_t)e * 1024 * 2048, 2048, 128 * kb, n0, WGU + (size_t)e * 2048 * 1024, DM, drow, scr, F.lane); continue; }
            r -= I_GU;
            { const int e = r / 128, q = r % 128, kb = q / 16, nb = q % 16;
                p0_transpose_item8(F.w_down + (size_t)e * 1024 * 1024, 1024, 128 * kb, 64 * nb, WD + (size_t)e * 1024 * 1024, FF, 64 * nb, scr, F.lane); }
        }
    }
}
template <bool EDGE>
__device__ __forceinline__ void sb_tile(f32x16& s0, f32x16& s1, float& carry, int kp0  , int qpos, bool hi0, bf16x8 (&pf)[2][2]) {
    float R[4];
#pragma unroll
    for (int q = 0; q < 4; ++q) {
        float S = 1.0f;
#pragma unroll
        for (int i = 7; i >= 0; --i) {
            const int r = (q & 1) * 8 + i;
            const float z = fminf((q < 2) ? s0[r] : s1[r], 100.0f);
            const float e = ex2(z);
            float kp_ = __builtin_amdgcn_rcpf(1.0f + e);
            float sg = e * kp_;
            if (EDGE) { const int kp = kp0 + 16 * q + i; const bool valid = (kp < qpos) && (kp >= KPAD); kp_ = valid ? kp_ : 1.0f; sg = valid ? sg : 0.0f; }
            const float m = sg * S; S *= kp_;
            if (q < 2) s0[r] = m; else s1[r] = m;
        }
        R[q] = S;
        __builtin_amdgcn_sched_barrier(0);
    }
    const float P0 = __shfl_xor(R[0], 32), P1 = __shfl_xor(R[1], 32), P2 = __shfl_xor(R[2], 32), P3 = __shfl_xor(R[3], 32);
    const float T1 = R[1] * P1, T2 = R[2] * P2, T3 = R[3] * P3, T0 = R[0] * P0;
    const float b3 = carry * (hi0 ? P3 : 1.0f), b2 = carry * (T3 * (hi0 ? P2 : 1.0f)), b1 = carry * ((T3 * T2) * (hi0 ? P1 : 1.0f)), b0 = carry * ((T3 * T2 * T1) * (hi0 ? P0 : 1.0f));
#pragma unroll
    for (int i = 0; i < 8; ++i) { s0[i] *= b0; s0[8 + i] *= b1; s1[i] *= b2; s1[8 + i] *= b3; }
    carry *= (T0 * T1) * (T2 * T3);
    u32x4 w;
    w.x = cvtpk(s0[0], s0[1]); w.y = cvtpk(s0[2], s0[3]); w.z = cvtpk(s0[4], s0[5]); w.w = cvtpk(s0[6], s0[7]); pf[0][0] = __builtin_bit_cast(bf16x8, w);
    w.x = cvtpk(s0[8], s0[9]); w.y = cvtpk(s0[10], s0[11]); w.z = cvtpk(s0[12], s0[13]); w.w = cvtpk(s0[14], s0[15]); pf[0][1] = __builtin_bit_cast(bf16x8, w);
    w.x = cvtpk(s1[0], s1[1]); w.y = cvtpk(s1[2], s1[3]); w.z = cvtpk(s1[4], s1[5]); w.w = cvtpk(s1[6], s1[7]); pf[1][0] = __builtin_bit_cast(bf16x8, w);
    w.x = cvtpk(s1[8], s1[9]); w.y = cvtpk(s1[10], s1[11]); w.z = cvtpk(s1[12], s1[13]); w.w = cvtpk(s1[14], s1[15]); pf[1][1] = __builtin_bit_cast(bf16x8, w);
}
template <bool EDGE>
__device__ __forceinline__ void sb_tile32(f32x16& s0, float& carry, int kp0  , int qpos, bool hi0, bf16x8 (&pf)[2]) {
    float R[2];
#pragma unroll
    for (int q = 0; q < 2; ++q) {
        float S = 1.0f;
#pragma unroll
        for (int i = 7; i >= 0; --i) {
            const int r = q * 8 + i;
            const float z = fminf(s0[r], 100.0f);
            const float e = ex2(z);
            float kp_ = __builtin_amdgcn_rcpf(1.0f + e);
            float sg = e * kp_;
            if (EDGE) { const int kp = kp0 + 16 * q + i; const bool valid = (kp < qpos) && (kp >= KPAD); kp_ = valid ? kp_ : 1.0f; sg = valid ? sg : 0.0f; }
            s0[r] = sg * S; S *= kp_;
        }
        R[q] = S;
    }
    const float P0 = __shfl_xor(R[0], 32), P1 = __shfl_xor(R[1], 32);
    const float T0 = R[0] * P0, T1 = R[1] * P1;
    const float b1 = carry * (hi0 ? P1 : 1.0f), b0 = carry * (T1 * (hi0 ? P0 : 1.0f));
#pragma unroll
    for (int i = 0; i < 8; ++i) { s0[i] *= b0; s0[8 + i] *= b1; }
    carry *= T0 * T1;
    u32x4 w;
    w.x = cvtpk(s0[0], s0[1]); w.y = cvtpk(s0[2], s0[3]); w.z = cvtpk(s0[4], s0[5]); w.w = cvtpk(s0[6], s0[7]); pf[0] = __builtin_bit_cast(bf16x8, w);
    w.x = cvtpk(s0[8], s0[9]); w.y = cvtpk(s0[10], s0[11]); w.z = cvtpk(s0[12], s0[13]); w.w = cvtpk(s0[14], s0[15]); pf[1] = __builtin_bit_cast(bf16x8, w);
}
#define MFMA32(a, b, c) __builtin_amdgcn_mfma_f32_32x32x16_bf16((a), (b), (c), 0, 0, 0)
template <bool DO_CONV, bool DO_ATT>
__device__ __forceinline__ void p2_unit(Frame& F, int b, int qb) {
    int lane_ = F.lane, head_ = F.wave;
    asm volatile("" : "+v"(lane_), "+s"(head_));
    const int lane = lane_, head = head_, l31 = lane & 31, hi = lane >> 5; const bool hi0 = hi == 0;
    const bf16_t* Q = wsp<bf16_t>(F, WS_Q); const bf16_t* KB = wsp<bf16_t>(F, WS_KB); const bf16_t* VT = wsp<bf16_t>(F, WS_VT);
    bf16_t* MX = wsp<bf16_t>(F, WS_MIXED);
    LAS float* ssA = (LAS float*)(F.lds + P2_SS_OFF);
    LAS float* ssC = (LAS float*)(F.lds + P2_SS_OFF + 2048);
    const int row0 = b * SEQ + qb * 64;
    const int pi = (l31 & 0x13) | ((l31 & 4) << 1) | ((l31 & 8) >> 1);
    const __amdgpu_buffer_rsrc_t rsK = __builtin_amdgcn_make_buffer_rsrc((void*)(KB + (size_t)b * TPAD * 512), (short)0, TPAD * 512 * 2, 0x00020000);
    const __amdgpu_buffer_rsrc_t rsV = __builtin_amdgcn_make_buffer_rsrc((void*)(VT + (size_t)b * TPAD), (short)0, (511 * NB * TPAD + TPAD) * 2, 0x00020000);
    const int voffK = (pi * 512 + head * 64 + hi * 8) * 2;
    const int voffV0 = ((head * 64 + l31) * (NB * TPAD) + hi * 8) * 2, voffV1 = voffV0 + 32 * NB * TPAD * 2;
    LAS unsigned char* kbuf = F.lds + head * 16384; LAS unsigned char* vbuf = kbuf + 4096; LAS unsigned char* qbuf = kbuf + 8192;
    const int P0 = QOFF + 64 * qb, qpos = P0 + l31;
#define ATT_DMA_K(st) do { \
        __builtin_amdgcn_raw_ptr_buffer_load_lds(rsK, (LAS void*)(kbuf + 0 * 1024), 16, voffK, (st) * 1024 + 0, 0, 0); \
        __builtin_amdgcn_raw_ptr_buffer_load_lds(rsK, (LAS void*)(kbuf + 1 * 1024), 16, voffK, (st) * 1024 + 32, 0, 0); \
        __builtin_amdgcn_raw_ptr_buffer_load_lds(rsK, (LAS void*)(kbuf + 2 * 1024), 16, voffK, (st) * 1024 + 64, 0, 0); \
        __builtin_amdgcn_raw_ptr_buffer_load_lds(rsK, (LAS void*)(kbuf + 3 * 1024), 16, voffK, (st) * 1024 + 96, 0, 0); } while (0)
#define ATT_DMA_V(st) do { \
        __builtin_amdgcn_raw_ptr_buffer_load_lds(rsV, (LAS void*)(vbuf + 0 * 1024), 16, voffV0, (st) * 2 + 0, 0, 0); \
        __builtin_amdgcn_raw_ptr_buffer_load_lds(rsV, (LAS void*)(vbuf + 1 * 1024), 16, voffV0, (st) * 2 + 32, 0, 0); \
        __builtin_amdgcn_raw_ptr_buffer_load_lds(rsV, (LAS void*)(vbuf + 2 * 1024), 16, voffV1, (st) * 2 + 0, 0, 0); \
        __builtin_amdgcn_raw_ptr_buffer_load_lds(rsV, (LAS void*)(vbuf + 3 * 1024), 16, voffV1, (st) * 2 + 32, 0, 0); } while (0)
    if constexpr (DO_ATT) {
        asm volatile("s_waitcnt lgkmcnt(0)" ::: "memory");
        ATT_DMA_K(P0 + 32); ATT_DMA_V(P0 + 32);
        {
            const __amdgpu_buffer_rsrc_t rsQ = __builtin_amdgcn_make_buffer_rsrc((void*)(Q + (size_t)row0 * 512), (short)0, 64 * 512 * 2, 0x00020000);
            const int voffQ = (l31 * 512 + head * 64 + hi * 8) * 2;
#pragma unroll
            for (int i = 0; i < 8; ++i) __builtin_amdgcn_raw_ptr_buffer_load_lds(rsQ, (LAS void*)(qbuf + i * 1024), 16, voffQ, (i >> 2) * 32768 + (i & 3) * 32, 0, 0);
        }
    }
    if constexpr (DO_CONV) {
        const int cgp = lane & 7, rg = lane >> 3, ch0 = head * 64 + cgp * 8;
        const bf16_t* CB = wsp<bf16_t>(F, WS_CB); const bf16_t* CC = wsp<bf16_t>(F, WS_CC); const bf16_t* CX = wsp<bf16_t>(F, WS_CX); const float* MT = wsp<float>(F, WS_META);
        float cv[8][8];
        {
            float w0[8], w1[8], w2[8], bs[8], u2[8], u1[8];
#pragma unroll
            for (int k = 0; k < 8; ++k) { w0[k] = F.conv_w[ch0 + k]; w1[k] = F.conv_w[512 + ch0 + k]; w2[k] = F.conv_w[1024 + ch0 + k]; bs[k] = F.conv_b[ch0 + k]; u2[k] = 0.f; u1[k] = 0.f; }
            float um[2][8];
#pragma unroll
            for (int t = 0; t < 2; ++t)
#pragma unroll
                for (int k = 0; k < 8; ++k) um[t][k] = 0.f;
            if (qb == 0) {
#pragma unroll
                for (int t = 0; t < 2; ++t) { const f32x4 c0 = *(const f32x4*)(MT + t * 512 + ch0), c1 = *(const f32x4*)(MT + t * 512 + ch0 + 4), x0 = *(const f32x4*)(MT + (2 + t) * 512 + ch0), x1 = *(const f32x4*)(MT + (2 + t) * 512 + ch0 + 4);
#pragma unroll
                    for (int k = 0; k < 4; ++k) { um[t][k] = c0[k] * x0[k]; um[t][4 + k] = c1[k] * x1[k]; } }
            }
#pragma unroll
            for (int hb = 0; hb < 2; ++hb) {
                u32x4 c4[6], x4[6], b4[4];
#pragma unroll
                for (int i = 0; i < (hb ? 4 : 6); ++i) { const int sl = qb * 64 + rg * 8 + (hb ? 4 + i : i - 2); const size_t ro = (size_t)(b * SEQ + (sl < 0 ? 0 : sl)) * 512 + ch0;
                    c4[i] = *(const u32x4*)(CC + ro); x4[i] = *(const u32x4*)(CX + ro); }
#pragma unroll
                for (int i = 0; i < 4; ++i) b4[i] = *(const u32x4*)(CB + (size_t)(b * SEQ + qb * 64 + rg * 8 + 4 * hb + i) * 512 + ch0);
#pragma unroll
                for (int i = 0; i < (hb ? 4 : 6); ++i) {
                    const int ri = hb ? 4 + i : i - 2;
                    const int sl = qb * 64 + rg * 8 + ri;
                    float u[8];
                    u[0] = bflo(c4[i].x) * bflo(x4[i].x); u[1] = bfhi(c4[i].x) * bfhi(x4[i].x); u[2] = bflo(c4[i].y) * bflo(x4[i].y); u[3] = bfhi(c4[i].y) * bfhi(x4[i].y);
                    u[4] = bflo(c4[i].z) * bflo(x4[i].z); u[5] = bfhi(c4[i].z) * bfhi(x4[i].z); u[6] = bflo(c4[i].w) * bflo(x4[i].w); u[7] = bfhi(c4[i].w) * bfhi(x4[i].w);
                    if (ri < 0) {
#pragma unroll
                        for (int k = 0; k < 8; ++k) u[k] = (sl < 0) ? um[ri + 2][k] : u[k];
                    } else {
                        const u32x4 bb = b4[ri - 4 * hb];
                        const float cbv[8] = {bflo(bb.x), bfhi(bb.x), bflo(bb.y), bfhi(bb.y), bflo(bb.z), bfhi(bb.z), bflo(bb.w), bfhi(bb.w)};
#pragma unroll
                        for (int k = 0; k < 8; ++k) cv[ri][k] = cbv[k] * (w0[k] * u2[k] + w1[k] * u1[k] + w2[k] * u[k] + bs[k]);
                    }
#pragma unroll
                    for (int k = 0; k < 8; ++k) { u2[k] = u1[k]; u1[k] = u[k]; }
                }
            }
        }
#pragma unroll
        for (int i = 0; i < 8; ++i) { float ss = 0.f;
#pragma unroll
            for (int k = 0; k < 8; ++k) ss += cv[i][k] * cv[i][k];
            ss += __shfl_xor(ss, 1); ss += __shfl_xor(ss, 2); ss += __shfl_xor(ss, 4);
            if (cgp == 0) ssC[head * 64 + rg * 8 + i] = ss; }
        __syncthreads();
        const f32x4 gc0 = *(const f32x4*)(F.g_conv + ch0), gc1 = *(const f32x4*)(F.g_conv + ch0 + 4);
#pragma unroll
        for (int i = 0; i < 8; ++i) { const int rl = rg * 8 + i; float tot = 0.f;
#pragma unroll
            for (int w = 0; w < 8; ++w) tot += ssC[w * 64 + rl];
            const float rstd = 1.0f / sqrtf(tot * (1.0f / AW) + RMS_EPS);
            u32x4 w4; w4.x = cvtpk(cv[i][0] * rstd * gc0[0], cv[i][1] * rstd * gc0[1]); w4.y = cvtpk(cv[i][2] * rstd * gc0[2], cv[i][3] * rstd * gc0[3]);
            w4.z = cvtpk(cv[i][4] * rstd * gc1[0], cv[i][5] * rstd * gc1[1]); w4.w = cvtpk(cv[i][6] * rstd * gc1[2], cv[i][7] * rstd * gc1[3]);
            *(u32x4*)(MX + (size_t)(row0 + rl) * DM + 512 + ch0) = w4; }
    }
    if constexpr (DO_ATT) {
    f32x16 o[2][2];
#pragma unroll
    for (int d = 0; d < 2; ++d)
#pragma unroll
        for (int q2 = 0; q2 < 2; ++q2)
#pragma unroll
            for (int r = 0; r < 16; ++r) o[d][q2][r] = 0.f;
    float carry0 = 1.0f, carry1 = 1.0f;
    asm volatile("s_waitcnt vmcnt(0)" ::: "memory");
    for (int start = P0 + 32; ; start -= 32) {
        const bool lastt = start <= KPAD;
        if (start != P0 + 32) asm volatile("s_waitcnt vmcnt(4)" ::: "memory");
        bf16x8 kf[4];
#pragma unroll
        for (int i = 0; i < 4; ++i) kf[i] = *(const LAS bf16x8*)(kbuf + i * 1024 + lane * 16);
        asm volatile("s_waitcnt lgkmcnt(0)" ::: "memory");
        if (!lastt) ATT_DMA_K(start - 32);
#pragma unroll
        for (int q2 = 0; q2 < 2; ++q2) {
            if (q2 == 0 && start == P0 + 32) continue;
            f32x16 s0;
#pragma unroll
            for (int r = 0; r < 16; ++r) s0[r] = 0.f;
#pragma unroll
            for (int s4 = 0; s4 < 4; ++s4) { const bf16x8 qf = *(const LAS bf16x8*)(qbuf + (q2 * 4 + s4) * 1024 + lane * 16); s0 = MFMA32(kf[s4], qf, s0); }
            bf16x8 pf[2];
            float& carry = q2 ? carry1 : carry0;
            const bool edge = (start == P0 + 32 * q2) || lastt;
            if (edge) sb_tile32<true>(s0, carry, start + 8 * hi, qpos + 32 * q2, hi0, pf);
            else sb_tile32<false>(s0, carry, start + 8 * hi, qpos + 32 * q2, hi0, pf);
            if (start != P0 + 32 && (q2 == 0 || start == P0)) { if (lastt) asm volatile("s_waitcnt vmcnt(0)" ::: "memory"); else asm volatile("s_waitcnt vmcnt(4)" ::: "memory"); }
            bf16x8 vf[4];
#pragma unroll
            for (int i = 0; i < 4; ++i) vf[i] = *(const LAS bf16x8*)(vbuf + i * 1024 + lane * 16);
#pragma unroll
            for (int d = 0; d < 2; ++d)
#pragma unroll
                for (int s2 = 0; s2 < 2; ++s2) o[d][q2] = MFMA32(vf[d * 2 + s2], pf[s2], o[d][q2]);
        }
        if (lastt || __all((carry0 < EXIT_THR) && (carry1 < EXIT_THR))) break;
        asm volatile("s_waitcnt lgkmcnt(0)" ::: "memory");
        ATT_DMA_V(start - 32);
    }
    asm volatile("s_waitcnt vmcnt(0)" ::: "memory");
    int lane2 = lane; asm volatile("" : "+v"(lane2));
    const int l31b = lane2 & 31, hib = lane2 >> 5;
#pragma unroll
    for (int q2 = 0; q2 < 2; ++q2) {
        float ss = 0.f;
#pragma unroll
        for (int d = 0; d < 2; ++d)
#pragma unroll
            for (int r = 0; r < 16; ++r) ss += o[d][q2][r] * o[d][q2][r];
        ss += __shfl_xor(ss, 32);
        if (hib == 0) ssA[head * 64 + q2 * 32 + l31b] = ss;
    }
    __syncthreads();
#pragma unroll
    for (int q2 = 0; q2 < 2; ++q2) {
        const int rl = q2 * 32 + l31b; float tot = 0.f;
#pragma unroll
        for (int h = 0; h < 8; ++h) tot += ssA[h * 64 + rl];
        const float rstd = 1.0f / sqrtf(tot * (1.0f / AW) + RMS_EPS);
        bf16_t* orow = MX + (size_t)(row0 + rl) * DM + head * 64 + 4 * hib;
#pragma unroll
        for (int d = 0; d < 2; ++d)
#pragma unroll
            for (int g = 0; g < 4; ++g) { const f32x4 ga = *(const f32x4*)(F.g_attn + head * 64 + 32 * d + 8 * g + 4 * hib);
                u32x2 w; w.x = cvtpk(o[d][q2][4 * g] * rstd * ga[0], o[d][q2][4 * g + 1] * rstd * ga[1]); w.y = cvtpk(o[d][q2][4 * g + 2] * rstd * ga[2], o[d][q2][4 * g + 3] * rstd * ga[3]);
                *(u32x2*)(orow + 32 * d + 8 * g) = w; }
    }
    __syncthreads();
    }
#undef ATT_DMA_K
#undef ATT_DMA_V
}

__device__ __forceinline__ void p4_router(Frame& F) {
    LAS unsigned char* img = F.lds;
    LAS int* hist = (LAS int*)(F.lds + 65536);
    for (int idx = F.tid; idx < 64 * 2 * 32; idx += 512) { const int s = idx >> 6, h = (idx >> 5) & 1, e = idx & 31; const int k0 = 16 * s + 8 * h; const float* wp = F.w_router + (size_t)k0 * NE + e; const float* gp = F.g_ffn + k0;
        u32x4 w; w.x = cvtpk(wp[0] * gp[0], wp[NE] * gp[1]); w.y = cvtpk(wp[2 * NE] * gp[2], wp[3 * NE] * gp[3]); w.z = cvtpk(wp[4 * NE] * gp[4], wp[5 * NE] * gp[5]); w.w = cvtpk(wp[6 * NE] * gp[6], wp[7 * NE] * gp[7]);
        *(LAS u32x4*)(img + idx * 16) = w; }
    if (F.tid < 32) hist[F.tid] = 0;
    __syncthreads();
    const bf16_t* A2 = wsp<bf16_t>(F, WS_A); const float* ssp = wsp<float>(F, WS_SSP); float* rstd2 = wsp<float>(F, WS_RSTD2);
    int* tope = wsp<int>(F, WS_TOPE); float* gate = wsp<float>(F, WS_GATE); int* cnt = wsp<int>(F, WS_CNT);
    const int wg = F.vcu;
    if (F.wave < 4) {
        const int l31 = F.lane & 31, hi = F.lane >> 5, row = wg * 128 + F.wave * 32 + l31;
        f32x16 acc;
#pragma unroll
        for (int r = 0; r < 16; ++r) acc[r] = 0.f;
        const bf16_t* ap = A2 + (size_t)row * DM + 8 * hi;
#pragma unroll 8
        for (int s = 0; s < 64; ++s) { const bf16x8 a = *(const LAS bf16x8*)(img + ((s * 2 + hi) * 32 + l31) * 16); const bf16x8 bq = *(const bf16x8*)(ap + 16 * s); acc = MFMA32(a, bq, acc); }
        float ss = 0.f;
#pragma unroll
        for (int q = 0; q < 4; ++q) { const f32x4 p4 = *(const f32x4*)(ssp + (size_t)row * 16 + 4 * q); ss += (p4[0] + p4[1]) + (p4[2] + p4[3]); }
        const float rstd = 1.0f / sqrtf(ss * (1.0f / DM) + RMS_EPS);
        float lg[16];
#pragma unroll
        for (int r = 0; r < 16; ++r) lg[r] = acc[r] * rstd + F.b_router[(r & 3) + 8 * (r >> 2) + 4 * hi];
        float cvv[8]; int cei[8];
#pragma unroll
        for (int k = 0; k < 4; ++k) { float best = -INFINITY; int bi = 0;
#pragma unroll
            for (int r = 0; r < 16; ++r) { const bool gtb = lg[r] > best; best = gtb ? lg[r] : best; bi = gtb ? r : bi; }
#pragma unroll
            for (int r = 0; r < 16; ++r) lg[r] = (r == bi) ? -INFINITY : lg[r];
            cvv[k] = best; cei[k] = (bi & 3) + 8 * (bi >> 2) + 4 * hi; }
#pragma unroll
        for (int k = 0; k < 4; ++k) { cvv[4 + k] = __shfl_xor(cvv[k], 32); cei[4 + k] = __shfl_xor(cei[k], 32); }
        float tv[4]; int te[4];
#pragma unroll
        for (int k = 0; k < 4; ++k) { float best = -INFINITY; int be = 1 << 30, bi = 0;
#pragma unroll
            for (int c = 0; c < 8; ++c) { const bool better = (cvv[c] > best) || (cvv[c] == best && cei[c] < be); best = better ? cvv[c] : best; be = better ? cei[c] : be; bi = better ? c : bi; }
#pragma unroll
            for (int c = 0; c < 8; ++c) { const bool hit = (c == bi); cvv[c] = hit ? -INFINITY : cvv[c]; cei[c] = hit ? (1 << 30) : cei[c]; }
            tv[k] = best; te[k] = be; }
        const float e1 = ex2((tv[1] - tv[0]) * LOG2E), e2 = ex2((tv[2] - tv[0]) * LOG2E), e3 = ex2((tv[3] - tv[0]) * LOG2E);
        const float inv = 1.0f / (1.0f + e1 + e2 + e3);
        if (hi == 0) {
            rstd2[row] = rstd;
            *(i32x4*)(tope + (size_t)row * 4) = (i32x4){te[0], te[1], te[2], te[3]};
            *(f32x4*)(gate + (size_t)row * 4) = (f32x4){inv, e1 * inv, e2 * inv, e3 * inv};
#pragma unroll
            for (int k = 0; k < 4; ++k) atomicAdd((int*)(hist + te[k]), 1);
        }
    }
    __syncthreads();
    if (F.tid < 32) cnt[wg * 32 + F.tid] = hist[F.tid];
    __syncthreads();
}

__device__ __forceinline__ void p5_scatter(Frame& F) {
    LAS int* tot = (LAS int*)F.lds; LAS int* pre = tot + 32; LAS int* ctr = tot + 64; LAS int* pstart = tot + 96;
    const int* cnt = wsp<int>(F, WS_CNT); const int wg = F.vcu;
    if (F.tid < 64) tot[F.tid] = 0;
    __syncthreads();
    { const int e = F.tid & 31, j = F.tid >> 5; int t = 0, p = 0;
        for (int w = j; w < 256; w += 16) { const int c = ld_i(cnt + w * 32 + e); t += c; p += (w < wg) ? c : 0; }
        atomicAdd((int*)(tot + e), t); atomicAdd((int*)(pre + e), p); }
    __syncthreads();
    if (F.tid == 0) { int run = 0; for (int e = 0; e < 32; ++e) { pstart[e] = run; run += (tot[e] + 255) & ~255; } pstart[32] = run; }
    __syncthreads();
    if (F.tid < 32) ctr[F.tid] = pstart[F.tid] + pre[F.tid];
    int* slot_tok = wsp<int>(F, WS_SLOTTOK); float* slot_gate = wsp<float>(F, WS_SLOTGATE); float* slot_rstd = wsp<float>(F, WS_SLOTRSTD);
    int* tile_e = wsp<int>(F, WS_TILEE);
    if (wg == 0) {
        if (F.tid < 32) { for (int rt = pstart[F.tid] >> 8; rt < (pstart[F.tid + 1] >> 8); ++rt) tile_e[rt] = F.tid; }
        if (F.tid == 0) tile_e[CAP_TILES] = pstart[32] >> 8;
        if (F.tid < 33) tile_e[CAP_TILES + 1 + F.tid] = pstart[F.tid] >> 8;
    }
    if (wg < 32) { const int e = wg; for (int s = pstart[e] + tot[e] + F.tid; s < pstart[e + 1]; s += 512) { slot_tok[s] = 0; slot_gate[s] = 0.f; slot_rstd[s] = 0.f; } }
    __syncthreads();
    { const int tok = wg * 128 + (F.tid >> 2), k = F.tid & 3;
        const int e = ld_i(wsp<int>(F, WS_TOPE) + tok * 4 + k);
        const int slot = atomicAdd((int*)(ctr + e), 1);
        slot_tok[slot] = tok; slot_gate[slot] = ld_f(wsp<float>(F, WS_GATE) + tok * 4 + k); slot_rstd[slot] = ld_f(wsp<float>(F, WS_RSTD2) + tok);
        wsp<int>(F, WS_TOKSLOT)[tok * 4 + k] = slot; }
    __syncthreads();
}

__device__ __forceinline__ void p8_combine(Frame& F, float* dst) {
    const int gw = F.vcu * NWAVES + F.wave, NGW = F.G * NWAVES;
    const unsigned char* ys = wsp<unsigned char>(F, WS_YS); const int* tokslot = wsp<int>(F, WS_TOKSLOT); const bf16_t* H1 = wsp<bf16_t>(F, WS_A);
    f32x4 gf[2][2];
#pragma unroll
    for (int j = 0; j < 2; ++j) { gf[j][0] = *(const f32x4*)(F.g_final + 512 * j + 8 * F.lane); gf[j][1] = *(const f32x4*)(F.g_final + 512 * j + 8 * F.lane + 4); }
    for (int m0 = gw; m0 < NTOK; m0 += 16 * NGW) {
        const int mrow = m0 + (F.lane >> 2) * NGW;
        const int myslot = (mrow < NTOK) ? ld_i(tokslot + (size_t)mrow * 4 + (F.lane & 3)) : 0;
#pragma unroll 1
        for (int r = 0; r < 16; r += 2) {
            const int ma = m0 + r * NGW, mb = ma + NGW;
            if (ma >= NTOK) break;
            const bool hasb = mb < NTOK; const int mbb = hasb ? mb : ma;
            int sa[4], sb[4];
#pragma unroll
            for (int k = 0; k < 4; ++k) { sa[k] = __builtin_amdgcn_readfirstlane(__shfl(myslot, 4 * r + k)); sb[k] = __builtin_amdgcn_readfirstlane(__shfl(myslot, 4 * r + 4 + k)); }
            u32x4 ha[2], hb[2]; u32x2 ya[2][4], yb[2][4];
#pragma unroll
            for (int j = 0; j < 2; ++j) { ha[j] = *(const u32x4*)(H1 + (size_t)ma * DM + 512 * j + 8 * F.lane); hb[j] = *(const u32x4*)(H1 + (size_t)mbb * DM + 512 * j + 8 * F.lane);
#pragma unroll
                for (int k = 0; k < 4; ++k) { ya[j][k] = *(const u32x2*)(ys + (size_t)sa[k] * DM + 512 * j + 8 * F.lane); yb[j][k] = *(const u32x2*)(ys + (size_t)sb[k] * DM + 512 * j + 8 * F.lane); } }
            f32x4 va[2][2], vb[2][2]; float ssa = 0.f, ssb = 0.f;
#pragma unroll
            for (int j = 0; j < 2; ++j) {
                f32x4 ea0 = {0.f, 0.f, 0.f, 0.f}, ea1 = ea0, eb0 = ea0, eb1 = ea0;
#pragma unroll
                for (int k = 0; k < 4; ++k) { const u32x2 y = ya[j][k], z = yb[j][k];
                    const f32x2 y0 = fp8lo(y.x), y1 = fp8hi(y.x), y2 = fp8lo(y.y), y3 = fp8hi(y.y), z0 = fp8lo(z.x), z1 = fp8hi(z.x), z2 = fp8lo(z.y), z3 = fp8hi(z.y);
                    ea0[0] += y0[0]; ea0[1] += y0[1]; ea0[2] += y1[0]; ea0[3] += y1[1]; ea1[0] += y2[0]; ea1[1] += y2[1]; ea1[2] += y3[0]; ea1[3] += y3[1];
                    eb0[0] += z0[0]; eb0[1] += z0[1]; eb0[2] += z1[0]; eb0[3] += z1[1]; eb1[0] += z2[0]; eb1[1] += z2[1]; eb1[2] += z3[0]; eb1[3] += z3[1]; }
                va[j][0] = (f32x4){bflo(ha[j].x), bfhi(ha[j].x), bflo(ha[j].y), bfhi(ha[j].y)} + ea0 * YINV; va[j][1] = (f32x4){bflo(ha[j].z), bfhi(ha[j].z), bflo(ha[j].w), bfhi(ha[j].w)} + ea1 * YINV;
                vb[j][0] = (f32x4){bflo(hb[j].x), bfhi(hb[j].x), bflo(hb[j].y), bfhi(hb[j].y)} + eb0 * YINV; vb[j][1] = (f32x4){bflo(hb[j].z), bfhi(hb[j].z), bflo(hb[j].w), bfhi(hb[j].w)} + eb1 * YINV;
#pragma unroll
                for (int q = 0; q < 2; ++q) { ssa += (va[j][q][0] * va[j][q][0] + va[j][q][1] * va[j][q][1]) + (va[j][q][2] * va[j][q][2] + va[j][q][3] * va[j][q][3]);
                    ssb += (vb[j][q][0] * vb[j][q][0] + vb[j][q][1] * vb[j][q][1]) + (vb[j][q][2] * vb[j][q][2] + vb[j][q][3] * vb[j][q][3]); } }
            const float ra = 1.0f / sqrtf(wave_sum(ssa) * (1.0f / DM) + RMS_EPS), rb = 1.0f / sqrtf(wave_sum(ssb) * (1.0f / DM) + RMS_EPS);
            float* oa = dst + (size_t)ma * DM + 8 * F.lane; float* ob = dst + (size_t)mbb * DM + 8 * F.lane;
#pragma unroll
            for (int j = 0; j < 2; ++j) { *(f32x4*)(oa + 512 * j) = va[j][0] * ra * gf[j][0]; *(f32x4*)(oa + 512 * j + 4) = va[j][1] * ra * gf[j][1]; }
            if (hasb) {
#pragma unroll
                for (int j = 0; j < 2; ++j) { *(f32x4*)(ob + 512 * j) = vb[j][0] * rb * gf[j][0]; *(f32x4*)(ob + 512 * j + 4) = vb[j][1] * rb * gf[j][1]; } }
        }
    }
}

#ifndef ALIGN_P3
#define ALIGN_P3 true
#endif
#ifndef ALIGN_P67
#define ALIGN_P67 true
#endif
#ifndef REP3
#define REP3 1
#endif
#ifndef REP1
#define REP1 1
#endif
#ifndef REP6
#define REP6 1
#endif
#ifndef REP7
#define REP7 1
#endif
__device__ __forceinline__ void run_p1(Frame& F) {
    { pg8::SchedPlain S; S.init(wsp<bf16_t>(F, WS_A), wsp<bf16_t>(F, WS_WIN), NTOK, 2560, F.G, (int)blockIdx.x); S.rep = REP1;
      EpiProj E{wsp<bf16_t>(F, WS_Q), wsp<bf16_t>(F, WS_KB), wsp<bf16_t>(F, WS_CB), wsp<bf16_t>(F, WS_CC), wsp<bf16_t>(F, WS_CX), wsp<float>(F, WS_RSTD1)};
      pg8::gemm_phase<EpiProj, pg8::SchedPlain, false>(F.lds, S, E); }
    { pg8::SchedPlain S; S.init(wsp<bf16_t>(F, WS_WIN) + (size_t)2560 * DM, wsp<bf16_t>(F, WS_A), 512, NTOK, F.G, (int)blockIdx.x);
      EpiVt E{wsp<bf16_t>(F, WS_VT), wsp<float>(F, WS_RSTD1)};
      pg8::gemm_phase<EpiVt, pg8::SchedPlain, false>(F.lds, S, E); }
}
template <bool DO_CONV, bool DO_ATT>
__device__ __forceinline__ void run_p2(Frame& F) {
    for (int u = F.vcu; u < NB * (SEQ / 64); u += F.G) p2_unit<DO_CONV, DO_ATT>(F, u >> 6, u & 63);
}
__device__ __forceinline__ void run_p3(Frame& F) {
#ifdef P3_STAGGER
    if (F.vcu & 1) { for (int i_ = 0; i_ < P3_STAGGER; ++i_) __builtin_amdgcn_s_sleep(127); }
#endif
    pg8::SchedPlain S; S.init(wsp<bf16_t>(F, WS_MIXED), wsp<bf16_t>(F, WS_WOUT), NTOK, DM, F.G, (int)blockIdx.x); S.rep = REP3;
    EpiOut E{F.x, wsp<bf16_t>(F, WS_A), wsp<unsigned char>(F, WS_A8), wsp<float>(F, WS_SSP), F.g_ffn};
    pg8::gemm_phase<EpiOut, pg8::SchedPlain, false, false, ALIGN_P3>(F.lds, S, E);
}
__device__ __forceinline__ void run_p6(Frame& F) {
    pg8::SchedGrouped<1024> S; S.A = (const char*)wsp<unsigned char>(F, WS_A8); S.Bt = (const char*)wsp<unsigned char>(F, WS_WGU); S.estep = (size_t)2048 * 1024; S.nN = 8; S.G = F.G; S.c = F.vcu; S.rep = REP6;
    S.tile_e = wsp<int>(F, WS_TILEE); S.slot_tok = wsp<int>(F, WS_SLOTTOK); S.ntiles = __builtin_amdgcn_readfirstlane(ld_i(S.tile_e + CAP_TILES));
    S.ltile = (LAS int*)(F.lds + RING_BYTES + 1024); S.ltok = (LAS int*)(F.lds + RING_BYTES + 4096); S.setup();
    EpiGU E{wsp<unsigned char>(F, WS_HID), F.b_gu, wsp<float>(F, WS_SLOTRSTD)};
    pg8::gemm_phase<EpiGU, pg8::SchedGrouped<1024>, true, true, ALIGN_P67>(F.lds, S, E);
}
__device__ __forceinline__ void run_p7(Frame& F) {
    pg8::SchedGrouped<1024> S; S.A = (const char*)wsp<unsigned char>(F, WS_HID); S.Bt = (const char*)wsp<unsigned char>(F, WS_WD); S.estep = (size_t)1024 * 1024; S.nN = 4; S.G = F.G; S.c = F.vcu; S.rep = REP7;
    S.tile_e = wsp<int>(F, WS_TILEE); S.slot_tok = wsp<int>(F, WS_SLOTTOK); S.ntiles = __builtin_amdgcn_readfirstlane(ld_i(S.tile_e + CAP_TILES));
    S.ltile = (LAS int*)(F.lds + RING_BYTES + 1024); S.ltok = (LAS int*)(F.lds + RING_BYTES + 4096); S.setup();
    EpiDown E{wsp<unsigned char>(F, WS_YS), F.b_down, wsp<float>(F, WS_SLOTGATE)};
    pg8::gemm_phase<EpiDown, pg8::SchedGrouped<1024>, false, true, ALIGN_P67>(F.lds, S, E);
}

constexpr int N_PHASES = 9;
__global__ void __launch_bounds__(NWAVES * 64, 2) fwd(Args args) {
    extern __shared__ __attribute__((aligned(16))) unsigned char lds_raw[];
    Frame F;
    F.lds = (LAS unsigned char*)lds_raw;
    F.tid = threadIdx.x; F.lane = F.tid & 63; F.wave = __builtin_amdgcn_readfirstlane(F.tid >> 6);
    F.G = gridDim.x; { const int bx = blockIdx.x; F.vcu = (F.G % 8 == 0) ? (bx % 8) * (F.G / 8) + bx / 8 : bx; }
    F.ws = args.ws; F.ctl = (gu32*)(args.ws + WS_CTL); F.out = args.out;
    F.x = args.in[0]; F.meta = args.in[1]; F.g_mix = args.in[2]; F.w_in = args.in[3]; F.g_attn = args.in[4]; F.conv_w = args.in[5]; F.conv_b = args.in[6]; F.g_conv = args.in[7];
    F.w_out = args.in[8]; F.g_ffn = args.in[9]; F.w_router = args.in[10]; F.b_router = args.in[11]; F.w_gu = args.in[12]; F.b_gu = args.in[13]; F.w_down = args.in[14]; F.b_down = args.in[15]; F.g_final = args.in[16];
    volatile LAS unsigned* MISC = (volatile LAS unsigned*)(F.lds + MISC_OFF);
    for (int u = F.tid; u < (LDS_BYTES - LDSCTL_OFF) / 4; u += NWAVES * 64) ((LAS unsigned*)(F.lds + LDSCTL_OFF))[u] = 0u;
    __syncthreads();
    const int lo = args.ph_lo, hi = args.ph_hi;
    const bool multi = (hi - lo) > 1;
    XcdBarrier bar; bar.bar = (unsigned*)(F.ctl + CW_BAR); bar.x = 0; bar.st = nullptr;
    if (multi) bar = xcd_barrier_post((unsigned*)(F.ctl + CW_BAR), MISC + 8);
#ifndef PH_MASK
#define PH_MASK 0x1ff
#endif
#define IN(k) (((PH_MASK >> (k)) & 1) && lo <= (k) && (k) < hi)
#define SEAM(k) do { if (IN(k) && IN((k) + 1)) xcd_barrier(bar); } while (0)
#ifndef DUP_MASK
#define DUP_MASK 0
#endif
#define DUPK(k) ((((DUP_MASK) >> (k)) & 1) != 0)

    if (IN(0)) { p0_prologue(F); if (DUPK(0)) { xcd_barrier(bar); p0_prologue(F); } }
    SEAM(0);
    if (IN(1)) { run_p1(F); if (DUPK(1)) { xcd_barrier(bar); run_p1(F); } }
    SEAM(1);
#ifndef P2DUP_CONV
#define P2DUP_CONV true
#endif
#ifndef P2DUP_ATT
#define P2DUP_ATT true
#endif
#ifndef P2M_CONV
#define P2M_CONV true
#endif
#ifndef P2M_ATT
#define P2M_ATT true
#endif
    if (IN(2)) { run_p2<P2M_CONV, P2M_ATT>(F); if (DUPK(2)) { xcd_barrier(bar); run_p2<P2DUP_CONV, P2DUP_ATT>(F); } }
    SEAM(2);
    if (IN(3)) { run_p3(F); if (DUPK(3)) { xcd_barrier(bar); run_p3(F); } }
    SEAM(3);
#ifdef XTRA_BAR
    for (int xb_ = 0; xb_ < XTRA_BAR; ++xb_) xcd_barrier(bar);
#endif
    if (IN(4)) { p4_router(F); if (DUPK(4)) { xcd_barrier(bar); p4_router(F); } }
    SEAM(4);
    if (IN(5)) { p5_scatter(F); if (DUPK(5)) { xcd_barrier(bar); p5_scatter(F); } }
    SEAM(5);
    if (IN(6)) { run_p6(F); if (DUPK(6)) { xcd_barrier(bar); run_p6(F); } }
    SEAM(6);
#ifdef DUP7_LOOP
    if (IN(7)) { for (int rep_ = 0; rep_ < 2; ++rep_) { if (rep_) xcd_barrier(bar); run_p7(F); } }
#else
    if (IN(7)) { run_p7(F); if (DUPK(7)) { xcd_barrier(bar); run_p7(F); } }
#endif
    SEAM(7);
    if (IN(8)) { if (DUPK(8)) { p8_combine(F, wsp<float>(F, WS_HID)); xcd_barrier(bar); } p8_combine(F, F.out); }
#undef IN
#undef SEAM
}

#ifndef MK_N_LAUNCHES
#define MK_N_LAUNCHES 1
#endif
extern "C" void kernel_launch(void* const* d_in, const int* in_sizes, int n_in, void* d_out, int out_size, void* d_ws, size_t ws_size, hipStream_t stream) {
    static int grid = 0;
    if (grid == 0) {
        if (n_in != 17 || out_size != NTOK * DM || ws_size < WS_END) { fprintf(stderr, "kernel_launch: unexpected problem (n_in %d out %d ws %zu)\n", n_in, out_size, ws_size); grid = -1; return; }
        int dev = 0, cus = 0, per_cu = 0;
        if (hipGetDevice(&dev) != hipSuccess || hipDeviceGetAttribute(&cus, hipDeviceAttributeMultiprocessorCount, dev) != hipSuccess) { grid = -1; return; }
        if (hipFuncSetAttribute((const void*)fwd, hipFuncAttributeMaxDynamicSharedMemorySize, LDS_BYTES) != hipSuccess) { fprintf(stderr, "kernel_launch: hipFuncSetAttribute failed\n"); grid = -1; return; }
        if (hipOccupancyMaxActiveBlocksPerMultiprocessor(&per_cu, (const void*)fwd, NWAVES * 64, LDS_BYTES) != hipSuccess || per_cu < 1) { fprintf(stderr, "kernel_launch: occupancy query says %d\n", per_cu); }
        (void)hipGetLastError();
        grid = cus;
        if (grid != 256) fprintf(stderr, "kernel_launch: %d CUs (built for 256)\n", grid);
    }
    if (grid < 0) return;
    (void)hipMemsetAsync((char*)d_ws + WS_CTL, 0, CTL_ZERO_BYTES, stream);
    Args a{};
    for (int i = 0; i < 17; ++i) a.in[i] = (const float*)d_in[i];
    a.out = (float*)d_out; a.ws = (unsigned char*)d_ws;
    if (MK_N_LAUNCHES == 1) { a.ph_lo = 0; a.ph_hi = N_PHASES; hipLaunchKernelGGL(fwd, dim3(grid), dim3(NWAVES * 64), LDS_BYTES, stream, a); }
    else for (int p = 0; p < N_PHASES; ++p) { a.ph_lo = p; a.ph_hi = p + 1; hipLaunchKernelGGL(fwd, dim3(grid), dim3(NWAVES * 64), LDS_BYTES, stream, a); }
    const hipError_t le = hipPeekAtLastError();
    if (le != hipSuccess) fprintf(stderr, "kernel_launch: launch failed: %s\n", hipGetErrorName(le));
}
```

```cpp
#include <hip/hip_runtime.h>
#include <cstdio>
#include <cstdint>

#define GAS __attribute__((address_space(1)))
#define LAS __attribute__((address_space(3)))
typedef unsigned short bf16_t;
typedef short bf16x8 __attribute__((ext_vector_type(8)));
typedef float f32x2 __attribute__((ext_vector_type(2)));
typedef float f32x4 __attribute__((ext_vector_type(4)));
typedef float f32x16 __attribute__((ext_vector_type(16)));
typedef unsigned u32x2 __attribute__((ext_vector_type(2)));
typedef unsigned u32x4 __attribute__((ext_vector_type(4)));
typedef int i32x4 __attribute__((ext_vector_type(4)));
typedef int i32x8 __attribute__((ext_vector_type(8)));
typedef __bf16 bf16x2_t __attribute__((ext_vector_type(2)));
typedef GAS unsigned gu32;
#define RLX_AGENT __ATOMIC_RELAXED, __HIP_MEMORY_SCOPE_AGENT

constexpr int DM = 1024, NB = 8, SEQ = 4096, NTOK = NB * SEQ;
constexpr int NMETA = 16, KPAD = 48, TPAD = KPAD + NMETA + SEQ;
constexpr int QOFF = KPAD + NMETA;
constexpr int AW = 512, NH = 8, HD = 64;
constexpr int NE = 32, TOPK = 4, FF = 1024;
constexpr int CAP_TILES = 544, CAP = CAP_TILES * 256;
constexpr float RMS_EPS = 1e-6f;
constexpr float LOG2E = 1.4426950408889634f;
constexpr float QSCALE = 0.125f * LOG2E;
#ifndef EXIT_THR_VAL
#define EXIT_THR_VAL 5.421010862427522e-20f
#endif
constexpr float EXIT_THR = EXIT_THR_VAL;
constexpr int NWAVES = 8;
constexpr float YSCALE = 16.0f, YINV = 1.0f / 16.0f;
constexpr float WSCALE = 32.0f, WINV = 1.0f / 32.0f;

constexpr size_t MiB = 1u << 20, KiB = 1u << 10;
constexpr size_t WS_CTL = 0, CTL_ZERO_BYTES = 64 * KiB;
constexpr size_t WS_RSTD1 = 1 * MiB, WS_RSTD2 = WS_RSTD1 + 128 * KiB, WS_CNT = WS_RSTD2 + 128 * KiB, WS_TILEE = WS_CNT + 64 * KiB, WS_META = WS_TILEE + 64 * KiB;
constexpr size_t WS_TOPE = 2 * MiB, WS_GATE = WS_TOPE + 512 * KiB, WS_TOKSLOT = 3 * MiB;
constexpr size_t WS_SLOTTOK = 4 * MiB, WS_SLOTGATE = 5 * MiB, WS_SLOTRSTD = 6 * MiB;
constexpr size_t WS_SSP = 8 * MiB;
constexpr size_t WS_WIN = 10 * MiB, WS_WGU = 16 * MiB, WS_WD = 144 * MiB, WS_A = 208 * MiB;
constexpr size_t WS_HID = 272 * MiB;
constexpr size_t WS_Q = 272 * MiB, WS_KB = 304 * MiB, WS_VT = 337 * MiB, WS_CB = 370 * MiB, WS_CC = 402 * MiB, WS_CX = 434 * MiB, WS_MIXED = 466 * MiB;
constexpr size_t WS_YS = 544 * MiB, WS_WOUT = 816 * MiB, WS_A8 = 820 * MiB, WS_END = 852 * MiB;
static_assert(WS_MIXED + 64 * MiB <= WS_HID + (size_t)CAP * 2048 && WS_HID + (size_t)CAP * 2048 <= WS_YS && WS_YS + (size_t)CAP * 2048 <= WS_WOUT, "ws map");
static_assert((size_t)NB * TPAD * 512 * 2 <= 33 * MiB, "K/Vt size");
constexpr int CW_TMO = 0, CW_QCONV = 64, CW_QATT = 128, CW_BAR = 1024;

constexpr int RING_BYTES = 131072, LDSCTL_OFF = RING_BYTES, MISC_OFF = LDSCTL_OFF + 320, P2_SS_OFF = 147456, LDS_BYTES = 151552;

__device__ __forceinline__ unsigned cvtpk(float lo, float hi) { f32x2 v = {lo, hi}; bf16x2_t b = __builtin_convertvector(v, bf16x2_t); return __builtin_bit_cast(unsigned, b); }
__device__ __forceinline__ unsigned pk4_fp8(float a, float b, float c, float d) { int w = 0; w = __builtin_amdgcn_cvt_pk_fp8_f32(a, b, w, false); w = __builtin_amdgcn_cvt_pk_fp8_f32(c, d, w, true); return (unsigned)w; }
__device__ __forceinline__ f32x2 fp8lo(unsigned w) { return __builtin_amdgcn_cvt_pk_f32_fp8((int)w, false); }
__device__ __forceinline__ f32x2 fp8hi(unsigned w) { return __builtin_amdgcn_cvt_pk_f32_fp8((int)w, true); }
__device__ __forceinline__ float bflo(unsigned u) { return __builtin_bit_cast(float, u << 16); }
__device__ __forceinline__ float bfhi(unsigned u) { return __builtin_bit_cast(float, u & 0xffff0000u); }
__device__ __forceinline__ float ex2(float x) { return __builtin_amdgcn_exp2f(x); }
__device__ __forceinline__ float lg2(float x) { return __builtin_amdgcn_logf(x); }
__device__ __forceinline__ int ld_i(const int* p) { return __hip_atomic_load(p, RLX_AGENT); }
__device__ __forceinline__ float ld_f(const float* p) { return __builtin_bit_cast(float, __hip_atomic_load((const int*)p, RLX_AGENT)); }
__device__ __forceinline__ float wave_sum(float v) {
#pragma unroll
    for (int o = 1; o < 64; o <<= 1) v += __shfl_xor(v, o);
    return v;
}
#define LDS_WAIT() asm volatile("s_waitcnt lgkmcnt(0)" ::: "memory")
#define VM_WAIT() asm volatile("s_waitcnt vmcnt(0)" ::: "memory")

namespace pg8 {
constexpr int BM = 256, BK = 64, HALF = 128, HTB = HALF * BK * 2, STAGE_BYTES = 8 * HTB, NXCD = 8, WGM = 8, GK = 1024;
__host__ __device__ __forceinline__ int lds_byte(int r, int c) { const int st = (r >> 4) * 2 + (c >> 5), rr = r & 15, cc = c & 31, ob = rr * 64 + cc * 2; return st * 1024 + (ob ^ (((ob >> 9) & 1) << 5)); }
__host__ __device__ __forceinline__ void stage_rc(int b, int& R, int& C) { const int st = b / 1024, sb = b % 1024, swz = sb ^ (((sb >> 9) & 1) << 5); R = (st >> 1) * 16 + swz / 64; C = (st & 1) * 32 + (swz % 64) / 2; }
__host__ __device__ __forceinline__ int perm32(int rho) { const int n = rho >> 4, i = rho & 15; return 8 * (i >> 2) + 4 * n + (i & 3); }
struct Unit { int pm, pn, e, dup; };

struct SchedPlain {
    const char* A; const char* Bt; int nM, nN, nwg, G, c, rep = 1; static constexpr int RB = 2048;
    __device__ void init(const void* A_, const void* Bt_, int M, int N, int G_, int c_) { A = (const char*)A_; Bt = (const char*)Bt_; nM = M / BM; nN = N / BM; nwg = nM * nN; G = G_; c = c_; }
    __device__ __forceinline__ bool next(int i, Unit& u) const {
        const int nmy = (c < nwg) ? (nwg - c + G - 1) / G : 0; if (i >= nmy * rep) return false;
        const long L = (long)(i % nmy) * G + c;
        int wgid = (int)L; { const int q = nwg / NXCD, r = nwg % NXCD, xcd = wgid % NXCD, off = wgid / NXCD; wgid = (xcd < r ? xcd * (q + 1) : r * (q + 1) + (xcd - r) * q) + off; }
        const int nig = WGM * nN, gid = wgid / nig, fm = gid * WGM, gsz = (nM - fm) < WGM ? (nM - fm) : WGM;
        u.pm = fm + ((wgid % nig) % gsz); u.pn = (wgid % nig) / gsz; u.e = 0; u.dup = (i >= nmy) ? 1 : 0; return true;
    }
    __device__ __forceinline__ unsigned a_tile(const Unit& u) const { return (unsigned)u.pm * (unsigned)(BM * RB); }
    __device__ __forceinline__ unsigned b_tile(const Unit& u) const { return (unsigned)u.pn * (unsigned)(BM * RB); }
    __device__ __forceinline__ unsigned tok_off(int) const { return 0u; }
    __device__ __forceinline__ unsigned tok_lds(int, int) const { return 0u; }
    __device__ __forceinline__ void tok_dma(int, int, int, int) const {}
};
template <int RB_> struct SchedGrouped {
    static constexpr int RB = RB_;
    const char* A; const char* Bt; size_t estep; int nN, G, c, ntiles; const int* tile_e; const int* slot_tok;
    LAS int* ltile;
    LAS int* ltok;
    int rep;
    __device__ __forceinline__ void setup() const { if (threadIdx.x < 33) ltile[threadIdx.x] = ld_i(tile_e + CAP_TILES + 1 + threadIdx.x); __syncthreads(); }
    __device__ __forceinline__ bool next(int i, Unit& u) const {
        const int g = c >> 5, w = c & 31;
        const int t0 = ltile[g], t1 = ltile[g + 1], t2 = ltile[g + 8], t3 = ltile[g + 9], t4 = ltile[g + 16], t5 = ltile[g + 17], t6 = ltile[g + 24], t7 = ltile[g + 25];
        const int n0 = (t1 - t0) * nN, n1 = (t3 - t2) * nN, n2 = (t5 - t4) * nN, n3 = (t7 - t6) * nN, tot = n0 + n1 + n2 + n3;
        const int nmy = (w < tot) ? (tot - w + 31) / 32 : 0; if (i >= nmy * rep) return false;
        int l = (i % nmy) * 32 + w, e, tb;
        if (l < n0) { e = g; tb = t0; } else if (l < n0 + n1) { l -= n0; e = g + 8; tb = t2; } else if (l < n0 + n1 + n2) { l -= n0 + n1; e = g + 16; tb = t4; } else { l -= n0 + n1 + n2; e = g + 24; tb = t6; }
        u.pm = __builtin_amdgcn_readfirstlane(tb + l / nN); u.pn = __builtin_amdgcn_readfirstlane(l % nN); u.e = __builtin_amdgcn_readfirstlane(e); u.dup = (i >= nmy) ? 1 : 0; return true;
    }
    __device__ __forceinline__ unsigned a_tile(const Unit& u) const { return (unsigned)u.pm * (unsigned)(BM * RB); }
    __device__ __forceinline__ unsigned b_tile(const Unit& u) const { return (unsigned)u.e * (unsigned)estep + (unsigned)u.pn * (unsigned)(BM * RB); }
    __device__ __forceinline__ unsigned tok_off(int row) const { return (unsigned)ld_i(slot_tok + row) * (unsigned)RB; }
    __device__ __forceinline__ unsigned tok_lds(int par, int r) const { return (unsigned)ltok[par * 256 + r] * (unsigned)RB; }
    __device__ __forceinline__ void tok_dma(int par, int pm, int wid, int lane) const {
        const __amdgpu_buffer_rsrc_t rsT = __builtin_amdgcn_make_buffer_rsrc((void*)slot_tok, (short)0, CAP * 4, 0x00020000);
        __builtin_amdgcn_raw_ptr_buffer_load_lds(rsT, (LAS void*)(ltok + par * 256 + wid * 64), 4, lane * 4, (pm * 256 + wid * 64) * 4, 0, 0);
    }
};

template <class Epi, class Sched, bool GATHER, bool FP8 = false, bool ALIGN_EPI = true>
__device__ __forceinline__ void gemm_phase(LAS unsigned char* lds, const Sched& S, const Epi& E) {
    constexpr int RB = Sched::RB, nt = RB / 128;
    const int tid = threadIdx.x, wid = __builtin_amdgcn_readfirstlane(tid >> 6), lane = tid & 63, wr = wid >> 2, wc = wid & 3, fr = lane & 15, fq = lane >> 4;
    unsigned voffA[2], voffB[2], stC2[2]; int stR[2];
#pragma unroll
    for (int i = 0; i < 2; ++i) { int R, C; stage_rc(tid * 16 + i * 8192, R, C); const int Rb = (R & ~31) + perm32(R & 31);
        voffA[i] = (unsigned)(R * RB + C * 2); voffB[i] = (unsigned)(Rb * RB + C * 2); stR[i] = R; stC2[i] = (unsigned)C * 2u; }
    constexpr unsigned kstep = 128u, hstep = (unsigned)(HALF * RB);
    const __amdgpu_buffer_rsrc_t rsA = __builtin_amdgcn_make_buffer_rsrc((void*)S.A, (short)0, 0x7fffff00, 0x00020000), rsB = __builtin_amdgcn_make_buffer_rsrc((void*)S.Bt, (short)0, 0x7fffff00, 0x00020000);
    const unsigned ldsw = (unsigned)wid * 1024u;
    const int aoff = lds_byte(wr * 64 + fr, fq * 8), boff = lds_byte(wc * 32 + fr, fq * 8);
#define PG8_SA(b, h) (((b) * 2 + (h)) * HTB)
#define PG8_SB(b, h) ((4 + (b) * 2 + (h)) * HTB)
#define PG8_STAGE2(bufoff, rs, soff, o0, o1) do { \
        __builtin_amdgcn_raw_ptr_buffer_load_lds(rs, (LAS void*)(lds + (bufoff) + ldsw), 16, (int)(o0), (int)(soff), 0, 0); \
        __builtin_amdgcn_raw_ptr_buffer_load_lds(rs, (LAS void*)(lds + (bufoff) + ldsw + 8192), 16, (int)(o1), (int)(soff), 0, 0); } while (0)
#define PG8_STAGE_B(bufoff, soff) PG8_STAGE2(bufoff, rsB, soff, voffB[0], voffB[1])
#define PG8_STAGE_A(bufoff, usenext, h, koff) do { if constexpr (GATHER) { \
            const unsigned _o0 = (usenext) ? ng[h][0] : cg[h][0], _o1 = (usenext) ? ng[h][1] : cg[h][1]; PG8_STAGE2(bufoff, rsA, (koff), _o0, _o1); } \
        else { PG8_STAGE2(bufoff, rsA, ((usenext) ? nA : cA) + (unsigned)(h) * hstep + (koff), voffA[0], voffA[1]); } } while (0)
#define PG8_LDA(dst, b, h) do { _Pragma("unroll") for (int m = 0; m < 4; ++m) _Pragma("unroll") for (int k = 0; k < 2; ++k) dst[m][k] = *(const LAS bf16x8*)(lds + PG8_SA(b, h) + aoff + m * 2048 + k * 1024); } while (0)
#define PG8_LDB(dst, b, h) do { _Pragma("unroll") for (int n = 0; n < 2; ++n) _Pragma("unroll") for (int k = 0; k < 2; ++k) dst[n][k] = *(const LAS bf16x8*)(lds + PG8_SB(b, h) + boff + n * 2048 + k * 1024); } while (0)
#define PG8_MMA(ai, bj, At, Bt) do { __builtin_amdgcn_s_setprio(1); _Pragma("unroll") for (int m = 0; m < 4; ++m) _Pragma("unroll") for (int n = 0; n < 2; ++n) { \
        if constexpr (FP8) { const i32x8 bb_ = __builtin_shufflevector(__builtin_bit_cast(i32x4, Bt[n][0]), __builtin_bit_cast(i32x4, Bt[n][1]), 0, 1, 2, 3, 4, 5, 6, 7); \
            const i32x8 aa_ = __builtin_shufflevector(__builtin_bit_cast(i32x4, At[m][0]), __builtin_bit_cast(i32x4, At[m][1]), 0, 1, 2, 3, 4, 5, 6, 7); \
            asm volatile("v_mfma_scale_f32_16x16x128_f8f6f4 %0, %1, %2, %0, %3, %3 op_sel_hi:[0,0,0]" : "+v"(acc[ai][bj][m][n]) : "v"(bb_), "v"(aa_), "v"(scl8)); } \
        else { _Pragma("unroll") for (int k = 0; k < 2; ++k) acc[ai][bj][m][n] = __builtin_amdgcn_mfma_f32_16x16x32_bf16(Bt[n][k], At[m][k], acc[ai][bj][m][n], 0, 0, 0); } } \
        __builtin_amdgcn_s_setprio(0); } while (0)
#define PG8_MFMA_DRAIN() do { if constexpr (FP8) asm volatile("s_nop 7\n\ts_nop 7" ::: "memory"); } while (0)
#define PG8_WAIT_V(n) asm volatile("s_waitcnt vmcnt(" #n ")" ::: "memory")
#define PG8_WAIT_L(n) asm volatile("s_waitcnt lgkmcnt(" #n ")" ::: "memory")
#define PG8_BAR __builtin_amdgcn_s_barrier()
#define PG8_SCHED __builtin_amdgcn_sched_barrier(0)
    Unit cur, nxt; int ui = 0;
    if (!S.next(0, cur)) return;
    f32x4 acc[2][2][4][2];
    if constexpr (Epi::HAS_INIT) E.init(acc, cur, wr, wc, fr, fq); else {
#pragma unroll
    for (int a = 0; a < 2; ++a)
#pragma unroll
        for (int b = 0; b < 2; ++b)
#pragma unroll
            for (int m = 0; m < 4; ++m)
#pragma unroll
                for (int n = 0; n < 2; ++n) acc[a][b][m][n] = (f32x4){0.f, 0.f, 0.f, 0.f};
    }
    bf16x8 At[4][2], B0[2][2], B1[2][2];
    int scl8 = 0x7f7f7f7f; asm volatile("" : "+v"(scl8));
    unsigned cA = S.a_tile(cur), cB = S.b_tile(cur), nA = cA;
    unsigned cg[2][2], ng[2][2];
    if constexpr (GATHER) {
#pragma unroll
        for (int h = 0; h < 2; ++h)
#pragma unroll
            for (int i = 0; i < 2; ++i) { cg[h][i] = S.tok_off(cur.pm * BM + h * HALF + stR[i]) + stC2[i]; ng[h][i] = cg[h][i]; }
    } else {
#pragma unroll
        for (int h = 0; h < 2; ++h)
#pragma unroll
            for (int i = 0; i < 2; ++i) { cg[h][i] = 0u; ng[h][i] = 0u; }
    }
    PG8_STAGE_B(PG8_SB(0, 0), cB); PG8_STAGE_B(PG8_SB(0, 1), cB + hstep); PG8_STAGE_A(PG8_SA(0, 0), false, 0, 0); PG8_STAGE_A(PG8_SA(0, 1), false, 1, 0);
    if (wr == 1) PG8_BAR;
    PG8_WAIT_V(2); PG8_BAR;
    PG8_STAGE_B(PG8_SB(1, 0), cB + kstep); PG8_STAGE_A(PG8_SA(1, 0), false, 0, kstep); PG8_STAGE_B(PG8_SB(1, 1), cB + hstep + kstep);
    PG8_WAIT_V(6); PG8_BAR;
    for (;;) {
        const bool has_next = S.next(ui + 1, nxt);
        nA = has_next ? S.a_tile(nxt) : cA; const unsigned nB = has_next ? S.b_tile(nxt) : cB;
#pragma unroll 1
        for (int t = 0; t < nt; t += 2) {
            const bool last = (t == nt - 2);
            const unsigned koff1 = (unsigned)(t + 1) * kstep, koff2 = last ? 0u : (unsigned)(t + 2) * kstep, koff3 = koff2 + kstep;
            const unsigned b2 = last ? nB : cB + (unsigned)(t + 2) * kstep, b3 = b2 + kstep;
            if constexpr (GATHER) {
                if (t == nt - 4 && has_next && wid < 4) S.tok_dma((ui + 1) & 1, nxt.pm, wid, lane);
                if (last && has_next) {
#pragma unroll
                    for (int h = 0; h < 2; ++h)
#pragma unroll
                        for (int i = 0; i < 2; ++i) ng[h][i] = S.tok_lds((ui + 1) & 1, h * HALF + stR[i]) + stC2[i]; } }
            PG8_LDB(B0, 0, 0); PG8_LDB(B1, 0, 1); PG8_SCHED; PG8_LDA(At, 0, 0); PG8_STAGE_A(PG8_SA(1, 1), false, 1, koff1);
            PG8_WAIT_V(8); PG8_WAIT_L(0); PG8_BAR; PG8_MMA(0, 0, At, B0); PG8_MMA(0, 1, At, B1); PG8_BAR; PG8_SCHED;
            PG8_LDA(At, 0, 1); PG8_STAGE_B(PG8_SB(0, 0), b2); PG8_STAGE_B(PG8_SB(0, 1), b2 + hstep); PG8_STAGE_A(PG8_SA(0, 0), last, 0, koff2);
            PG8_WAIT_V(8); PG8_WAIT_L(0); PG8_BAR; PG8_MMA(1, 0, At, B0); PG8_MMA(1, 1, At, B1); PG8_BAR; PG8_SCHED;
            PG8_LDB(B0, 1, 0); PG8_LDB(B1, 1, 1); PG8_SCHED; PG8_LDA(At, 1, 0); PG8_STAGE_A(PG8_SA(0, 1), last, 1, koff2);
            PG8_WAIT_V(8); PG8_WAIT_L(0); PG8_BAR; PG8_MMA(0, 0, At, B0); PG8_MMA(0, 1, At, B1); PG8_BAR; PG8_SCHED;
            PG8_LDA(At, 1, 1); PG8_STAGE_B(PG8_SB(1, 0), b3); PG8_STAGE_B(PG8_SB(1, 1), b3 + hstep); PG8_STAGE_A(PG8_SA(1, 0), last, 0, koff3);
            PG8_WAIT_V(8); PG8_WAIT_L(0); PG8_BAR; PG8_MMA(1, 0, At, B0); PG8_MMA(1, 1, At, B1); PG8_BAR; PG8_SCHED;
        }
        if constexpr (ALIGN_EPI) { if (wr == 0) PG8_BAR; }
        PG8_MFMA_DRAIN();
        E(acc, cur, wr, wc, fr, fq);
        if (!has_next) break;
        if constexpr (Epi::HAS_INIT) E.init(acc, nxt, wr, wc, fr, fq); else {
#pragma unroll
        for (int a = 0; a < 2; ++a)
#pragma unroll
            for (int b = 0; b < 2; ++b)
#pragma unroll
                for (int m = 0; m < 4; ++m)
#pragma unroll
                    for (int n = 0; n < 2; ++n) acc[a][b][m][n] = (f32x4){0.f, 0.f, 0.f, 0.f};
        }
        cur = nxt; cA = nA; cB = nB; ++ui;
#pragma unroll
        for (int h = 0; h < 2; ++h)
#pragma unroll
            for (int i = 0; i < 2; ++i) cg[h][i] = ng[h][i];
        if constexpr (ALIGN_EPI) { if (wr == 1) PG8_BAR; }
    }
    PG8_WAIT_V(0);
    if constexpr (!ALIGN_EPI) { if (wr == 0) PG8_BAR; }
    PG8_BAR;
#undef PG8_SA
#undef PG8_SB
#undef PG8_STAGE2
#undef PG8_STAGE_B
#undef PG8_STAGE_A
#undef PG8_LDA
#undef PG8_LDB
#undef PG8_MMA
#undef PG8_MFMA_DRAIN
#undef PG8_WAIT_V
#undef PG8_WAIT_L
#undef PG8_BAR
#undef PG8_SCHED
}
}

#define XB_TMO      128
#define XB_XCNT(j)  (256  + 64 * (j))
#define XB_XSUB(j)  (1280 + 64 * (j))
#define XB_XGEN(j)  (2304 + 64 * (j))
#define XB_TOP      3328
#define XB_TOPGEN   3392
#define XCD_BAR_WORDS 3456
#define XB_SPIN_CAP (1u << 18)

__device__ __forceinline__ unsigned xb_ld(unsigned* p)              { return __hip_atomic_load(p, __ATOMIC_RELAXED, __HIP_MEMORY_SCOPE_AGENT); }
__device__ __forceinline__ unsigned xb_add(unsigned* p, unsigned v) { return __hip_atomic_fetch_add(p, v, __ATOMIC_RELAXED, __HIP_MEMORY_SCOPE_AGENT); }
__device__ __forceinline__ unsigned xb_xcc_id() { return (unsigned)__builtin_amdgcn_s_getreg((3 << 11) | 20) & 0xFu; }
#define XB_SPIN(cond, bar) do { unsigned _sp = 0; while (cond) { __builtin_amdgcn_s_sleep(1); \
    if ((++_sp & 255u) == 0u) { if (xb_ld(&(bar)[XB_TMO])) break; if (_sp > XB_SPIN_CAP) { atomicAdd(&(bar)[XB_TMO], 1u); break; } } } } while (0)

struct XcdBarrier {
    unsigned* bar; unsigned x;
    volatile LAS unsigned* st;
};

__device__ __forceinline__ XcdBarrier xcd_barrier_post(unsigned* bar, volatile LAS unsigned* st) {
    XcdBarrier b; b.bar = bar; b.x = xb_xcc_id(); b.st = st;
    if (threadIdx.x == 0) (void)xb_add(&bar[XB_XCNT(b.x)], 1u);
    return b;
}
__device__ __forceinline__ void xcd_barrier_complete(unsigned* bar, unsigned x, unsigned& nloc, unsigned& nx) {
    const unsigned G = gridDim.x * gridDim.y * gridDim.z;
    unsigned sum, cnt, mine, sp = 0u;
    for (;;) {
        sum = 0u; cnt = 0u; mine = 0u;
#pragma unroll
        for (unsigned j = 0; j < 16; ++j) { const unsigned c = xb_ld(&bar[XB_XCNT(j)]); sum += c; cnt += (c > 0u) ? 1u : 0u; mine = (j == x) ? c : mine; }
        if (sum == G) break;
        __builtin_amdgcn_s_sleep(1);
        if ((++sp & 255u) == 0u) { if (xb_ld(&bar[XB_TMO])) break; if (sp > XB_SPIN_CAP) { atomicAdd(&bar[XB_TMO], 1u); break; } }
    }
    nloc = mine > 0u ? mine : 1u; nx = cnt > 0u ? cnt : 1u;
}

__device__ __forceinline__ void xcd_barrier(const XcdBarrier& b) {
    asm volatile("s_waitcnt vmcnt(0)" ::: "memory");
    __syncthreads();
    if (threadIdx.x == 0) {
        unsigned* bar = b.bar;
        __builtin_amdgcn_s_waitcnt(0);
        unsigned nloc = b.st[0], nx = b.st[1];
        if (nloc == 0u) { xcd_barrier_complete(bar, b.x, nloc, nx); b.st[0] = nloc; b.st[1] = nx; }
        const unsigned old = xb_add(&bar[XB_XSUB(b.x)], 1u);
        const unsigned gen = old / nloc;
        if (old + 1u == (gen + 1u) * nloc) {
            __builtin_amdgcn_fence(__ATOMIC_RELEASE, "agent");
            asm volatile("s_waitcnt vmcnt(0)" ::: "memory");
            const unsigned og = xb_add(&bar[XB_TOP], 1u);
            const unsigned tg = og / nx;
            if (og + 1u == (tg + 1u) * nx) xb_add(&bar[XB_TOPGEN], 1u);
            else XB_SPIN(xb_ld(&bar[XB_TOPGEN]) == tg, bar);
            __builtin_amdgcn_fence(__ATOMIC_ACQUIRE, "agent");
            xb_add(&bar[XB_XGEN(b.x)], 1u);
            asm volatile("s_waitcnt vmcnt(0)" ::: "memory");
        } else {
            XB_SPIN(xb_ld(&bar[XB_XGEN(b.x)]) == gen, bar);
            __builtin_amdgcn_fence(__ATOMIC_ACQUIRE, "agent");
            asm volatile("s_waitcnt vmcnt(0)" ::: "memory");
        }
    }
    __syncthreads();
}

typedef f32x4 AccT[2][2][4][2];
struct EpiProj {
    static constexpr bool HAS_INIT = false;
    bf16_t *Q, *KB, *CB, *CC, *CX; const float* rstd1;
    __device__ __forceinline__ void operator()(const AccT& acc, const pg8::Unit& u, int wr, int wc, int fr, int fq) const {
#ifdef SKIP_REP_EPI
        if (u.dup) return;
#endif
        const int sec = u.pn >> 1, row0 = u.pm * 256 + wr * 64 + fr, col0 = (u.pn & 1) * 256 + wc * 32 + 8 * fq;
        bf16_t* base = sec == 0 ? Q : sec == 1 ? KB : sec == 2 ? CB : sec == 3 ? CC : CX;
        const int radd = (sec == 1) ? 64 * ((u.pm >> 4) + 1) : 0;
        const float sc0 = (sec == 0) ? QSCALE : 1.0f;
        float rsv[2][4];
#pragma unroll
        for (int ai = 0; ai < 2; ++ai)
#pragma unroll
            for (int m = 0; m < 4; ++m) rsv[ai][m] = rstd1[row0 + ai * 128 + m * 16];
#pragma unroll
        for (int ai = 0; ai < 2; ++ai)
#pragma unroll
            for (int m = 0; m < 4; ++m) { const int r = row0 + ai * 128 + m * 16; const float sc = rsv[ai][m] * sc0;
                bf16_t* rowp = base + (size_t)(r + radd) * 512 + col0;
#pragma unroll
                for (int bj = 0; bj < 2; ++bj) { const f32x4 v0 = acc[ai][bj][m][0] * sc, v1 = acc[ai][bj][m][1] * sc;
                    u32x4 w; w.x = cvtpk(v0[0], v0[1]); w.y = cvtpk(v0[2], v0[3]); w.z = cvtpk(v1[0], v1[1]); w.w = cvtpk(v1[2], v1[3]);
                    *(u32x4*)(rowp + bj * 128) = w; } }
    }
};
struct EpiVt {
    static constexpr bool HAS_INIT = false;
    bf16_t* VT; const float* rstd1;
    __device__ __forceinline__ void operator()(const AccT& acc, const pg8::Unit& u, int wr, int wc, int fr, int fq) const {
#ifdef SKIP_REP_EPI
        if (u.dup) return;
#endif
        const int row0 = u.pm * 256 + wr * 64 + fr, col0 = u.pn * 256 + wc * 32 + 8 * fq;
        f32x4 rs[2][2];
#pragma unroll
        for (int bj = 0; bj < 2; ++bj)
#pragma unroll
            for (int n = 0; n < 2; ++n) rs[bj][n] = *(const f32x4*)(rstd1 + col0 + bj * 128 + 4 * n);
        const int dcol0 = col0 + 64 * ((u.pn >> 4) + 1);
#pragma unroll
        for (int ai = 0; ai < 2; ++ai)
#pragma unroll
            for (int m = 0; m < 4; ++m) { bf16_t* rowp = VT + (size_t)(row0 + ai * 128 + m * 16) * (size_t)(NB * TPAD) + dcol0;
#pragma unroll
                for (int bj = 0; bj < 2; ++bj) { const f32x4 v0 = acc[ai][bj][m][0] * rs[bj][0], v1 = acc[ai][bj][m][1] * rs[bj][1];
                    u32x4 w; w.x = cvtpk(v0[0], v0[1]); w.y = cvtpk(v0[2], v0[3]); w.z = cvtpk(v1[0], v1[1]); w.w = cvtpk(v1[2], v1[3]);
                    *(u32x4*)(rowp + bj * 128) = w; } }
    }
};
struct EpiOut {
    static constexpr bool HAS_INIT = false;
    const float* x; bf16_t* H1; unsigned char* A8; float* ssp; const float* gffn;
    __device__ __forceinline__ void init(AccT&, const pg8::Unit&, int, int, int, int) const {}
    __device__ __forceinline__ void operator()(const AccT& acc, const pg8::Unit& u, int wr, int wc, int fr, int fq) const {
        const int row0 = u.pm * 256 + wr * 64 + fr, col0 = u.pn * 256 + wc * 32 + 8 * fq;
        f32x4 g[2][2];
#pragma unroll
        for (int bj = 0; bj < 2; ++bj)
#pragma unroll
            for (int n = 0; n < 2; ++n) g[bj][n] = *(const f32x4*)(gffn + col0 + bj * 128 + 4 * n);
        f32x4 xc[2][2], xn[2][2];
        { const size_t ro = (size_t)row0 * DM + col0;
#pragma unroll
          for (int bj = 0; bj < 2; ++bj) { xc[bj][0] = *(const f32x4*)(x + ro + bj * 128); xc[bj][1] = *(const f32x4*)(x + ro + bj * 128 + 4); } }
#pragma unroll
        for (int gi = 0; gi < 8; ++gi) { const int ai = gi >> 2, m = gi & 3;
            if (gi < 7) { const int r2 = row0 + ((gi + 1) >> 2) * 128 + ((gi + 1) & 3) * 16; const size_t ro2 = (size_t)r2 * DM + col0;
#pragma unroll
                for (int bj = 0; bj < 2; ++bj) { xn[bj][0] = *(const f32x4*)(x + ro2 + bj * 128); xn[bj][1] = *(const f32x4*)(x + ro2 + bj * 128 + 4); } }
            asm volatile("" ::: "memory");
            const int r = row0 + ai * 128 + m * 16; const size_t ro = (size_t)r * DM + col0; u32x2 w8[2];
#pragma unroll
            for (int bj = 0; bj < 2; ++bj) {
                const f32x4 v0 = acc[ai][bj][m][0] + xc[bj][0], v1 = acc[ai][bj][m][1] + xc[bj][1];
                u32x4 w; w.x = cvtpk(v0[0], v0[1]); w.y = cvtpk(v0[2], v0[3]); w.z = cvtpk(v1[0], v1[1]); w.w = cvtpk(v1[2], v1[3]);
                *(u32x4*)(H1 + ro + bj * 128) = w;
                const f32x4 a0 = v0 * g[bj][0], a1 = v1 * g[bj][1];
                w8[bj].x = pk4_fp8(a0[0], a0[1], a0[2], a0[3]); w8[bj].y = pk4_fp8(a1[0], a1[1], a1[2], a1[3]); }
            {
                const bool odd = fq & 1; const u32x2 snd = odd ? w8[0] : w8[1]; u32x2 rcv; rcv.x = __shfl_xor(snd.x, 16); rcv.y = __shfl_xor(snd.y, 16);
                const u32x4 o16 = odd ? (u32x4){rcv.x, rcv.y, w8[1].x, w8[1].y} : (u32x4){w8[0].x, w8[0].y, rcv.x, rcv.y};
                *(u32x4*)(A8 + (size_t)r * DM + u.pn * 256 + wc * 32 + 16 * (fq >> 1) + (odd ? 128 : 0)) = o16; }
            asm volatile("" ::: "memory");
#pragma unroll
            for (int bj = 0; bj < 2; ++bj) { xc[bj][0] = xn[bj][0]; xc[bj][1] = xn[bj][1]; }
        }
    }
};
struct EpiGU {
    static constexpr bool HAS_INIT = false;
    unsigned char* hid; const float* bgu; const float* slot_rstd;
    __device__ __forceinline__ void operator()(const AccT& acc, const pg8::Unit& u, int wr, int wc, int fr, int fq) const {
#ifdef SKIP_REP_EPI
        if (u.dup) return;
#endif
        const int row0 = u.pm * 256 + wr * 64 + fr, colr = u.pn * 128 + wc * 32 + 8 * fq;
        const float* bg = bgu + (size_t)u.e * 2048 + colr;
        const f32x4 bg0 = *(const f32x4*)(bg), bg1 = *(const f32x4*)(bg + 4), bl0 = *(const f32x4*)(bg + 1024), bl1 = *(const f32x4*)(bg + 1028);
        float rsv[2][4];
#pragma unroll
        for (int ai = 0; ai < 2; ++ai)
#pragma unroll
            for (int m = 0; m < 4; ++m) rsv[ai][m] = slot_rstd[row0 + ai * 128 + m * 16];
#pragma unroll
        for (int ai = 0; ai < 2; ++ai)
#pragma unroll
            for (int m = 0; m < 4; ++m) { const int r = row0 + ai * 128 + m * 16; const float rs = rsv[ai][m] * WINV;
                float hv[8];
#pragma unroll
                for (int n = 0; n < 2; ++n)
#pragma unroll
                    for (int i = 0; i < 4; ++i) {
                        float gt = acc[ai][0][m][n][i] * rs + (n ? bg1[i] : bg0[i]), ln = acc[ai][1][m][n][i] * rs + (n ? bl1[i] : bl0[i]);
                        gt = fminf(gt, 7.0f); ln = fminf(fmaxf(ln, -7.0f), 7.0f);
                        const float sg = __builtin_amdgcn_rcpf(1.0f + ex2(gt * (-1.702f * LOG2E)));
                        hv[n * 4 + i] = (ln + 1.0f) * (gt * sg); }
                u32x2 w; w.x = pk4_fp8(hv[0], hv[1], hv[2], hv[3]); w.y = pk4_fp8(hv[4], hv[5], hv[6], hv[7]);
                *(u32x2*)(hid + (size_t)r * FF + colr) = w; }
    }
};
struct EpiDown {
    static constexpr bool HAS_INIT = false;
    unsigned char* ys; const float* bd; const float* slot_gate;
    __device__ __forceinline__ void operator()(const AccT& acc, const pg8::Unit& u, int wr, int wc, int fr, int fq) const {
#ifdef SKIP_REP_EPI
        if (u.dup) return;
#endif
        const int row0 = u.pm * 256 + wr * 64 + fr, col0 = u.pn * 256 + wc * 32 + 8 * fq;
        f32x4 bv[2][2];
#pragma unroll
        for (int bj = 0; bj < 2; ++bj)
#pragma unroll
            for (int n = 0; n < 2; ++n) bv[bj][n] = *(const f32x4*)(bd + (size_t)u.e * DM + col0 + bj * 128 + 4 * n);
        float gtv[2][4];
#pragma unroll
        for (int ai = 0; ai < 2; ++ai)
#pragma unroll
            for (int m = 0; m < 4; ++m) gtv[ai][m] = slot_gate[row0 + ai * 128 + m * 16] * YSCALE;
#pragma unroll
        for (int ai = 0; ai < 2; ++ai)
#pragma unroll
            for (int m = 0; m < 4; ++m) { const int r = row0 + ai * 128 + m * 16; const float gt = gtv[ai][m];
                u32x2 w[2];
#pragma unroll
                for (int bj = 0; bj < 2; ++bj) { const f32x4 v0 = (acc[ai][bj][m][0] * WINV + bv[bj][0]) * gt, v1 = (acc[ai][bj][m][1] * WINV + bv[bj][1]) * gt;
                    w[bj].x = pk4_fp8(v0[0], v0[1], v0[2], v0[3]); w[bj].y = pk4_fp8(v1[0], v1[1], v1[2], v1[3]); }
                const bool odd = fq & 1; const u32x2 snd = odd ? w[0] : w[1]; u32x2 rcv; rcv.x = __shfl_xor(snd.x, 16); rcv.y = __shfl_xor(snd.y, 16);
                const u32x4 o16 = odd ? (u32x4){rcv.x, rcv.y, w[1].x, w[1].y} : (u32x4){w[0].x, w[0].y, rcv.x, rcv.y};
                *(u32x4*)(ys + (size_t)r * DM + u.pn * 256 + wc * 32 + 16 * (fq >> 1) + (odd ? 128 : 0)) = o16; }
    }
};

struct Args { const float* in[17]; float* out; unsigned char* ws; int ph_lo, ph_hi; };
struct Frame {
    LAS unsigned char* lds; gu32* ctl; int tid, lane, wave, vcu, G;
    const float *x, *meta, *g_mix, *w_in, *g_attn, *conv_w, *conv_b, *g_conv, *w_out, *g_ffn, *w_router, *b_router, *w_gu, *b_gu, *w_down, *b_down, *g_final;
    float* out; unsigned char* ws;
};
template <class T> __device__ __forceinline__ T* wsp(const Frame& F, size_t off) { return (T*)(F.ws + off); }

__device__ __forceinline__ void p0_transpose_item(const float* W, int ldw, int k0, int n0, bf16_t* WT, int Kd, int drow0, LAS unsigned* scr, int lane) {
    const int ks = lane >> 4, n4 = lane & 15;
    f32x4 va[8], vb[8];
    const float* src = W + (size_t)(k0 + 2 * ks) * ldw + n0 + 4 * n4;
#pragma unroll
    for (int i = 0; i < 8; ++i) { va[i] = *(const f32x4*)(src + (size_t)(8 * i) * ldw); vb[i] = *(const f32x4*)(src + (size_t)(8 * i + 1) * ldw); }
#pragma unroll
    for (int i = 0; i < 8; ++i)
#pragma unroll
        for (int j = 0; j < 4; ++j) scr[(4 * n4 + j) * 33 + 4 * i + ks] = cvtpk(va[i][j], vb[i][j]);
    LDS_WAIT(); asm volatile("" ::: "memory");
    const int ns = lane >> 3, c = lane & 7;
#pragma unroll
    for (int r = 0; r < 8; ++r) { const int n = 8 * r + ns; const LAS unsigned* t = scr + n * 33 + 4 * c;
        u32x4 o; o.x = t[0]; o.y = t[1]; o.z = t[2]; o.w = t[3];
        *(u32x4*)(WT + (size_t)(drow0 + n) * Kd + k0 + 8 * c) = o; }
    LDS_WAIT(); asm volatile("" ::: "memory");
}
__device__ __forceinline__ void p0_transpose_item8(const float* W, int ldw, int k0, int n0, unsigned char* WT8, int Kd, int drow0, LAS unsigned* scr, int lane) {
    const int ks = lane >> 4, n4 = lane & 15;
#pragma unroll
    for (int h = 0; h < 2; ++h) {
        f32x4 v[4][4];
        const float* src = W + (size_t)(k0 + 64 * h + 4 * ks) * ldw + n0 + 4 * n4;
#pragma unroll
        for (int i = 0; i < 4; ++i)
#pragma unroll
            for (int q = 0; q < 4; ++q) v[i][q] = *(const f32x4*)(src + (size_t)(16 * i + q) * ldw);
#pragma unroll
        for (int i = 0; i < 4; ++i)
#pragma unroll
            for (int j = 0; j < 4; ++j) scr[(4 * n4 + j) * 33 + 16 * h + 4 * i + ks] = pk4_fp8(v[i][0][j] * WSCALE, v[i][1][j] * WSCALE, v[i][2][j] * WSCALE, v[i][3][j] * WSCALE);
    }
    LDS_WAIT(); asm volatile("" ::: "memory");
    const int ns = lane >> 3, c = lane & 7;
#pragma unroll
    for (int r = 0; r < 8; ++r) { const int n = 8 * r + ns; const LAS unsigned* t = scr + n * 33 + 4 * c;
        u32x4 o; o.x = t[0]; o.y = t[1]; o.z = t[2]; o.w = t[3];
        *(u32x4*)(WT8 + (size_t)(drow0 + n) * Kd + k0 + 16 * c) = o; }
    LDS_WAIT(); asm volatile("" ::: "memory");
}
__device__ __forceinline__ void p0_meta_job(Frame& F, int mw) {
    LAS float* nm = (LAS float*)F.lds;
    LAS float* part = (LAS float*)(F.lds + 65536);
    for (int t = F.wave * 2; t < F.wave * 2 + 2; ++t) {
        float v[16]; float ss = 0.f;
#pragma unroll
        for (int j = 0; j < 16; ++j) { v[j] = F.meta[t * DM + j * 64 + F.lane]; ss += v[j] * v[j]; }
        const float rstd = 1.0f / sqrtf(wave_sum(ss) * (1.0f / DM) + RMS_EPS);
#pragma unroll
        for (int j = 0; j < 16; ++j) { const int k = j * 64 + F.lane; nm[k * 16 + t] = v[j] * rstd * F.g_mix[k]; }
    }
    __syncthreads();
    const int kq = F.tid >> 7, c = F.tid & 127, j = mw * 128 + c, sec4 = j >> 9, jc = j & 511;
    const int ocol = (sec4 == 0 ? 512 : sec4 == 1 ? 1024 : sec4 == 2 ? 2048 : 2560) + jc;
    float acc[16];
#pragma unroll
    for (int t = 0; t < 16; ++t) acc[t] = 0.f;
    for (int kk = kq * 256; kk < kq * 256 + 256; kk += 16) {
        float wv[16];
#pragma unroll
        for (int u = 0; u < 16; ++u) wv[u] = F.w_in[(size_t)(kk + u) * 3072 + ocol];
#pragma unroll
        for (int u = 0; u < 16; ++u) { const float w = wv[u];
            const LAS f32x4* nv = (const LAS f32x4*)(nm + (kk + u) * 16);
#pragma unroll
            for (int q = 0; q < 4; ++q) { const f32x4 n4 = nv[q]; acc[4 * q] += w * n4[0]; acc[4 * q + 1] += w * n4[1]; acc[4 * q + 2] += w * n4[2]; acc[4 * q + 3] += w * n4[3]; } }
    }
#pragma unroll
    for (int t = 0; t < 16; ++t) part[(kq * 128 + c) * 16 + t] = acc[t];
    __syncthreads();
    {
        const int tq = F.tid >> 7;
        bf16_t* KB = wsp<bf16_t>(F, WS_KB); bf16_t* VT = wsp<bf16_t>(F, WS_VT); float* MT = wsp<float>(F, WS_META);
#pragma unroll
        for (int tt = 0; tt < 4; ++tt) { const int t = 4 * tq + tt;
            const float v = (part[(0 * 128 + c) * 16 + t] + part[(1 * 128 + c) * 16 + t]) + (part[(2 * 128 + c) * 16 + t] + part[(3 * 128 + c) * 16 + t]);
            const bf16_t bv = (bf16_t)(cvtpk(v, 0.f) & 0xffffu);
            if (sec4 == 0) { for (int b = 0; b < NB; ++b) KB[(size_t)(b * TPAD + KPAD + t) * 512 + jc] = bv; }
            else if (sec4 == 1) { for (int b = 0; b < NB; ++b) VT[(size_t)jc * (NB * TPAD) + b * TPAD + KPAD + t] = bv; }
            else if (t >= 14) MT[((sec4 - 2) * 2 + (t - 14)) * 512 + jc] = v;
        }
    }
    __syncthreads();
}
__device__ __forceinline__ void p0_prologue(Frame& F) {
    constexpr int NMW = 16;
    if (F.vcu < NMW) {
        p0_meta_job(F, F.vcu);
        bf16_t* KB = wsp<bf16_t>(F, WS_KB); bf16_t* VT = wsp<bf16_t>(F, WS_VT);
        const int gt = F.vcu * 512 + F.tid, NT = NMW * 512;
        for (int i = gt; i < NB * KPAD * 64; i += NT) { const int b = i / (KPAD * 64), r = i % (KPAD * 64); *(u32x4*)(KB + (size_t)(b * TPAD) * 512 + (size_t)r * 8) = (u32x4){0u, 0u, 0u, 0u}; }
        for (int i = gt; i < 512 * NB * 6; i += NT) { const int ch = i / (NB * 6), r = i % (NB * 6), b = r / 6, q = r % 6; *(u32x4*)(VT + (size_t)ch * (NB * TPAD) + b * TPAD + q * 8) = (u32x4){0u, 0u, 0u, 0u}; }
        return;
    }
    const int gw = (F.vcu - NMW) * NWAVES + F.wave, NGW = (F.G - NMW) * NWAVES;
    {
        float* rstd1 = wsp<float>(F, WS_RSTD1); bf16_t* A1 = wsp<bf16_t>(F, WS_A);
        f32x4 g4[4];
#pragma unroll
        for (int j = 0; j < 4; ++j) g4[j] = *(const f32x4*)(F.g_mix + 256 * j + 4 * F.lane);
        for (int m = gw; m < NTOK; m += NGW) {
            const f32x4* xr = (const f32x4*)(F.x + (size_t)m * DM) + F.lane;
            f32x4 v[4]; float s = 0.f;
#pragma unroll
            for (int j = 0; j < 4; ++j) { v[j] = xr[64 * j]; s += (v[j][0] * v[j][0] + v[j][1] * v[j][1]) + (v[j][2] * v[j][2] + v[j][3] * v[j][3]); }
            s = wave_sum(s);
            if (F.lane == 0) rstd1[m] = 1.0f / sqrtf(s * (1.0f / DM) + RMS_EPS);
            u32x2* o8 = (u32x2*)(A1 + (size_t)m * DM) + F.lane;
#pragma unroll
            for (int j = 0; j < 4; ++j) { const f32x4 a = v[j] * g4[j]; u32x2 o; o.x = cvtpk(a[0], a[1]); o.y = cvtpk(a[2], a[3]); o8[64 * j] = o; }
        }
    }
    {
        LAS unsigned* scr = (LAS unsigned*)(F.lds + F.wave * 8704);
        constexpr int I_IN = 16 * 48, I_OUT = 16 * 16, I_GU = 32 * 8 * 32, I_D = 32 * 8 * 16, NITEMS = I_IN + I_OUT + I_GU + I_D;
        bf16_t* WIN = wsp<bf16_t>(F, WS_WIN); bf16_t* WOUT = wsp<bf16_t>(F, WS_WOUT); unsigned char* WGU = wsp<unsigned char>(F, WS_WGU); unsigned char* WD = wsp<unsigned char>(F, WS_WD);
        for (int it = gw; it < NITEMS; it += NGW) {
            int r = it;
            if (r < I_IN) { const int kb = r / 48, nb = r % 48, n0 = 64 * nb, sec = n0 >> 9;
                const int dsec = sec == 0 ? 0 : sec == 1 ? 1 : sec == 2 ? 5 : sec - 1;
                p0_transpose_item(F.w_in, 3072, 64 * kb, n0, WIN, DM, dsec * 512 + (n0 & 511), scr, F.lane); continue; }
            r -= I_IN;
            if (r < I_OUT) { const int kb = r / 16, nb = r % 16; p0_transpose_item(F.w_out, 1024, 64 * kb, 64 * nb, WOUT, DM, 64 * nb, scr, F.lane); continue; }
            r -= I_OUT;
            if (r < I_GU) { const int e = r / 256, q = r % 256, kb = q / 32, nb = q % 32, n0 = 64 * nb, c = n0 & 1023;
                const int drow = (c >> 7) * 256 + (n0 >= 1024 ? 128 : 0) + (c & 127);
                p0_transpose_item8(F.w_gu + (size_t)e * 1024 * 2048, 2048, 128 * kb, n0, WGU + (size_t)e * 2048 * 1024, DM, drow, scr, F.lane); continue; }
            r -= I_GU;
            { const int e = r / 128, q = r % 128, kb = q / 16, nb = q % 16;
                p0_transpose_item8(F.w_down + (size_t)e * 1024 * 1024, 1024, 128 * kb, 64 * nb, WD + (size_t)e * 1024 * 1024, FF, 64 * nb, scr, F.lane); }
        }
    }
}
template <bool EDGE>
__device__ __forceinline__ void sb_tile(f32x16& s0, f32x16& s1, float& carry, int kp0  , int qpos, bool hi0, bf16x8 (&pf)[2][2]) {
    float R[4];
#pragma unroll
    for (int q = 0; q < 4; ++q) {
        float S = 1.0f;
#pragma unroll
        for (int i = 7; i >= 0; --i) {
            const int r = (q & 1) * 8 + i;
            const float z = fminf((q < 2) ? s0[r] : s1[r], 100.0f);
            const float e = ex2(z);
            float kp_ = __builtin_amdgcn_rcpf(1.0f + e);
            float sg = e * kp_;
            if (EDGE) { const int kp = kp0 + 16 * q + i; const bool valid = (kp < qpos) && (kp >= KPAD); kp_ = valid ? kp_ : 1.0f; sg = valid ? sg : 0.0f; }
            const float m = sg * S; S *= kp_;
            if (q < 2) s0[r] = m; else s1[r] = m;
        }
        R[q] = S;
        __builtin_amdgcn_sched_barrier(0);
    }
    const float P0 = __shfl_xor(R[0], 32), P1 = __shfl_xor(R[1], 32), P2 = __shfl_xor(R[2], 32), P3 = __shfl_xor(R[3], 32);
    const float T1 = R[1] * P1, T2 = R[2] * P2, T3 = R[3] * P3, T0 = R[0] * P0;
    const float b3 = carry * (hi0 ? P3 : 1.0f), b2 = carry * (T3 * (hi0 ? P2 : 1.0f)), b1 = carry * ((T3 * T2) * (hi0 ? P1 : 1.0f)), b0 = carry * ((T3 * T2 * T1) * (hi0 ? P0 : 1.0f));
#pragma unroll
    for (int i = 0; i < 8; ++i) { s0[i] *= b0; s0[8 + i] *= b1; s1[i] *= b2; s1[8 + i] *= b3; }
    carry *= (T0 * T1) * (T2 * T3);
    u32x4 w;
    w.x = cvtpk(s0[0], s0[1]); w.y = cvtpk(s0[2], s0[3]); w.z = cvtpk(s0[4], s0[5]); w.w = cvtpk(s0[6], s0[7]); pf[0][0] = __builtin_bit_cast(bf16x8, w);
    w.x = cvtpk(s0[8], s0[9]); w.y = cvtpk(s0[10], s0[11]); w.z = cvtpk(s0[12], s0[13]); w.w = cvtpk(s0[14], s0[15]); pf[0][1] = __builtin_bit_cast(bf16x8, w);
    w.x = cvtpk(s1[0], s1[1]); w.y = cvtpk(s1[2], s1[3]); w.z = cvtpk(s1[4], s1[5]); w.w = cvtpk(s1[6], s1[7]); pf[1][0] = __builtin_bit_cast(bf16x8, w);
    w.x = cvtpk(s1[8], s1[9]); w.y = cvtpk(s1[10], s1[11]); w.z = cvtpk(s1[12], s1[13]); w.w = cvtpk(s1[14], s1[15]); pf[1][1] = __builtin_bit_cast(bf16x8, w);
}
template <bool EDGE>
__device__ __forceinline__ void sb_tile32(f32x16& s0, float& carry, int kp0  , int qpos, bool hi0, bf16x8 (&pf)[2]) {
    float R[2];
#pragma unroll
    for (int q = 0; q < 2; ++q) {
        float S = 1.0f;
#pragma unroll
        for (int i = 7; i >= 0; --i) {
            const int r = q * 8 + i;
            const float z = fminf(s0[r], 100.0f);
            const float e = ex2(z);
            float kp_ = __builtin_amdgcn_rcpf(1.0f + e);
            float sg = e * kp_;
            if (EDGE) { const int kp = kp0 + 16 * q + i; const bool valid = (kp < qpos) && (kp >= KPAD); kp_ = valid ? kp_ : 1.0f; sg = valid ? sg : 0.0f; }
            s0[r] = sg * S; S *= kp_;
        }
        R[q] = S;
    }
    const float P0 = __shfl_xor(R[0], 32), P1 = __shfl_xor(R[1], 32);
    const float T0 = R[0] * P0, T1 = R[1] * P1;
    const float b1 = carry * (hi0 ? P1 : 1.0f), b0 = carry * (T1 * (hi0 ? P0 : 1.0f));
#pragma unroll
    for (int i = 0; i < 8; ++i) { s0[i] *= b0; s0[8 + i] *= b1; }
    carry *= T0 * T1;
    u32x4 w;
    w.x = cvtpk(s0[0], s0[1]); w.y = cvtpk(s0[2], s0[3]); w.z = cvtpk(s0[4], s0[5]); w.w = cvtpk(s0[6], s0[7]); pf[0] = __builtin_bit_cast(bf16x8, w);
    w.x = cvtpk(s0[8], s0[9]); w.y = cvtpk(s0[10], s0[11]); w.z = cvtpk(s0[12], s0[13]); w.w = cvtpk(s0[14], s0[15]); pf[1] = __builtin_bit_cast(bf16x8, w);
}
#define MFMA32(a, b, c) __builtin_amdgcn_mfma_f32_32x32x16_bf16((a), (b), (c), 0, 0, 0)
#define P2_LDS_BARRIER() do { asm volatile("s_waitcnt lgkmcnt(0)" ::: "memory"); __builtin_amdgcn_s_barrier(); asm volatile("" ::: "memory"); } while (0)
template <bool DO_CONV, bool DO_ATT, bool PROBE = false>
__device__ __forceinline__ void p2_unit(Frame& F, int b, int qb) {
    int lane_ = F.lane, head_ = F.wave;
    asm volatile("" : "+v"(lane_), "+s"(head_));
    const int lane = lane_, head = head_, l31 = lane & 31, hi = lane >> 5; const bool hi0 = hi == 0;
    const bf16_t* Q = wsp<bf16_t>(F, WS_Q); const bf16_t* KB = wsp<bf16_t>(F, WS_KB); const bf16_t* VT = wsp<bf16_t>(F, WS_VT);
    bf16_t* MX = wsp<bf16_t>(F, PROBE ? WS_YS : WS_MIXED);
    LAS float* ssA = (LAS float*)(F.lds + P2_SS_OFF);
    LAS float* ssC = (LAS float*)(F.lds + P2_SS_OFF + 2048);
    const int row0 = b * SEQ + qb * 64;
    const int pi = (l31 & 0x13) | ((l31 & 4) << 1) | ((l31 & 8) >> 1);
    const __amdgpu_buffer_rsrc_t rsK = __builtin_amdgcn_make_buffer_rsrc((void*)(KB + (size_t)b * TPAD * 512), (short)0, TPAD * 512 * 2, 0x00020000);
    const __amdgpu_buffer_rsrc_t rsV = __builtin_amdgcn_make_buffer_rsrc((void*)(VT + (size_t)b * TPAD), (short)0, (511 * NB * TPAD + TPAD) * 2, 0x00020000);
    const int voffK = (pi * 512 + head * 64 + hi * 8) * 2;
    const int voffV0 = ((head * 64 + l31) * (NB * TPAD) + hi * 8) * 2, voffV1 = voffV0 + 32 * NB * TPAD * 2;
    LAS unsigned char* kbuf = F.lds + head * 16384; LAS unsigned char* vbuf = kbuf + 8192;
    const int P0 = QOFF + 64 * qb, qpos = P0 + l31, NT = (P0 >> 5) + 1;
#define ATT_DMA_K(st, pp) do { \
        __builtin_amdgcn_raw_ptr_buffer_load_lds(rsK, (LAS void*)(kbuf + (pp) * 4096 + 0 * 1024), 16, voffK, (st) * 1024 + 0, 0, 0); \
        __builtin_amdgcn_raw_ptr_buffer_load_lds(rsK, (LAS void*)(kbuf + (pp) * 4096 + 1 * 1024), 16, voffK, (st) * 1024 + 32, 0, 0); \
        __builtin_amdgcn_raw_ptr_buffer_load_lds(rsK, (LAS void*)(kbuf + (pp) * 4096 + 2 * 1024), 16, voffK, (st) * 1024 + 64, 0, 0); \
        __builtin_amdgcn_raw_ptr_buffer_load_lds(rsK, (LAS void*)(kbuf + (pp) * 4096 + 3 * 1024), 16, voffK, (st) * 1024 + 96, 0, 0); } while (0)
#define ATT_DMA_V(st, pp) do { \
        __builtin_amdgcn_raw_ptr_buffer_load_lds(rsV, (LAS void*)(vbuf + (pp) * 4096 + 0 * 1024), 16, voffV0, (st) * 2 + 0, 0, 0); \
        __builtin_amdgcn_raw_ptr_buffer_load_lds(rsV, (LAS void*)(vbuf + (pp) * 4096 + 1 * 1024), 16, voffV0, (st) * 2 + 32, 0, 0); \
        __builtin_amdgcn_raw_ptr_buffer_load_lds(rsV, (LAS void*)(vbuf + (pp) * 4096 + 2 * 1024), 16, voffV1, (st) * 2 + 0, 0, 0); \
        __builtin_amdgcn_raw_ptr_buffer_load_lds(rsV, (LAS void*)(vbuf + (pp) * 4096 + 3 * 1024), 16, voffV1, (st) * 2 + 32, 0, 0); } while (0)
#define ATT_WAIT_VM(n) do { if ((n) >= 12) asm volatile("s_waitcnt vmcnt(12)" ::: "memory"); else if ((n) == 8) asm volatile("s_waitcnt vmcnt(8)" ::: "memory"); \
        else if ((n) == 4) asm volatile("s_waitcnt vmcnt(4)" ::: "memory"); else asm volatile("s_waitcnt vmcnt(0)" ::: "memory"); } while (0)
    bf16x8 qf[2][4];
    if constexpr (DO_ATT) {
        asm volatile("s_waitcnt lgkmcnt(0)" ::: "memory");
        ATT_DMA_K(P0 + 32, 0); ATT_DMA_V(P0 + 32, 0); ATT_DMA_K(P0, 1); ATT_DMA_V(P0, 1);
        const bf16_t* Qp = Q + (size_t)(row0 + l31) * 512 + head * 64 + hi * 8;
#pragma unroll
        for (int q2 = 0; q2 < 2; ++q2)
#pragma unroll
            for (int s = 0; s < 4; ++s) qf[q2][s] = *(const bf16x8*)(Qp + (size_t)q2 * 32 * 512 + s * 16);
    }
    if constexpr (DO_CONV) {
        const int cgp = lane & 7, rg = lane >> 3, ch0 = head * 64 + cgp * 8;
        const bf16_t* CB = wsp<bf16_t>(F, WS_CB); const bf16_t* CC = wsp<bf16_t>(F, WS_CC); const bf16_t* CX = wsp<bf16_t>(F, WS_CX); const float* MT = wsp<float>(F, WS_META);
        float cv[8][8];
        {
            float w0[8], w1[8], w2[8], bs[8], u2[8], u1[8];
#pragma unroll
            for (int k = 0; k < 8; ++k) { w0[k] = F.conv_w[ch0 + k]; w1[k] = F.conv_w[512 + ch0 + k]; w2[k] = F.conv_w[1024 + ch0 + k]; bs[k] = F.conv_b[ch0 + k]; u2[k] = 0.f; u1[k] = 0.f; }
            float um[2][8];
#pragma unroll
            for (int t = 0; t < 2; ++t)
#pragma unroll
                for (int k = 0; k < 8; ++k) um[t][k] = 0.f;
            if (qb == 0) {
#pragma unroll
                for (int t = 0; t < 2; ++t) { const f32x4 c0 = *(const f32x4*)(MT + t * 512 + ch0), c1 = *(const f32x4*)(MT + t * 512 + ch0 + 4), x0 = *(const f32x4*)(MT + (2 + t) * 512 + ch0), x1 = *(const f32x4*)(MT + (2 + t) * 512 + ch0 + 4);
#pragma unroll
                    for (int k = 0; k < 4; ++k) { um[t][k] = c0[k] * x0[k]; um[t][4 + k] = c1[k] * x1[k]; } }
            }
            u32x4 c4[10], x4[10], b4[8];
#pragma unroll
            for (int i = 0; i < 10; ++i) { const int sl = qb * 64 + rg * 8 + i - 2; const size_t ro = (size_t)(b * SEQ + (sl < 0 ? 0 : sl)) * 512 + ch0;
                c4[i] = *(const u32x4*)(CC + ro); x4[i] = *(const u32x4*)(CX + ro); }
#pragma unroll
            for (int i = 0; i < 8; ++i) b4[i] = *(const u32x4*)(CB + (size_t)(b * SEQ + qb * 64 + rg * 8 + i) * 512 + ch0);
#pragma unroll
            for (int i = 0; i < 10; ++i) {
                const int ri = i - 2;
                const int sl = qb * 64 + rg * 8 + ri;
                float u[8];
                u[0] = bflo(c4[i].x) * bflo(x4[i].x); u[1] = bfhi(c4[i].x) * bfhi(x4[i].x); u[2] = bflo(c4[i].y) * bflo(x4[i].y); u[3] = bfhi(c4[i].y) * bfhi(x4[i].y);
                u[4] = bflo(c4[i].z) * bflo(x4[i].z); u[5] = bfhi(c4[i].z) * bfhi(x4[i].z); u[6] = bflo(c4[i].w) * bflo(x4[i].w); u[7] = bfhi(c4[i].w) * bfhi(x4[i].w);
                if (ri < 0) {
#pragma unroll
                    for (int k = 0; k < 8; ++k) u[k] = (sl < 0) ? um[ri + 2][k] : u[k];
                } else {
                    const u32x4 bb = b4[ri];
                    const float cbv[8] = {bflo(bb.x), bfhi(bb.x), bflo(bb.y), bfhi(bb.y), bflo(bb.z), bfhi(bb.z), bflo(bb.w), bfhi(bb.w)};
#pragma unroll
                    for (int k = 0; k < 8; ++k) cv[ri][k] = cbv[k] * (w0[k] * u2[k] + w1[k] * u1[k] + w2[k] * u[k] + bs[k]);
                }
#pragma unroll
                for (int k = 0; k < 8; ++k) { u2[k] = u1[k]; u1[k] = u[k]; }
            }
        }
#pragma unroll
        for (int i = 0; i < 8; ++i) { float ss = 0.f;
#pragma unroll
            for (int k = 0; k < 8; ++k) ss += cv[i][k] * cv[i][k];
            ss += __shfl_xor(ss, 1); ss += __shfl_xor(ss, 2); ss += __shfl_xor(ss, 4);
            if (cgp == 0) ssC[head * 64 + rg * 8 + i] = ss; }
        P2_LDS_BARRIER();
        const f32x4 gc0 = *(const f32x4*)(F.g_conv + ch0), gc1 = *(const f32x4*)(F.g_conv + ch0 + 4);
#pragma unroll
        for (int i = 0; i < 8; ++i) { const int rl = rg * 8 + i; float tot = 0.f;
#pragma unroll
            for (int w = 0; w < 8; ++w) tot += ssC[w * 64 + rl];
            const float rstd = 1.0f / sqrtf(tot * (1.0f / AW) + RMS_EPS);
            u32x4 w4; w4.x = cvtpk(cv[i][0] * rstd * gc0[0], cv[i][1] * rstd * gc0[1]); w4.y = cvtpk(cv[i][2] * rstd * gc0[2], cv[i][3] * rstd * gc0[3]);
            w4.z = cvtpk(cv[i][4] * rstd * gc1[0], cv[i][5] * rstd * gc1[1]); w4.w = cvtpk(cv[i][6] * rstd * gc1[2], cv[i][7] * rstd * gc1[3]);
            *(u32x4*)(MX + (size_t)(row0 + rl) * DM + 512 + ch0) = w4; }
    }
    if constexpr (DO_ATT) {
    f32x16 o[2][2];
#pragma unroll
    for (int d = 0; d < 2; ++d)
#pragma unroll
        for (int q2 = 0; q2 < 2; ++q2)
#pragma unroll
            for (int r = 0; r < 16; ++r) o[d][q2][r] = 0.f;
    float carry0 = 1.0f, carry1 = 1.0f;
    if constexpr (DO_CONV) asm volatile("s_waitcnt vmcnt(8)" ::: "memory"); else asm volatile("s_waitcnt vmcnt(0)" ::: "memory");
    for (int t = 0; ; ++t) {
        const int start = P0 + 32 - 32 * t, pp = t & 1;
        const bool lastt = (t == NT - 1), e1 = (t + 1 < NT), e2 = (t + 2 < NT);
        ATT_WAIT_VM(4 + (e1 ? 8 : 0));
        bf16x8 kf[4];
#pragma unroll
        for (int i = 0; i < 4; ++i) kf[i] = *(const LAS bf16x8*)(kbuf + pp * 4096 + i * 1024 + lane * 16);
        asm volatile("s_waitcnt lgkmcnt(0)" ::: "memory");
        if (e2) ATT_DMA_K(start - 64, pp);
#pragma unroll
        for (int q2 = 0; q2 < 2; ++q2) {
            if (q2 == 0 && t == 0) continue;
            f32x16 s0;
#pragma unroll
            for (int r = 0; r < 16; ++r) s0[r] = 0.f;
#pragma unroll
            for (int s4 = 0; s4 < 4; ++s4) s0 = MFMA32(kf[s4], qf[q2][s4], s0);
            bf16x8 pf[2];
            float& carry = q2 ? carry1 : carry0;
            const bool edge = (start == P0 + 32 * q2) || lastt;
#ifdef PROBE_NOSB
            if (PROBE) { u32x4 w_; w_.x = cvtpk(s0[0], s0[1]); w_.y = cvtpk(s0[2], s0[3]); w_.z = cvtpk(s0[4], s0[5]); w_.w = cvtpk(s0[6], s0[7]); pf[0] = __builtin_bit_cast(bf16x8, w_); pf[1] = pf[0]; carry *= 0.5f; } else
#endif
            if (edge) sb_tile32<true>(s0, carry, start + 8 * hi, qpos + 32 * q2, hi0, pf);
            else sb_tile32<false>(s0, carry, start + 8 * hi, qpos + 32 * q2, hi0, pf);
            if (q2 == 0 || t == 0) ATT_WAIT_VM((e1 ? 8 : 0) + (e2 ? 4 : 0));
            bf16x8 vf[4];
#pragma unroll
            for (int i = 0; i < 4; ++i) vf[i] = *(const LAS bf16x8*)(vbuf + pp * 4096 + i * 1024 + lane * 16);
#pragma unroll
            for (int d = 0; d < 2; ++d)
#pragma unroll
                for (int s2 = 0; s2 < 2; ++s2) o[d][q2] = MFMA32(vf[d * 2 + s2], pf[s2], o[d][q2]);
        }
#ifdef PROBE_MAXT
        if (PROBE && t >= PROBE_MAXT - 1) break;
#endif
        if (lastt || __all((carry0 < EXIT_THR) && (carry1 < EXIT_THR))) break;
        asm volatile("s_waitcnt lgkmcnt(0)" ::: "memory");
        if (e2) ATT_DMA_V(start - 64, pp);
    }
    asm volatile("s_waitcnt vmcnt(0)" ::: "memory");
    int lane2 = lane; asm volatile("" : "+v"(lane2));
    const int l31b = lane2 & 31, hib = lane2 >> 5;
#pragma unroll
    for (int q2 = 0; q2 < 2; ++q2) {
        float ss = 0.f;
#pragma unroll
        for (int d = 0; d < 2; ++d)
#pragma unroll
            for (int r = 0; r < 16; ++r) ss += o[d][q2][r] * o[d][q2][r];
        ss += __shfl_xor(ss, 32);
        if (hib == 0) ssA[head * 64 + q2 * 32 + l31b] = ss;
    }
    P2_LDS_BARRIER();
    {
        LAS unsigned char* obuf = F.lds + head * 16384;
#pragma unroll
        for (int q2 = 0; q2 < 2; ++q2) {
            const int rl = q2 * 32 + l31b; float tot = 0.f;
#pragma unroll
            for (int h = 0; h < 8; ++h) tot += ssA[h * 64 + rl];
            const float rstd = 1.0f / sqrtf(tot * (1.0f / AW) + RMS_EPS);
#pragma unroll
            for (int d = 0; d < 2; ++d)
#pragma unroll
                for (int g = 0; g < 4; ++g) { const f32x4 ga = *(const f32x4*)(F.g_attn + head * 64 + 32 * d + 8 * g + 4 * hib);
                    u32x2 w; w.x = cvtpk(o[d][q2][4 * g] * rstd * ga[0], o[d][q2][4 * g + 1] * rstd * ga[1]); w.y = cvtpk(o[d][q2][4 * g + 2] * rstd * ga[2], o[d][q2][4 * g + 3] * rstd * ga[3]);
                    *(LAS u32x2*)(obuf + rl * 144 + (32 * d + 8 * g + 4 * hib) * 2) = w; }
        }
        asm volatile("s_waitcnt lgkmcnt(0)" ::: "memory");
#pragma unroll
        for (int k = 0; k < 8; ++k) { const int rr = 8 * k + (lane2 >> 3), ch = lane2 & 7;
            const u32x4 v = *(const LAS u32x4*)(obuf + rr * 144 + ch * 16);
            *(u32x4*)(MX + (size_t)(row0 + rr) * DM + head * 64 + ch * 8) = v; }
    }
    if constexpr (!DO_CONV) P2_LDS_BARRIER();
    }
#undef ATT_DMA_K
#undef ATT_DMA_V
#undef ATT_WAIT_VM
}

__device__ __forceinline__ void p4_router(Frame& F) {
    LAS unsigned char* img = F.lds;
    LAS int* hist = (LAS int*)(F.lds + 65536);
    for (int idx = F.tid; idx < 64 * 2 * 32; idx += 512) { const int s = idx >> 6, h = (idx >> 5) & 1, e = idx & 31; const int k0 = 16 * s + 8 * h; const float* wp = F.w_router + (size_t)k0 * NE + e; const float* gp = F.g_ffn + k0;
        u32x4 w; w.x = cvtpk(wp[0] * gp[0], wp[NE] * gp[1]); w.y = cvtpk(wp[2 * NE] * gp[2], wp[3 * NE] * gp[3]); w.z = cvtpk(wp[4 * NE] * gp[4], wp[5 * NE] * gp[5]); w.w = cvtpk(wp[6 * NE] * gp[6], wp[7 * NE] * gp[7]);
        *(LAS u32x4*)(img + idx * 16) = w; }
    if (F.tid < 32) hist[F.tid] = 0;
    __syncthreads();
    const bf16_t* A2 = wsp<bf16_t>(F, WS_A); float* rstd2 = wsp<float>(F, WS_RSTD2);
    int* tope = wsp<int>(F, WS_TOPE); float* gate = wsp<float>(F, WS_GATE); int* cnt = wsp<int>(F, WS_CNT);
    const int wg = F.vcu;
    if (F.wave < 4) {
        const int l31 = F.lane & 31, hi = F.lane >> 5, row = wg * 128 + F.wave * 32 + l31;
        f32x16 acc;
#pragma unroll
        for (int r = 0; r < 16; ++r) acc[r] = 0.f;
        const bf16_t* ap = A2 + (size_t)row * DM + 8 * hi;
        float ss = 0.f;
#pragma unroll 8
        for (int s = 0; s < 64; ++s) { const bf16x8 a = *(const LAS bf16x8*)(img + ((s * 2 + hi) * 32 + l31) * 16); const bf16x8 bq = *(const bf16x8*)(ap + 16 * s); acc = MFMA32(a, bq, acc);
            const u32x4 bu = __builtin_bit_cast(u32x4, bq);
            const float f0 = bflo(bu.x), f1 = bfhi(bu.x), f2 = bflo(bu.y), f3 = bfhi(bu.y), f4 = bflo(bu.z), f5 = bfhi(bu.z), f6 = bflo(bu.w), f7 = bfhi(bu.w);
            ss += ((f0 * f0 + f1 * f1) + (f2 * f2 + f3 * f3)) + ((f4 * f4 + f5 * f5) + (f6 * f6 + f7 * f7)); }
        ss += __shfl_xor(ss, 32);
        const float rstd = 1.0f / sqrtf(ss * (1.0f / DM) + RMS_EPS);
        float lg[16];
#pragma unroll
        for (int r = 0; r < 16; ++r) lg[r] = acc[r] * rstd + F.b_router[(r & 3) + 8 * (r >> 2) + 4 * hi];
        float cvv[8]; int cei[8];
#pragma unroll
        for (int k = 0; k < 4; ++k) { float best = -INFINITY; int bi = 0;
#pragma unroll
            for (int r = 0; r < 16; ++r) { const bool gtb = lg[r] > best; best = gtb ? lg[r] : best; bi = gtb ? r : bi; }
#pragma unroll
            for (int r = 0; r < 16; ++r) lg[r] = (r == bi) ? -INFINITY : lg[r];
            cvv[k] = best; cei[k] = (bi & 3) + 8 * (bi >> 2) + 4 * hi; }
#pragma unroll
        for (int k = 0; k < 4; ++k) { cvv[4 + k] = __shfl_xor(cvv[k], 32); cei[4 + k] = __shfl_xor(cei[k], 32); }
        float tv[4]; int te[4];
#pragma unroll
        for (int k = 0; k < 4; ++k) { float best = -INFINITY; int be = 1 << 30, bi = 0;
#pragma unroll
            for (int c = 0; c < 8; ++c) { const bool better = (cvv[c] > best) || (cvv[c] == best && cei[c] < be); best = better ? cvv[c] : best; be = better ? cei[c] : be; bi = better ? c : bi; }
#pragma unroll
            for (int c = 0; c < 8; ++c) { const bool hit = (c == bi); cvv[c] = hit ? -INFINITY : cvv[c]; cei[c] = hit ? (1 << 30) : cei[c]; }
            tv[k] = best; te[k] = be; }
        const float e1 = ex2((tv[1] - tv[0]) * LOG2E), e2 = ex2((tv[2] - tv[0]) * LOG2E), e3 = ex2((tv[3] - tv[0]) * LOG2E);
        const float inv = 1.0f / (1.0f + e1 + e2 + e3);
        if (hi == 0) {
            rstd2[row] = rstd;
            *(i32x4*)(tope + (size_t)row * 4) = (i32x4){te[0], te[1], te[2], te[3]};
            *(f32x4*)(gate + (size_t)row * 4) = (f32x4){inv, e1 * inv, e2 * inv, e3 * inv};
#pragma unroll
            for (int k = 0; k < 4; ++k) atomicAdd((int*)(hist + te[k]), 1);
        }
    }
    __syncthreads();
    if (F.tid < 32) cnt[wg * 32 + F.tid] = hist[F.tid];
    __syncthreads();
}

__device__ __forceinline__ void p5_scatter(Frame& F) {
    LAS int* tot = (LAS int*)F.lds; LAS int* pre = tot + 32; LAS int* ctr = tot + 64; LAS int* pstart = tot + 96;
    const int* cnt = wsp<int>(F, WS_CNT); const int wg = F.vcu;
    if (F.tid < 64) tot[F.tid] = 0;
    __syncthreads();
    { const int e = F.tid & 31, j = F.tid >> 5; int t = 0, p = 0;
        for (int w = j; w < 256; w += 16) { const int c = ld_i(cnt + w * 32 + e); t += c; p += (w < wg) ? c : 0; }
        atomicAdd((int*)(tot + e), t); atomicAdd((int*)(pre + e), p); }
    __syncthreads();
    if (F.tid == 0) { int run = 0; for (int e = 0; e < 32; ++e) { pstart[e] = run; run += (tot[e] + 255) & ~255; } pstart[32] = run; }
    __syncthreads();
    if (F.tid < 32) ctr[F.tid] = pstart[F.tid] + pre[F.tid];
    int* slot_tok = wsp<int>(F, WS_SLOTTOK); float* slot_gate = wsp<float>(F, WS_SLOTGATE); float* slot_rstd = wsp<float>(F, WS_SLOTRSTD);
    int* tile_e = wsp<int>(F, WS_TILEE);
    if (wg == 0) {
        if (F.tid < 32) { for (int rt = pstart[F.tid] >> 8; rt < (pstart[F.tid + 1] >> 8); ++rt) tile_e[rt] = F.tid; }
        if (F.tid == 0) tile_e[CAP_TILES] = pstart[32] >> 8;
        if (F.tid < 33) tile_e[CAP_TILES + 1 + F.tid] = pstart[F.tid] >> 8;
    }
    if (wg < 32) { const int e = wg; for (int s = pstart[e] + tot[e] + F.tid; s < pstart[e + 1]; s += 512) { slot_tok[s] = 0; slot_gate[s] = 0.f; slot_rstd[s] = 0.f; } }
    __syncthreads();
    { const int tok = wg * 128 + (F.tid >> 2), k = F.tid & 3;
        const int e = ld_i(wsp<int>(F, WS_TOPE) + tok * 4 + k);
        const int slot = atomicAdd((int*)(ctr + e), 1);
        slot_tok[slot] = tok; slot_gate[slot] = ld_f(wsp<float>(F, WS_GATE) + tok * 4 + k); slot_rstd[slot] = ld_f(wsp<float>(F, WS_RSTD2) + tok);
        wsp<int>(F, WS_TOKSLOT)[tok * 4 + k] = slot; }
    __syncthreads();
}

__device__ __forceinline__ void p8_combine(Frame& F, float* dst) {
    const int gw = F.vcu * NWAVES + F.wave, NGW = F.G * NWAVES;
    const unsigned char* ys = wsp<unsigned char>(F, WS_YS); const int* tokslot = wsp<int>(F, WS_TOKSLOT); const bf16_t* H1 = wsp<bf16_t>(F, WS_A);
    f32x4 gf[2][2];
#pragma unroll
    for (int j = 0; j < 2; ++j) { gf[j][0] = *(const f32x4*)(F.g_final + 512 * j + 8 * F.lane); gf[j][1] = *(const f32x4*)(F.g_final + 512 * j + 8 * F.lane + 4); }
    for (int m0 = gw; m0 < NTOK; m0 += 16 * NGW) {
        const int mrow = m0 + (F.lane >> 2) * NGW;
        const int myslot = (mrow < NTOK) ? ld_i(tokslot + (size_t)mrow * 4 + (F.lane & 3)) : 0;
#pragma unroll 1
        for (int r = 0; r < 16; r += 2) {
            const int ma = m0 + r * NGW, mb = ma + NGW;
            if (ma >= NTOK) break;
            const bool hasb = mb < NTOK; const int mbb = hasb ? mb : ma;
            int sa[4], sb[4];
#pragma unroll
            for (int k = 0; k < 4; ++k) { sa[k] = __builtin_amdgcn_readfirstlane(__shfl(myslot, 4 * r + k)); sb[k] = __builtin_amdgcn_readfirstlane(__shfl(myslot, 4 * r + 4 + k)); }
            u32x4 ha[2], hb[2]; u32x2 ya[2][4], yb[2][4];
#pragma unroll
            for (int j = 0; j < 2; ++j) { ha[j] = *(const u32x4*)(H1 + (size_t)ma * DM + 512 * j + 8 * F.lane); hb[j] = *(const u32x4*)(H1 + (size_t)mbb * DM + 512 * j + 8 * F.lane);
#pragma unroll
                for (int k = 0; k < 4; ++k) { ya[j][k] = *(const u32x2*)(ys + (size_t)sa[k] * DM + 512 * j + 8 * F.lane); yb[j][k] = *(const u32x2*)(ys + (size_t)sb[k] * DM + 512 * j + 8 * F.lane); } }
            f32x4 va[2][2], vb[2][2]; float ssa = 0.f, ssb = 0.f;
#pragma unroll
            for (int j = 0; j < 2; ++j) {
                f32x4 ea0 = {0.f, 0.f, 0.f, 0.f}, ea1 = ea0, eb0 = ea0, eb1 = ea0;
#pragma unroll
                for (int k = 0; k < 4; ++k) { const u32x2 y = ya[j][k], z = yb[j][k];
                    const f32x2 y0 = fp8lo(y.x), y1 = fp8hi(y.x), y2 = fp8lo(y.y), y3 = fp8hi(y.y), z0 = fp8lo(z.x), z1 = fp8hi(z.x), z2 = fp8lo(z.y), z3 = fp8hi(z.y);
                    ea0[0] += y0[0]; ea0[1] += y0[1]; ea0[2] += y1[0]; ea0[3] += y1[1]; ea1[0] += y2[0]; ea1[1] += y2[1]; ea1[2] += y3[0]; ea1[3] += y3[1];
                    eb0[0] += z0[0]; eb0[1] += z0[1]; eb0[2] += z1[0]; eb0[3] += z1[1]; eb1[0] += z2[0]; eb1[1] += z2[1]; eb1[2] += z3[0]; eb1[3] += z3[1]; }
                va[j][0] = (f32x4){bflo(ha[j].x), bfhi(ha[j].x), bflo(ha[j].y), bfhi(ha[j].y)} + ea0 * YINV; va[j][1] = (f32x4){bflo(ha[j].z), bfhi(ha[j].z), bflo(ha[j].w), bfhi(ha[j].w)} + ea1 * YINV;
                vb[j][0] = (f32x4){bflo(hb[j].x), bfhi(hb[j].x), bflo(hb[j].y), bfhi(hb[j].y)} + eb0 * YINV; vb[j][1] = (f32x4){bflo(hb[j].z), bfhi(hb[j].z), bflo(hb[j].w), bfhi(hb[j].w)} + eb1 * YINV;
#pragma unroll
                for (int q = 0; q < 2; ++q) { ssa += (va[j][q][0] * va[j][q][0] + va[j][q][1] * va[j][q][1]) + (va[j][q][2] * va[j][q][2] + va[j][q][3] * va[j][q][3]);
                    ssb += (vb[j][q][0] * vb[j][q][0] + vb[j][q][1] * vb[j][q][1]) + (vb[j][q][2] * vb[j][q][2] + vb[j][q][3] * vb[j][q][3]); } }
            const float ra = 1.0f / sqrtf(wave_sum(ssa) * (1.0f / DM) + RMS_EPS), rb = 1.0f / sqrtf(wave_sum(ssb) * (1.0f / DM) + RMS_EPS);
            float* oa = dst + (size_t)ma * DM + 8 * F.lane; float* ob = dst + (size_t)mbb * DM + 8 * F.lane;
#pragma unroll
            for (int j = 0; j < 2; ++j) { *(f32x4*)(oa + 512 * j) = va[j][0] * ra * gf[j][0]; *(f32x4*)(oa + 512 * j + 4) = va[j][1] * ra * gf[j][1]; }
            if (hasb) {
#pragma unroll
                for (int j = 0; j < 2; ++j) { *(f32x4*)(ob + 512 * j) = vb[j][0] * rb * gf[j][0]; *(f32x4*)(ob + 512 * j + 4) = vb[j][1] * rb * gf[j][1]; } }
        }
    }
}

#ifndef ALIGN_P3
#define ALIGN_P3 true
#endif
#ifndef ALIGN_P67
#define ALIGN_P67 true
#endif
#ifndef REP3
#define REP3 1
#endif
#ifndef REP1
#define REP1 1
#endif
#ifndef REP6
#define REP6 1
#endif
#ifndef REP7
#define REP7 1
#endif
__device__ __forceinline__ void run_p1(Frame& F) {
    { pg8::SchedPlain S; S.init(wsp<bf16_t>(F, WS_A), wsp<bf16_t>(F, WS_WIN), NTOK, 2560, F.G, (int)blockIdx.x); S.rep = REP1;
      EpiProj E{wsp<bf16_t>(F, WS_Q), wsp<bf16_t>(F, WS_KB), wsp<bf16_t>(F, WS_CB), wsp<bf16_t>(F, WS_CC), wsp<bf16_t>(F, WS_CX), wsp<float>(F, WS_RSTD1)};
      pg8::gemm_phase<EpiProj, pg8::SchedPlain, false>(F.lds, S, E); }
    { pg8::SchedPlain S; S.init(wsp<bf16_t>(F, WS_WIN) + (size_t)2560 * DM, wsp<bf16_t>(F, WS_A), 512, NTOK, F.G, (int)blockIdx.x);
      EpiVt E{wsp<bf16_t>(F, WS_VT), wsp<float>(F, WS_RSTD1)};
      pg8::gemm_phase<EpiVt, pg8::SchedPlain, false>(F.lds, S, E); }
}
template <bool DO_CONV, bool DO_ATT, bool PROBE = false>
__device__ __forceinline__ void run_p2(Frame& F) {
    for (int u = F.vcu; u < NB * (SEQ / 64); u += F.G) p2_unit<DO_CONV, DO_ATT, PROBE>(F, u >> 6, u & 63);
}
__device__ __forceinline__ void run_p3(Frame& F) {
#ifdef P3_STAGGER
    if (F.vcu & 1) { for (int i_ = 0; i_ < P3_STAGGER; ++i_) __builtin_amdgcn_s_sleep(127); }
#endif
    pg8::SchedPlain S; S.init(wsp<bf16_t>(F, WS_MIXED), wsp<bf16_t>(F, WS_WOUT), NTOK, DM, F.G, (int)blockIdx.x); S.rep = REP3;
    EpiOut E{F.x, wsp<bf16_t>(F, WS_A), wsp<unsigned char>(F, WS_A8), wsp<float>(F, WS_SSP), F.g_ffn};
    pg8::gemm_phase<EpiOut, pg8::SchedPlain, false, false, ALIGN_P3>(F.lds, S, E);
}
__device__ __forceinline__ void run_p6(Frame& F) {
    pg8::SchedGrouped<1024> S; S.A = (const char*)wsp<unsigned char>(F, WS_A8); S.Bt = (const char*)wsp<unsigned char>(F, WS_WGU); S.estep = (size_t)2048 * 1024; S.nN = 8; S.G = F.G; S.c = F.vcu; S.rep = REP6;
    S.tile_e = wsp<int>(F, WS_TILEE); S.slot_tok = wsp<int>(F, WS_SLOTTOK); S.ntiles = __builtin_amdgcn_readfirstlane(ld_i(S.tile_e + CAP_TILES));
    S.ltile = (LAS int*)(F.lds + RING_BYTES + 1024); S.ltok = (LAS int*)(F.lds + RING_BYTES + 4096); S.setup();
    EpiGU E{wsp<unsigned char>(F, WS_HID), F.b_gu, wsp<float>(F, WS_SLOTRSTD)};
    pg8::gemm_phase<EpiGU, pg8::SchedGrouped<1024>, true, true, ALIGN_P67>(F.lds, S, E);
}
__device__ __forceinline__ void run_p7(Frame& F) {
    pg8::SchedGrouped<1024> S; S.A = (const char*)wsp<unsigned char>(F, WS_HID); S.Bt = (const char*)wsp<unsigned char>(F, WS_WD); S.estep = (size_t)1024 * 1024; S.nN = 4; S.G = F.G; S.c = F.vcu; S.rep = REP7;
    S.tile_e = wsp<int>(F, WS_TILEE); S.slot_tok = wsp<int>(F, WS_SLOTTOK); S.ntiles = __builtin_amdgcn_readfirstlane(ld_i(S.tile_e + CAP_TILES));
    S.ltile = (LAS int*)(F.lds + RING_BYTES + 1024); S.ltok = (LAS int*)(F.lds + RING_BYTES + 4096); S.setup();
    EpiDown E{wsp<unsigned char>(F, WS_YS), F.b_down, wsp<float>(F, WS_SLOTGATE)};
    pg8::gemm_phase<EpiDown, pg8::SchedGrouped<1024>, false, true, ALIGN_P67>(F.lds, S, E);
}

constexpr int N_PHASES = 9;
__global__ void __launch_bounds__(NWAVES * 64, 2) fwd(Args args) {
    extern __shared__ __attribute__((aligned(16))) unsigned char lds_raw[];
    Frame F;
    F.lds = (LAS unsigned char*)lds_raw;
    F.tid = threadIdx.x; F.lane = F.tid & 63; F.wave = __builtin_amdgcn_readfirstlane(F.tid >> 6);
    F.G = gridDim.x; { const int bx = blockIdx.x; F.vcu = (F.G % 8 == 0) ? (bx % 8) * (F.G / 8) + bx / 8 : bx; }
    F.ws = args.ws; F.ctl = (gu32*)(args.ws + WS_CTL); F.out = args.out;
    F.x = args.in[0]; F.meta = args.in[1]; F.g_mix = args.in[2]; F.w_in = args.in[3]; F.g_attn = args.in[4]; F.conv_w = args.in[5]; F.conv_b = args.in[6]; F.g_conv = args.in[7];
    F.w_out = args.in[8]; F.g_ffn = args.in[9]; F.w_router = args.in[10]; F.b_router = args.in[11]; F.w_gu = args.in[12]; F.b_gu = args.in[13]; F.w_down = args.in[14]; F.b_down = args.in[15]; F.g_final = args.in[16];
    volatile LAS unsigned* MISC = (volatile LAS unsigned*)(F.lds + MISC_OFF);
    for (int u = F.tid; u < (LDS_BYTES - LDSCTL_OFF) / 4; u += NWAVES * 64) ((LAS unsigned*)(F.lds + LDSCTL_OFF))[u] = 0u;
    __syncthreads();
    const int lo = args.ph_lo, hi = args.ph_hi;
    const bool multi = (hi - lo) > 1;
    XcdBarrier bar; bar.bar = (unsigned*)(F.ctl + CW_BAR); bar.x = 0; bar.st = nullptr;
    if (multi) bar = xcd_barrier_post((unsigned*)(F.ctl + CW_BAR), MISC + 8);
#ifndef PH_MASK
#define PH_MASK 0x1ff
#endif
#define IN(k) (((PH_MASK >> (k)) & 1) && lo <= (k) && (k) < hi)
#define SEAM(k) do { if (IN(k) && IN((k) + 1)) xcd_barrier(bar); } while (0)
#ifndef DUP_MASK
#define DUP_MASK 0
#endif
#define DUPK(k) ((((DUP_MASK) >> (k)) & 1) != 0)

    if (IN(0)) { p0_prologue(F); if (DUPK(0)) { xcd_barrier(bar); p0_prologue(F); } }
    SEAM(0);
    if (IN(1)) { run_p1(F); if (DUPK(1)) { xcd_barrier(bar); run_p1(F); } }
    SEAM(1);
#ifndef P2DUP_CONV
#define P2DUP_CONV true
#endif
#ifndef P2DUP_ATT
#define P2DUP_ATT true
#endif
#ifndef P2M_CONV
#define P2M_CONV true
#endif
#ifndef P2M_ATT
#define P2M_ATT true
#endif
    if (IN(2)) { run_p2<P2M_CONV, P2M_ATT>(F); if (DUPK(2)) { xcd_barrier(bar); run_p2<P2DUP_CONV, P2DUP_ATT, true>(F); } }
    SEAM(2);
    if (IN(3)) { run_p3(F); if (DUPK(3)) { xcd_barrier(bar); run_p3(F); } }
    SEAM(3);
#ifdef XTRA_BAR
    for (int xb_ = 0; xb_ < XTRA_BAR; ++xb_) xcd_barrier(bar);
#endif
    if (IN(4)) { p4_router(F); if (DUPK(4)) { xcd_barrier(bar); p4_router(F); } }
    SEAM(4);
    if (IN(5)) { p5_scatter(F); if (DUPK(5)) { xcd_barrier(bar); p5_scatter(F); } }
    SEAM(5);
    if (IN(6)) { run_p6(F); if (DUPK(6)) { xcd_barrier(bar); run_p6(F); } }
    SEAM(6);
#ifdef DUP7_LOOP
    if (IN(7)) { for (int rep_ = 0; rep_ < 2; ++rep_) { if (rep_) xcd_barrier(bar); run_p7(F); } }
#else
    if (IN(7)) { run_p7(F); if (DUPK(7)) { xcd_barrier(bar); run_p7(F); } }
#endif
    SEAM(7);
    if (IN(8)) { if (DUPK(8)) { p8_combine(F, wsp<float>(F, WS_HID)); xcd_barrier(bar); } p8_combine(F, F.out); }
#undef IN
#undef SEAM
}

#ifndef MK_N_LAUNCHES
#define MK_N_LAUNCHES 1
#endif
extern "C" void kernel_launch(void* const* d_in, const int* in_sizes, int n_in, void* d_out, int out_size, void* d_ws, size_t ws_size, hipStream_t stream) {
    static int grid = 0;
    if (grid == 0) {
        if (n_in != 17 || out_size != NTOK * DM || ws_size < WS_END) { fprintf(stderr, "kernel_launch: unexpected problem (n_in %d out %d ws %zu)\n", n_in, out_size, ws_size); grid = -1; return; }
        int dev = 0, cus = 0, per_cu = 0;
        if (hipGetDevice(&dev) != hipSuccess || hipDeviceGetAttribute(&cus, hipDeviceAttributeMultiprocessorCount, dev) != hipSuccess) { grid = -1; return; }
        if (hipFuncSetAttribute((const void*)fwd, hipFuncAttributeMaxDynamicSharedMemorySize, LDS_BYTES) != hipSuccess) { fprintf(stderr, "kernel_launch: hipFuncSetAttribute failed\n"); grid = -1; return; }
        if (hipOccupancyMaxActiveBlocksPerMultiprocessor(&per_cu, (const void*)fwd, NWAVES * 64, LDS_BYTES) != hipSuccess || per_cu < 1) { fprintf(stderr, "kernel_launch: occupancy query says %d\n", per_cu); }
        (void)hipGetLastError();
        grid = cus;
        if (grid != 256) fprintf(stderr, "kernel_launch: %d CUs (built for 256)\n", grid);
    }
    if (grid < 0) return;
    (void)hipMemsetAsync((char*)d_ws + WS_CTL, 0, CTL_ZERO_BYTES, stream);
    Args a{};
    for (int i = 0; i < 17; ++i) a.in[i] = (const float*)d_in[i];
    a.out = (float*)d_out; a.ws = (unsigned char*)d_ws;
    if (MK_N_LAUNCHES == 1) { a.ph_lo = 0; a.ph_hi = N_PHASES; hipLaunchKernelGGL(fwd, dim3(grid), dim3(NWAVES * 64), LDS_BYTES, stream, a); }
    else for (int p = 0; p < N_PHASES; ++p) { a.ph_lo = p; a.ph_hi = p + 1; hipLaunchKernelGGL(fwd, dim3(grid), dim3(NWAVES * 64), LDS_BYTES, stream, a); }
    const hipError_t le = hipPeekAtLastError();
    if (le != hipSuccess) fprintf(stderr, "kernel_launch: launch failed: %s\n", hipGetErrorName(le));
}
```

```cpp
#include <hip/hip_runtime.h>
#include <cstdio>
#include <cstdint>

#define GAS __attribute__((address_space(1)))
#define LAS __attribute__((address_space(3)))
typedef unsigned short bf16_t;
typedef short bf16x8 __attribute__((ext_vector_type(8)));
typedef float f32x2 __attribute__((ext_vector_type(2)));
typedef float f32x4 __attribute__((ext_vector_type(4)));
typedef float f32x16 __attribute__((ext_vector_type(16)));
typedef unsigned u32x2 __attribute__((ext_vector_type(2)));
typedef unsigned u32x4 __attribute__((ext_vector_type(4)));
typedef int i32x4 __attribute__((ext_vector_type(4)));
typedef int i32x8 __attribute__((ext_vector_type(8)));
typedef __bf16 bf16x2_t __attribute__((ext_vector_type(2)));
typedef GAS unsigned gu32;
#define RLX_AGENT __ATOMIC_RELAXED, __HIP_MEMORY_SCOPE_AGENT

constexpr int DM = 1024, NB = 8, SEQ = 4096, NTOK = NB * SEQ;
constexpr int NMETA = 16, KPAD = 48, TPAD = KPAD + NMETA + SEQ;
constexpr int QOFF = KPAD + NMETA;
constexpr int AW = 512, NH = 8, HD = 64;
constexpr int NE = 32, TOPK = 4, FF = 1024;
constexpr int CAP_TILES = 544, CAP = CAP_TILES * 256;
constexpr float RMS_EPS = 1e-6f;
constexpr float LOG2E = 1.4426950408889634f;
constexpr float QSCALE = 0.125f * LOG2E;
#ifndef EXIT_THR_VAL
#define EXIT_THR_VAL 5.421010862427522e-20f
#endif
constexpr float EXIT_THR = EXIT_THR_VAL;
constexpr int NWAVES = 8;
#ifndef CONV_IN_P1
#define CONV_IN_P1 1
#endif
constexpr float YSCALE = 16.0f, YINV = 1.0f / 16.0f;
constexpr float WSCALE = 32.0f, WINV = 1.0f / 32.0f;

constexpr size_t MiB = 1u << 20, KiB = 1u << 10;
constexpr size_t WS_CTL = 0, CTL_ZERO_BYTES = 64 * KiB;
constexpr size_t WS_RSTD1 = 1 * MiB, WS_RSTD2 = WS_RSTD1 + 128 * KiB, WS_CNT = WS_RSTD2 + 128 * KiB, WS_TILEE = WS_CNT + 64 * KiB, WS_META = WS_TILEE + 64 * KiB;
constexpr size_t WS_TOPE = 2 * MiB, WS_GATE = WS_TOPE + 512 * KiB, WS_TOKSLOT = 3 * MiB;
constexpr size_t WS_SLOTTOK = 4 * MiB, WS_SLOTGATE = 5 * MiB, WS_SLOTRSTD = 6 * MiB;
constexpr size_t WS_WIN = 10 * MiB, WS_WGU = 16 * MiB, WS_WD = 144 * MiB, WS_A = 208 * MiB;
constexpr size_t WS_HID = 272 * MiB;
constexpr size_t WS_Q = 272 * MiB, WS_KB = 304 * MiB, WS_VT = 337 * MiB, WS_CB = 370 * MiB, WS_CC = 402 * MiB, WS_CX = 434 * MiB, WS_MIXED = 466 * MiB;
constexpr size_t WS_YS = 544 * MiB, WS_WOUT = 816 * MiB, WS_A8 = 820 * MiB, WS_END = 852 * MiB;
static_assert(WS_MIXED + 64 * MiB <= WS_HID + (size_t)CAP * 2048 && WS_HID + (size_t)CAP * 2048 <= WS_YS && WS_YS + (size_t)CAP * 2048 <= WS_WOUT, "ws map");
static_assert((size_t)NB * TPAD * 512 * 2 <= 33 * MiB, "K/Vt size");
constexpr int CW_TMO = 0, CW_QCONV = 64, CW_QATT = 128, CW_BAR = 1024;

constexpr int RING_BYTES = 131072, LDSCTL_OFF = RING_BYTES, MISC_OFF = LDSCTL_OFF + 320, P2_SS_OFF = 147456, LDS_BYTES = 151552;

__device__ __forceinline__ unsigned cvtpk(float lo, float hi) { f32x2 v = {lo, hi}; bf16x2_t b = __builtin_convertvector(v, bf16x2_t); return __builtin_bit_cast(unsigned, b); }
__device__ __forceinline__ unsigned pk4_fp8(float a, float b, float c, float d) { int w = 0; w = __builtin_amdgcn_cvt_pk_fp8_f32(a, b, w, false); w = __builtin_amdgcn_cvt_pk_fp8_f32(c, d, w, true); return (unsigned)w; }
__device__ __forceinline__ f32x2 fp8lo(unsigned w) { return __builtin_amdgcn_cvt_pk_f32_fp8((int)w, false); }
__device__ __forceinline__ f32x2 fp8hi(unsigned w) { return __builtin_amdgcn_cvt_pk_f32_fp8((int)w, true); }
__device__ __forceinline__ float bflo(unsigned u) { return __builtin_bit_cast(float, u << 16); }
__device__ __forceinline__ float bfhi(unsigned u) { return __builtin_bit_cast(float, u & 0xffff0000u); }
__device__ __forceinline__ float ex2(float x) { return __builtin_amdgcn_exp2f(x); }
__device__ __forceinline__ float lg2(float x) { return __builtin_amdgcn_logf(x); }
__device__ __forceinline__ int ld_i(const int* p) { return __hip_atomic_load(p, RLX_AGENT); }
__device__ __forceinline__ float ld_f(const float* p) { return __builtin_bit_cast(float, __hip_atomic_load((const int*)p, RLX_AGENT)); }
__device__ __forceinline__ float wave_sum(float v) {
#pragma unroll
    for (int o = 1; o < 64; o <<= 1) v += __shfl_xor(v, o);
    return v;
}
#define LDS_WAIT() asm volatile("s_waitcnt lgkmcnt(0)" ::: "memory")
#define VM_WAIT() asm volatile("s_waitcnt vmcnt(0)" ::: "memory")

namespace pg8 {
constexpr int BM = 256, BK = 64, HALF = 128, HTB = HALF * BK * 2, STAGE_BYTES = 8 * HTB, NXCD = 8, WGM = 8, GK = 1024;
__host__ __device__ __forceinline__ int lds_byte(int r, int c) { const int st = (r >> 4) * 2 + (c >> 5), rr = r & 15, cc = c & 31, ob = rr * 64 + cc * 2; return st * 1024 + (ob ^ (((ob >> 9) & 1) << 5)); }
__host__ __device__ __forceinline__ void stage_rc(int b, int& R, int& C) { const int st = b / 1024, sb = b % 1024, swz = sb ^ (((sb >> 9) & 1) << 5); R = (st >> 1) * 16 + swz / 64; C = (st & 1) * 32 + (swz % 64) / 2; }
__host__ __device__ __forceinline__ int perm32(int rho) { const int n = rho >> 4, i = rho & 15; return 8 * (i >> 2) + 4 * n + (i & 3); }
struct Unit { int pm, pn, e, dup; };

struct SchedPlain {
    const char* A; const char* Bt; int nM, nN, nwg, G, c, rep = 1; static constexpr int RB = 2048;
    __device__ void init(const void* A_, const void* Bt_, int M, int N, int G_, int c_) { A = (const char*)A_; Bt = (const char*)Bt_; nM = M / BM; nN = N / BM; nwg = nM * nN; G = G_; c = c_; }
    __device__ __forceinline__ bool next(int i, Unit& u) const {
        const int nmy = (c < nwg) ? (nwg - c + G - 1) / G : 0; if (i >= nmy * rep) return false;
        const long L = (long)(i % nmy) * G + c;
        int wgid = (int)L; { const int q = nwg / NXCD, r = nwg % NXCD, xcd = wgid % NXCD, off = wgid / NXCD; wgid = (xcd < r ? xcd * (q + 1) : r * (q + 1) + (xcd - r) * q) + off; }
        const int nig = WGM * nN, gid = wgid / nig, fm = gid * WGM, gsz = (nM - fm) < WGM ? (nM - fm) : WGM;
        u.pm = fm + ((wgid % nig) % gsz); u.pn = (wgid % nig) / gsz; u.e = 0; u.dup = (i >= nmy) ? 1 : 0; return true;
    }
    __device__ __forceinline__ unsigned a_tile(const Unit& u) const { return (unsigned)u.pm * (unsigned)(BM * RB); }
    __device__ __forceinline__ unsigned b_tile(const Unit& u) const { return (unsigned)u.pn * (unsigned)(BM * RB); }
    __device__ __forceinline__ unsigned tok_off(int) const { return 0u; }
    __device__ __forceinline__ unsigned tok_lds(int, int) const { return 0u; }
    __device__ __forceinline__ void tok_dma(int, int, int, int) const {}
};
struct SchedIn {
    const char* A; const char* Bt; int G, c, rep = 1; static constexpr int RB = 2048;
    static constexpr unsigned A1OFF = (unsigned)(WS_A - WS_WIN);
    __device__ __forceinline__ bool next(int i, Unit& u) const {
        constexpr int NU0 = 128 * 10, NU1 = 2 * 128, NU = NU0 + NU1;
        const int nmy = (c < NU) ? (NU - c + G - 1) / G : 0; if (i >= nmy * rep) return false;
        const int L = (i % nmy) * G + c; u.dup = (i >= nmy) ? 1 : 0;
        int nM, nN, nwg, wgid;
        if (L < NU0) { u.e = 0; nM = 128; nN = 10; nwg = NU0; wgid = L; } else { u.e = 1; nM = 2; nN = 128; nwg = NU1; wgid = L - NU0; }
        { const int q = nwg / NXCD, r = nwg % NXCD, xcd = wgid % NXCD, off = wgid / NXCD; wgid = (xcd < r ? xcd * (q + 1) : r * (q + 1) + (xcd - r) * q) + off; }
        const int nig = WGM * nN, gid = wgid / nig, fm = gid * WGM, gsz = (nM - fm) < WGM ? (nM - fm) : WGM;
        u.pm = fm + ((wgid % nig) % gsz); u.pn = (wgid % nig) / gsz; return true;
    }
    __device__ __forceinline__ unsigned a_tile(const Unit& u) const { return u.e ? (unsigned)(2560 + u.pm * BM) * (unsigned)RB : A1OFF + (unsigned)u.pm * (unsigned)(BM * RB); }
    __device__ __forceinline__ unsigned b_tile(const Unit& u) const { return u.e ? A1OFF + (unsigned)u.pn * (unsigned)(BM * RB) : (unsigned)u.pn * (unsigned)(BM * RB); }
    __device__ __forceinline__ unsigned tok_off(int) const { return 0u; }
    __device__ __forceinline__ unsigned tok_lds(int, int) const { return 0u; }
    __device__ __forceinline__ void tok_dma(int, int, int, int) const {}
};
template <int RB_> struct SchedGrouped {
    static constexpr int RB = RB_;
    const char* A; const char* Bt; size_t estep; int nN, G, c, ntiles; const int* tile_e; const int* slot_tok;
    LAS int* ltile;
    LAS int* ltok;
    int rep;
    __device__ __forceinline__ void setup() const { if (threadIdx.x < 33) ltile[threadIdx.x] = ld_i(tile_e + CAP_TILES + 1 + threadIdx.x); __syncthreads(); }
    __device__ __forceinline__ bool next(int i, Unit& u) const {
        const int g = c >> 5, w = c & 31;
        const int t0 = ltile[g], t1 = ltile[g + 1], t2 = ltile[g + 8], t3 = ltile[g + 9], t4 = ltile[g + 16], t5 = ltile[g + 17], t6 = ltile[g + 24], t7 = ltile[g + 25];
        const int n0 = (t1 - t0) * nN, n1 = (t3 - t2) * nN, n2 = (t5 - t4) * nN, n3 = (t7 - t6) * nN, tot = n0 + n1 + n2 + n3;
        const int nmy = (w < tot) ? (tot - w + 31) / 32 : 0; if (i >= nmy * rep) return false;
        int l = (i % nmy) * 32 + w, e, tb;
        if (l < n0) { e = g; tb = t0; } else if (l < n0 + n1) { l -= n0; e = g + 8; tb = t2; } else if (l < n0 + n1 + n2) { l -= n0 + n1; e = g + 16; tb = t4; } else { l -= n0 + n1 + n2; e = g + 24; tb = t6; }
        u.pm = __builtin_amdgcn_readfirstlane(tb + l / nN); u.pn = __builtin_amdgcn_readfirstlane(l % nN); u.e = __builtin_amdgcn_readfirstlane(e); u.dup = (i >= nmy) ? 1 : 0; return true;
    }
    __device__ __forceinline__ unsigned a_tile(const Unit& u) const { return (unsigned)u.pm * (unsigned)(BM * RB); }
    __device__ __forceinline__ unsigned b_tile(const Unit& u) const { return (unsigned)u.e * (unsigned)estep + (unsigned)u.pn * (unsigned)(BM * RB); }
    __device__ __forceinline__ unsigned tok_off(int row) const { return (unsigned)ld_i(slot_tok + row) * (unsigned)RB; }
    __device__ __forceinline__ unsigned tok_lds(int par, int r) const { return (unsigned)ltok[par * 256 + r] * (unsigned)RB; }
    __device__ __forceinline__ void tok_dma(int par, int pm, int wid, int lane) const {
        const __amdgpu_buffer_rsrc_t rsT = __builtin_amdgcn_make_buffer_rsrc((void*)slot_tok, (short)0, CAP * 4, 0x00020000);
        __builtin_amdgcn_raw_ptr_buffer_load_lds(rsT, (LAS void*)(ltok + par * 256 + wid * 64), 4, lane * 4, (pm * 256 + wid * 64) * 4, 0, 0);
    }
};

template <class Epi, class Sched, bool GATHER, bool FP8 = false, bool ALIGN_EPI = true>
__device__ __forceinline__ void gemm_phase(LAS unsigned char* lds, const Sched& S, const Epi& E) {
    constexpr int RB = Sched::RB, nt = RB / 128;
    const int tid = threadIdx.x, wid = __builtin_amdgcn_readfirstlane(tid >> 6), lane = tid & 63, wr = wid >> 2, wc = wid & 3, fr = lane & 15, fq = lane >> 4;
    unsigned voffA[2], voffB[2], stC2[2]; int stR[2];
#pragma unroll
    for (int i = 0; i < 2; ++i) { int R, C; stage_rc(tid * 16 + i * 8192, R, C); const int Rb = (R & ~31) + perm32(R & 31);
        voffA[i] = (unsigned)(R * RB + C * 2); voffB[i] = (unsigned)(Rb * RB + C * 2); stR[i] = R; stC2[i] = (unsigned)C * 2u; }
    constexpr unsigned kstep = 128u, hstep = (unsigned)(HALF * RB);
    const __amdgpu_buffer_rsrc_t rsA = __builtin_amdgcn_make_buffer_rsrc((void*)S.A, (short)0, 0x7fffff00, 0x00020000), rsB = __builtin_amdgcn_make_buffer_rsrc((void*)S.Bt, (short)0, 0x7fffff00, 0x00020000);
    const unsigned ldsw = (unsigned)wid * 1024u;
    const int aoff = lds_byte(wr * 64 + fr, fq * 8), boff = lds_byte(wc * 32 + fr, fq * 8);
#define PG8_SA(b, h) (((b) * 2 + (h)) * HTB)
#define PG8_SB(b, h) ((4 + (b) * 2 + (h)) * HTB)
#define PG8_STAGE2(bufoff, rs, soff, o0, o1) do { \
        __builtin_amdgcn_raw_ptr_buffer_load_lds(rs, (LAS void*)(lds + (bufoff) + ldsw), 16, (int)(o0), (int)(soff), 0, 0); \
        __builtin_amdgcn_raw_ptr_buffer_load_lds(rs, (LAS void*)(lds + (bufoff) + ldsw + 8192), 16, (int)(o1), (int)(soff), 0, 0); } while (0)
#define PG8_STAGE_B(bufoff, soff) PG8_STAGE2(bufoff, rsB, soff, voffB[0], voffB[1])
#define PG8_STAGE_A(bufoff, usenext, h, koff) do { if constexpr (GATHER) { \
            const unsigned _o0 = (usenext) ? ng[h][0] : cg[h][0], _o1 = (usenext) ? ng[h][1] : cg[h][1]; PG8_STAGE2(bufoff, rsA, (koff), _o0, _o1); } \
        else { PG8_STAGE2(bufoff, rsA, ((usenext) ? nA : cA) + (unsigned)(h) * hstep + (koff), voffA[0], voffA[1]); } } while (0)
#define PG8_LDA(dst, b, h) do { _Pragma("unroll") for (int m = 0; m < 4; ++m) _Pragma("unroll") for (int k = 0; k < 2; ++k) dst[m][k] = *(const LAS bf16x8*)(lds + PG8_SA(b, h) + aoff + m * 2048 + k * 1024); } while (0)
#define PG8_LDB(dst, b, h) do { _Pragma("unroll") for (int n = 0; n < 2; ++n) _Pragma("unroll") for (int k = 0; k < 2; ++k) dst[n][k] = *(const LAS bf16x8*)(lds + PG8_SB(b, h) + boff + n * 2048 + k * 1024); } while (0)
#define PG8_MMA(ai, bj, At, Bt) do { __builtin_amdgcn_s_setprio(1); _Pragma("unroll") for (int m = 0; m < 4; ++m) _Pragma("unroll") for (int n = 0; n < 2; ++n) { \
        if constexpr (FP8) { const i32x8 bb_ = __builtin_shufflevector(__builtin_bit_cast(i32x4, Bt[n][0]), __builtin_bit_cast(i32x4, Bt[n][1]), 0, 1, 2, 3, 4, 5, 6, 7); \
            const i32x8 aa_ = __builtin_shufflevector(__builtin_bit_cast(i32x4, At[m][0]), __builtin_bit_cast(i32x4, At[m][1]), 0, 1, 2, 3, 4, 5, 6, 7); \
            asm volatile("v_mfma_scale_f32_16x16x128_f8f6f4 %0, %1, %2, %0, %3, %3 op_sel_hi:[0,0,0]" : "+v"(acc[ai][bj][m][n]) : "v"(bb_), "v"(aa_), "v"(scl8)); } \
        else { _Pragma("unroll") for (int k = 0; k < 2; ++k) acc[ai][bj][m][n] = __builtin_amdgcn_mfma_f32_16x16x32_bf16(Bt[n][k], At[m][k], acc[ai][bj][m][n], 0, 0, 0); } } \
        __builtin_amdgcn_s_setprio(0); } while (0)
#define PG8_MFMA_DRAIN() do { if constexpr (FP8) asm volatile("s_nop 7\n\ts_nop 7" ::: "memory"); } while (0)
#define PG8_WAIT_V(n) asm volatile("s_waitcnt vmcnt(" #n ")" ::: "memory")
#define PG8_WAIT_L(n) asm volatile("s_waitcnt lgkmcnt(" #n ")" ::: "memory")
#define PG8_BAR __builtin_amdgcn_s_barrier()
#define PG8_SCHED __builtin_amdgcn_sched_barrier(0)
    Unit cur, nxt; int ui = 0;
    if (!S.next(0, cur)) return;
    f32x4 acc[2][2][4][2];
    if constexpr (Epi::HAS_INIT) E.init(acc, cur, wr, wc, fr, fq); else {
#pragma unroll
    for (int a = 0; a < 2; ++a)
#pragma unroll
        for (int b = 0; b < 2; ++b)
#pragma unroll
            for (int m = 0; m < 4; ++m)
#pragma unroll
                for (int n = 0; n < 2; ++n) acc[a][b][m][n] = (f32x4){0.f, 0.f, 0.f, 0.f};
    }
    bf16x8 At[4][2], B0[2][2], B1[2][2];
    int scl8 = 0x7f7f7f7f; asm volatile("" : "+v"(scl8));
    unsigned cA = S.a_tile(cur), cB = S.b_tile(cur), nA = cA;
    unsigned cg[2][2], ng[2][2];
    if constexpr (GATHER) {
#pragma unroll
        for (int h = 0; h < 2; ++h)
#pragma unroll
            for (int i = 0; i < 2; ++i) { cg[h][i] = S.tok_off(cur.pm * BM + h * HALF + stR[i]) + stC2[i]; ng[h][i] = cg[h][i]; }
    } else {
#pragma unroll
        for (int h = 0; h < 2; ++h)
#pragma unroll
            for (int i = 0; i < 2; ++i) { cg[h][i] = 0u; ng[h][i] = 0u; }
    }
    PG8_STAGE_B(PG8_SB(0, 0), cB); PG8_STAGE_B(PG8_SB(0, 1), cB + hstep); PG8_STAGE_A(PG8_SA(0, 0), false, 0, 0); PG8_STAGE_A(PG8_SA(0, 1), false, 1, 0);
    if (wr == 1) PG8_BAR;
    PG8_WAIT_V(2); PG8_BAR;
    PG8_STAGE_B(PG8_SB(1, 0), cB + kstep); PG8_STAGE_A(PG8_SA(1, 0), false, 0, kstep); PG8_STAGE_B(PG8_SB(1, 1), cB + hstep + kstep);
    PG8_WAIT_V(6); PG8_BAR;
    for (;;) {
        const bool has_next = S.next(ui + 1, nxt);
        nA = has_next ? S.a_tile(nxt) : cA; const unsigned nB = has_next ? S.b_tile(nxt) : cB;
#pragma unroll 1
        for (int t = 0; t < nt; t += 2) {
            const bool last = (t == nt - 2);
            const unsigned koff1 = (unsigned)(t + 1) * kstep, koff2 = last ? 0u : (unsigned)(t + 2) * kstep, koff3 = koff2 + kstep;
            const unsigned b2 = last ? nB : cB + (unsigned)(t + 2) * kstep, b3 = b2 + kstep;
            if constexpr (GATHER) {
                if (t == nt - 4 && has_next && wid < 4) S.tok_dma((ui + 1) & 1, nxt.pm, wid, lane);
                if (last && has_next) {
#pragma unroll
                    for (int h = 0; h < 2; ++h)
#pragma unroll
                        for (int i = 0; i < 2; ++i) ng[h][i] = S.tok_lds((ui + 1) & 1, h * HALF + stR[i]) + stC2[i]; } }
            PG8_LDB(B0, 0, 0); PG8_LDB(B1, 0, 1); PG8_SCHED; PG8_LDA(At, 0, 0); PG8_STAGE_A(PG8_SA(1, 1), false, 1, koff1);
            PG8_WAIT_V(8); PG8_WAIT_L(0); PG8_BAR; PG8_MMA(0, 0, At, B0); PG8_MMA(0, 1, At, B1); PG8_BAR; PG8_SCHED;
            PG8_LDA(At, 0, 1); PG8_STAGE_B(PG8_SB(0, 0), b2); PG8_STAGE_B(PG8_SB(0, 1), b2 + hstep); PG8_STAGE_A(PG8_SA(0, 0), last, 0, koff2);
            PG8_WAIT_V(8); PG8_WAIT_L(0); PG8_BAR; PG8_MMA(1, 0, At, B0); PG8_MMA(1, 1, At, B1); PG8_BAR; PG8_SCHED;
            PG8_LDB(B0, 1, 0); PG8_LDB(B1, 1, 1); PG8_SCHED; PG8_LDA(At, 1, 0); PG8_STAGE_A(PG8_SA(0, 1), last, 1, koff2);
            PG8_WAIT_V(8); PG8_WAIT_L(0); PG8_BAR; PG8_MMA(0, 0, At, B0); PG8_MMA(0, 1, At, B1); PG8_BAR; PG8_SCHED;
            PG8_LDA(At, 1, 1); PG8_STAGE_B(PG8_SB(1, 0), b3); PG8_STAGE_B(PG8_SB(1, 1), b3 + hstep); PG8_STAGE_A(PG8_SA(1, 0), last, 0, koff3);
            PG8_WAIT_V(8); PG8_WAIT_L(0); PG8_BAR; PG8_MMA(1, 0, At, B0); PG8_MMA(1, 1, At, B1); PG8_BAR; PG8_SCHED;
        }
        if constexpr (ALIGN_EPI) { if (wr == 0) PG8_BAR; }
        PG8_MFMA_DRAIN();
        E(acc, cur, wr, wc, fr, fq);
        if (!has_next) break;
        if constexpr (Epi::HAS_INIT) E.init(acc, nxt, wr, wc, fr, fq); else {
#pragma unroll
        for (int a = 0; a < 2; ++a)
#pragma unroll
            for (int b = 0; b < 2; ++b)
#pragma unroll
                for (int m = 0; m < 4; ++m)
#pragma unroll
                    for (int n = 0; n < 2; ++n) acc[a][b][m][n] = (f32x4){0.f, 0.f, 0.f, 0.f};
        }
        cur = nxt; cA = nA; cB = nB; ++ui;
#pragma unroll
        for (int h = 0; h < 2; ++h)
#pragma unroll
            for (int i = 0; i < 2; ++i) cg[h][i] = ng[h][i];
        if constexpr (ALIGN_EPI) { if (wr == 1) PG8_BAR; }
    }
    PG8_WAIT_V(0);
    if constexpr (!ALIGN_EPI) { if (wr == 0) PG8_BAR; }
    PG8_BAR;
#undef PG8_SA
#undef PG8_SB
#undef PG8_STAGE2
#undef PG8_STAGE_B
#undef PG8_STAGE_A
#undef PG8_LDA
#undef PG8_LDB
#undef PG8_MMA
#undef PG8_MFMA_DRAIN
#undef PG8_WAIT_V
#undef PG8_WAIT_L
#undef PG8_BAR
#undef PG8_SCHED
}
}

#define XB_TMO      128
#define XB_XCNT(j)  (256  + 64 * (j))
#define XB_XSUB(j)  (1280 + 64 * (j))
#define XB_XGEN(j)  (2304 + 64 * (j))
#define XB_TOP      3328
#define XB_TOPGEN   3392
#define XCD_BAR_WORDS 3456
#define XB_SPIN_CAP (1u << 18)

__device__ __forceinline__ unsigned xb_ld(unsigned* p)              { return __hip_atomic_load(p, __ATOMIC_RELAXED, __HIP_MEMORY_SCOPE_AGENT); }
__device__ __forceinline__ unsigned xb_add(unsigned* p, unsigned v) { return __hip_atomic_fetch_add(p, v, __ATOMIC_RELAXED, __HIP_MEMORY_SCOPE_AGENT); }
__device__ __forceinline__ unsigned xb_xcc_id() { return (unsigned)__builtin_amdgcn_s_getreg((3 << 11) | 20) & 0xFu; }
#define XB_SPIN(cond, bar) do { unsigned _sp = 0; while (cond) { __builtin_amdgcn_s_sleep(1); \
    if ((++_sp & 255u) == 0u) { if (xb_ld(&(bar)[XB_TMO])) break; if (_sp > XB_SPIN_CAP) { atomicAdd(&(bar)[XB_TMO], 1u); break; } } } } while (0)

struct XcdBarrier {
    unsigned* bar; unsigned x;
    volatile LAS unsigned* st;
};

__device__ __forceinline__ XcdBarrier xcd_barrier_post(unsigned* bar, volatile LAS unsigned* st) {
    XcdBarrier b; b.bar = bar; b.x = xb_xcc_id(); b.st = st;
    if (threadIdx.x == 0) (void)xb_add(&bar[XB_XCNT(b.x)], 1u);
    return b;
}
__device__ __forceinline__ void xcd_barrier_complete(unsigned* bar, unsigned x, unsigned& nloc, unsigned& nx) {
    const unsigned G = gridDim.x * gridDim.y * gridDim.z;
    unsigned sum, cnt, mine, sp = 0u;
    for (;;) {
        sum = 0u; cnt = 0u; mine = 0u;
#pragma unroll
        for (unsigned j = 0; j < 16; ++j) { const unsigned c = xb_ld(&bar[XB_XCNT(j)]); sum += c; cnt += (c > 0u) ? 1u : 0u; mine = (j == x) ? c : mine; }
        if (sum == G) break;
        __builtin_amdgcn_s_sleep(1);
        if ((++sp & 255u) == 0u) { if (xb_ld(&bar[XB_TMO])) break; if (sp > XB_SPIN_CAP) { atomicAdd(&bar[XB_TMO], 1u); break; } }
    }
    nloc = mine > 0u ? mine : 1u; nx = cnt > 0u ? cnt : 1u;
}

__device__ __forceinline__ void xcd_barrier(const XcdBarrier& b) {
    asm volatile("s_waitcnt vmcnt(0)" ::: "memory");
    __syncthreads();
    if (threadIdx.x == 0) {
        unsigned* bar = b.bar;
        __builtin_amdgcn_s_waitcnt(0);
        unsigned nloc = b.st[0], nx = b.st[1];
        if (nloc == 0u) { xcd_barrier_complete(bar, b.x, nloc, nx); b.st[0] = nloc; b.st[1] = nx; }
        const unsigned old = xb_add(&bar[XB_XSUB(b.x)], 1u);
        const unsigned gen = old / nloc;
        if (old + 1u == (gen + 1u) * nloc) {
            __builtin_amdgcn_fence(__ATOMIC_RELEASE, "agent");
            asm volatile("s_waitcnt vmcnt(0)" ::: "memory");
            const unsigned og = xb_add(&bar[XB_TOP], 1u);
            const unsigned tg = og / nx;
            if (og + 1u == (tg + 1u) * nx) xb_add(&bar[XB_TOPGEN], 1u);
            else XB_SPIN(xb_ld(&bar[XB_TOPGEN]) == tg, bar);
            __builtin_amdgcn_fence(__ATOMIC_ACQUIRE, "agent");
            xb_add(&bar[XB_XGEN(b.x)], 1u);
            asm volatile("s_waitcnt vmcnt(0)" ::: "memory");
        } else {
            XB_SPIN(xb_ld(&bar[XB_XGEN(b.x)]) == gen, bar);
            __builtin_amdgcn_fence(__ATOMIC_ACQUIRE, "agent");
            asm volatile("s_waitcnt vmcnt(0)" ::: "memory");
        }
    }
    __syncthreads();
}

typedef f32x4 AccT[2][2][4][2];
struct EpiProj {
    static constexpr bool HAS_INIT = false;
    bf16_t *Q, *KB, *CB, *CC, *CX; const float* rstd1;
    __device__ __forceinline__ void operator()(const AccT& acc, const pg8::Unit& u, int wr, int wc, int fr, int fq) const {
#ifdef SKIP_REP_EPI
        if (u.dup) return;
#endif
        const int sec = u.pn >> 1, row0 = u.pm * 256 + wr * 64 + fr, col0 = (u.pn & 1) * 256 + wc * 32 + 8 * fq;
        bf16_t* base = sec == 0 ? Q : sec == 1 ? KB : sec == 2 ? CB : sec == 3 ? CC : CX;
        const int radd = (sec == 1) ? 64 * ((u.pm >> 4) + 1) : 0;
        const float sc0 = (sec == 0) ? QSCALE : 1.0f;
        float rsv[2][4];
#pragma unroll
        for (int ai = 0; ai < 2; ++ai)
#pragma unroll
            for (int m = 0; m < 4; ++m) rsv[ai][m] = rstd1[row0 + ai * 128 + m * 16];
#pragma unroll
        for (int ai = 0; ai < 2; ++ai)
#pragma unroll
            for (int m = 0; m < 4; ++m) { const int r = row0 + ai * 128 + m * 16; const float sc = rsv[ai][m] * sc0;
                bf16_t* rowp = base + (size_t)(r + radd) * 512 + col0;
#pragma unroll
                for (int bj = 0; bj < 2; ++bj) { const f32x4 v0 = acc[ai][bj][m][0] * sc, v1 = acc[ai][bj][m][1] * sc;
                    u32x4 w; w.x = cvtpk(v0[0], v0[1]); w.y = cvtpk(v0[2], v0[3]); w.z = cvtpk(v1[0], v1[1]); w.w = cvtpk(v1[2], v1[3]);
                    *(u32x4*)(rowp + bj * 128) = w; } }
    }
};
struct EpiVt {
    static constexpr bool HAS_INIT = false;
    bf16_t* VT; const float* rstd1;
    __device__ __forceinline__ void operator()(const AccT& acc, const pg8::Unit& u, int wr, int wc, int fr, int fq) const {
#ifdef SKIP_REP_EPI
        if (u.dup) return;
#endif
        const int row0 = u.pm * 256 + wr * 64 + fr, col0 = u.pn * 256 + wc * 32 + 8 * fq;
        f32x4 rs[2][2];
#pragma unroll
        for (int bj = 0; bj < 2; ++bj)
#pragma unroll
            for (int n = 0; n < 2; ++n) rs[bj][n] = *(const f32x4*)(rstd1 + col0 + bj * 128 + 4 * n);
        const int dcol0 = col0 + 64 * ((u.pn >> 4) + 1);
#pragma unroll
        for (int ai = 0; ai < 2; ++ai)
#pragma unroll
            for (int m = 0; m < 4; ++m) { bf16_t* rowp = VT + (size_t)(row0 + ai * 128 + m * 16) * (size_t)(NB * TPAD) + dcol0;
#pragma unroll
                for (int bj = 0; bj < 2; ++bj) { const f32x4 v0 = acc[ai][bj][m][0] * rs[bj][0], v1 = acc[ai][bj][m][1] * rs[bj][1];
                    u32x4 w; w.x = cvtpk(v0[0], v0[1]); w.y = cvtpk(v0[2], v0[3]); w.z = cvtpk(v1[0], v1[1]); w.w = cvtpk(v1[2], v1[3]);
                    *(u32x4*)(rowp + bj * 128) = w; } }
    }
};
struct EpiIn {
    static constexpr bool HAS_INIT = false;
    EpiProj ep; EpiVt ev;
    __device__ __forceinline__ void operator()(const AccT& acc, const pg8::Unit& u, int wr, int wc, int fr, int fq) const { if (u.e) ev(acc, u, wr, wc, fr, fq); else ep(acc, u, wr, wc, fr, fq); }
};
struct EpiOut {
    static constexpr bool HAS_INIT = false;
    const float* x; bf16_t* H1; unsigned char* A8; const float* gffn;
    __device__ __forceinline__ void init(AccT&, const pg8::Unit&, int, int, int, int) const {}
    __device__ __forceinline__ void operator()(const AccT& acc, const pg8::Unit& u, int wr, int wc, int fr, int fq) const {
        const int row0 = u.pm * 256 + wr * 64 + fr, col0 = u.pn * 256 + wc * 32 + 8 * fq;
        f32x4 g[2][2];
#pragma unroll
        for (int bj = 0; bj < 2; ++bj)
#pragma unroll
            for (int n = 0; n < 2; ++n) g[bj][n] = *(const f32x4*)(gffn + col0 + bj * 128 + 4 * n);
        f32x4 xc[2][2], xn[2][2];
        { const size_t ro = (size_t)row0 * DM + col0;
#pragma unroll
          for (int bj = 0; bj < 2; ++bj) { xc[bj][0] = *(const f32x4*)(x + ro + bj * 128); xc[bj][1] = *(const f32x4*)(x + ro + bj * 128 + 4); } }
#pragma unroll
        for (int gi = 0; gi < 8; ++gi) { const int ai = gi >> 2, m = gi & 3;
            if (gi < 7) { const int r2 = row0 + ((gi + 1) >> 2) * 128 + ((gi + 1) & 3) * 16; const size_t ro2 = (size_t)r2 * DM + col0;
#pragma unroll
                for (int bj = 0; bj < 2; ++bj) { xn[bj][0] = *(const f32x4*)(x + ro2 + bj * 128); xn[bj][1] = *(const f32x4*)(x + ro2 + bj * 128 + 4); } }
            asm volatile("" ::: "memory");
            const int r = row0 + ai * 128 + m * 16; const size_t ro = (size_t)r * DM + col0; u32x2 w8[2];
#pragma unroll
            for (int bj = 0; bj < 2; ++bj) {
                const f32x4 v0 = acc[ai][bj][m][0] + xc[bj][0], v1 = acc[ai][bj][m][1] + xc[bj][1];
                u32x4 w; w.x = cvtpk(v0[0], v0[1]); w.y = cvtpk(v0[2], v0[3]); w.z = cvtpk(v1[0], v1[1]); w.w = cvtpk(v1[2], v1[3]);
                *(u32x4*)(H1 + ro + bj * 128) = w;
                const f32x4 a0 = v0 * g[bj][0], a1 = v1 * g[bj][1];
                w8[bj].x = pk4_fp8(a0[0], a0[1], a0[2], a0[3]); w8[bj].y = pk4_fp8(a1[0], a1[1], a1[2], a1[3]); }
            {
                const bool odd = fq & 1; const u32x2 snd = odd ? w8[0] : w8[1]; u32x2 rcv; rcv.x = __shfl_xor(snd.x, 16); rcv.y = __shfl_xor(snd.y, 16);
                const u32x4 o16 = odd ? (u32x4){rcv.x, rcv.y, w8[1].x, w8[1].y} : (u32x4){w8[0].x, w8[0].y, rcv.x, rcv.y};
                *(u32x4*)(A8 + (size_t)r * DM + u.pn * 256 + wc * 32 + 16 * (fq >> 1) + (odd ? 128 : 0)) = o16; }
            asm volatile("" ::: "memory");
#pragma unroll
            for (int bj = 0; bj < 2; ++bj) { xc[bj][0] = xn[bj][0]; xc[bj][1] = xn[bj][1]; }
        }
    }
};
struct EpiGU {
    static constexpr bool HAS_INIT = false;
    unsigned char* hid; const float* bgu; const float* slot_rstd;
    __device__ __forceinline__ void operator()(const AccT& acc, const pg8::Unit& u, int wr, int wc, int fr, int fq) const {
#ifdef SKIP_REP_EPI
        if (u.dup) return;
#endif
        const int row0 = u.pm * 256 + wr * 64 + fr, colr = u.pn * 128 + wc * 32 + 8 * fq;
        const float* bg = bgu + (size_t)u.e * 2048 + colr;
        const f32x4 bg0 = *(const f32x4*)(bg), bg1 = *(const f32x4*)(bg + 4), bl0 = *(const f32x4*)(bg + 1024), bl1 = *(const f32x4*)(bg + 1028);
        float rsv[2][4];
#pragma unroll
        for (int ai = 0; ai < 2; ++ai)
#pragma unroll
            for (int m = 0; m < 4; ++m) rsv[ai][m] = slot_rstd[row0 + ai * 128 + m * 16];
#pragma unroll
        for (int ai = 0; ai < 2; ++ai)
#pragma unroll
            for (int m = 0; m < 4; ++m) { const int r = row0 + ai * 128 + m * 16; const float rs = rsv[ai][m] * WINV;
                float hv[8];
#pragma unroll
                for (int n = 0; n < 2; ++n)
#pragma unroll
                    for (int i = 0; i < 4; ++i) {
                        float gt = acc[ai][0][m][n][i] * rs + (n ? bg1[i] : bg0[i]), ln = acc[ai][1][m][n][i] * rs + (n ? bl1[i] : bl0[i]);
                        gt = fminf(gt, 7.0f); ln = fminf(fmaxf(ln, -7.0f), 7.0f);
                        const float sg = __builtin_amdgcn_rcpf(1.0f + ex2(gt * (-1.702f * LOG2E)));
                        hv[n * 4 + i] = (ln + 1.0f) * (gt * sg); }
                u32x2 w; w.x = pk4_fp8(hv[0], hv[1], hv[2], hv[3]); w.y = pk4_fp8(hv[4], hv[5], hv[6], hv[7]);
                *(u32x2*)(hid + (size_t)r * FF + colr) = w; }
    }
};
struct EpiDown {
    static constexpr bool HAS_INIT = false;
    unsigned char* ys; const float* bd; const float* slot_gate;
    __device__ __forceinline__ void operator()(const AccT& acc, const pg8::Unit& u, int wr, int wc, int fr, int fq) const {
#ifdef SKIP_REP_EPI
        if (u.dup) return;
#endif
        const int row0 = u.pm * 256 + wr * 64 + fr, col0 = u.pn * 256 + wc * 32 + 8 * fq;
        f32x4 bv[2][2];
#pragma unroll
        for (int bj = 0; bj < 2; ++bj)
#pragma unroll
            for (int n = 0; n < 2; ++n) bv[bj][n] = *(const f32x4*)(bd + (size_t)u.e * DM + col0 + bj * 128 + 4 * n);
        float gtv[2][4];
#pragma unroll
        for (int ai = 0; ai < 2; ++ai)
#pragma unroll
            for (int m = 0; m < 4; ++m) gtv[ai][m] = slot_gate[row0 + ai * 128 + m * 16] * YSCALE;
#pragma unroll
        for (int ai = 0; ai < 2; ++ai)
#pragma unroll
            for (int m = 0; m < 4; ++m) { const int r = row0 + ai * 128 + m * 16; const float gt = gtv[ai][m];
                u32x2 w[2];
#pragma unroll
                for (int bj = 0; bj < 2; ++bj) { const f32x4 v0 = (acc[ai][bj][m][0] * WINV + bv[bj][0]) * gt, v1 = (acc[ai][bj][m][1] * WINV + bv[bj][1]) * gt;
                    w[bj].x = pk4_fp8(v0[0], v0[1], v0[2], v0[3]); w[bj].y = pk4_fp8(v1[0], v1[1], v1[2], v1[3]); }
                const bool odd = fq & 1; const u32x2 snd = odd ? w[0] : w[1]; u32x2 rcv; rcv.x = __shfl_xor(snd.x, 16); rcv.y = __shfl_xor(snd.y, 16);
                const u32x4 o16 = odd ? (u32x4){rcv.x, rcv.y, w[1].x, w[1].y} : (u32x4){w[0].x, w[0].y, rcv.x, rcv.y};
                *(u32x4*)(ys + (size_t)r * DM + u.pn * 256 + wc * 32 + 16 * (fq >> 1) + (odd ? 128 : 0)) = o16; }
    }
};

struct Args { const float* in[17]; float* out; unsigned char* ws; int ph_lo, ph_hi; };
struct Frame {
    LAS unsigned char* lds; gu32* ctl; int tid, lane, wave, vcu, G;
    const float *x, *meta, *g_mix, *w_in, *g_attn, *conv_w, *conv_b, *g_conv, *w_out, *g_ffn, *w_router, *b_router, *w_gu, *b_gu, *w_down, *b_down, *g_final;
    float* out; unsigned char* ws;
};
template <class T> __device__ __forceinline__ T* wsp(const Frame& F, size_t off) { return (T*)(F.ws + off); }

__device__ __forceinline__ void p0_transpose_item(const float* W, int ldw, int k0, int n0, bf16_t* WT, int Kd, int drow0, LAS unsigned* scr, int lane) {
    const int ks = lane >> 4, n4 = lane & 15;
    f32x4 va[8], vb[8];
    const float* src = W + (size_t)(k0 + 2 * ks) * ldw + n0 + 4 * n4;
#pragma unroll
    for (int i = 0; i < 8; ++i) { va[i] = *(const f32x4*)(src + (size_t)(8 * i) * ldw); vb[i] = *(const f32x4*)(src + (size_t)(8 * i + 1) * ldw); }
#pragma unroll
    for (int i = 0; i < 8; ++i)
#pragma unroll
        for (int j = 0; j < 4; ++j) scr[(4 * n4 + j) * 33 + 4 * i + ks] = cvtpk(va[i][j], vb[i][j]);
    LDS_WAIT(); asm volatile("" ::: "memory");
    const int ns = lane >> 3, c = lane & 7;
#pragma unroll
    for (int r = 0; r < 8; ++r) { const int n = 8 * r + ns; const LAS unsigned* t = scr + n * 33 + 4 * c;
        u32x4 o; o.x = t[0]; o.y = t[1]; o.z = t[2]; o.w = t[3];
        *(u32x4*)(WT + (size_t)(drow0 + n) * Kd + k0 + 8 * c) = o; }
    LDS_WAIT(); asm volatile("" ::: "memory");
}
#ifndef ITEM8_ALL32
#define ITEM8_ALL32 0
#endif
__device__ __forceinline__ void p0_transpose_item8(const float* W, int ldw, int k0, int n0, unsigned char* WT8, int Kd, int drow0, LAS unsigned* scr, int lane) {
    const int ks = lane >> 4, n4 = lane & 15;
#if ITEM8_ALL32
    f32x4 v[2][4][4];
#pragma unroll
    for (int h = 0; h < 2; ++h) {
        const float* src = W + (size_t)(k0 + 64 * h + 4 * ks) * ldw + n0 + 4 * n4;
#pragma unroll
        for (int i = 0; i < 4; ++i)
#pragma unroll
            for (int q = 0; q < 4; ++q) v[h][i][q] = *(const f32x4*)(src + (size_t)(16 * i + q) * ldw);
    }
#pragma unroll
    for (int h = 0; h < 2; ++h)
#pragma unroll
        for (int i = 0; i < 4; ++i)
#pragma unroll
            for (int j = 0; j < 4; ++j) scr[(4 * n4 + j) * 33 + 16 * h + 4 * i + ks] = pk4_fp8(v[h][i][0][j] * WSCALE, v[h][i][1][j] * WSCALE, v[h][i][2][j] * WSCALE, v[h][i][3][j] * WSCALE);
#else
#pragma unroll
    for (int h = 0; h < 2; ++h) {
        f32x4 v[4][4];
        const float* src = W + (size_t)(k0 + 64 * h + 4 * ks) * ldw + n0 + 4 * n4;
#pragma unroll
        for (int i = 0; i < 4; ++i)
#pragma unroll
            for (int q = 0; q < 4; ++q) v[i][q] = *(const f32x4*)(src + (size_t)(16 * i + q) * ldw);
#pragma unroll
        for (int i = 0; i < 4; ++i)
#pragma unroll
            for (int j = 0; j < 4; ++j) scr[(4 * n4 + j) * 33 + 16 * h + 4 * i + ks] = pk4_fp8(v[i][0][j] * WSCALE, v[i][1][j] * WSCALE, v[i][2][j] * WSCALE, v[i][3][j] * WSCALE);
    }
#endif
    LDS_WAIT(); asm volatile("" ::: "memory");
    const int ns = lane >> 3, c = lane & 7;
#pragma unroll
    for (int r = 0; r < 8; ++r) { const int n = 8 * r + ns; const LAS unsigned* t = scr + n * 33 + 4 * c;
        u32x4 o; o.x = t[0]; o.y = t[1]; o.z = t[2]; o.w = t[3];
        *(u32x4*)(WT8 + (size_t)(drow0 + n) * Kd + k0 + 16 * c) = o; }
    LDS_WAIT(); asm volatile("" ::: "memory");
}
__device__ __forceinline__ void p0_meta_job(Frame& F, int mw) {
    LAS float* nm = (LAS float*)F.lds;
    LAS float* part = (LAS float*)(F.lds + 65536);
    for (int t = F.wave * 2; t < F.wave * 2 + 2; ++t) {
        float v[16]; float ss = 0.f;
#pragma unroll
        for (int j = 0; j < 16; ++j) { v[j] = F.meta[t * DM + j * 64 + F.lane]; ss += v[j] * v[j]; }
        const float rstd = 1.0f / sqrtf(wave_sum(ss) * (1.0f / DM) + RMS_EPS);
#pragma unroll
        for (int j = 0; j < 16; ++j) { const int k = j * 64 + F.lane; nm[k * 16 + t] = v[j] * rstd * F.g_mix[k]; }
    }
    __syncthreads();
    const int kq = F.tid >> 7, c = F.tid & 127, j = mw * 128 + c, sec4 = j >> 9, jc = j & 511;
    const int ocol = (sec4 == 0 ? 512 : sec4 == 1 ? 1024 : sec4 == 2 ? 2048 : 2560) + jc;
    float acc[16];
#pragma unroll
    for (int t = 0; t < 16; ++t) acc[t] = 0.f;
    for (int kk = kq * 256; kk < kq * 256 + 256; kk += 16) {
        float wv[16];
#pragma unroll
        for (int u = 0; u < 16; ++u) wv[u] = F.w_in[(size_t)(kk + u) * 3072 + ocol];
#pragma unroll
        for (int u = 0; u < 16; ++u) { const float w = wv[u];
            const LAS f32x4* nv = (const LAS f32x4*)(nm + (kk + u) * 16);
#pragma unroll
            for (int q = 0; q < 4; ++q) { const f32x4 n4 = nv[q]; acc[4 * q] += w * n4[0]; acc[4 * q + 1] += w * n4[1]; acc[4 * q + 2] += w * n4[2]; acc[4 * q + 3] += w * n4[3]; } }
    }
#pragma unroll
    for (int t = 0; t < 16; ++t) part[(kq * 128 + c) * 16 + t] = acc[t];
    __syncthreads();
    {
        const int tq = F.tid >> 7;
        bf16_t* KB = wsp<bf16_t>(F, WS_KB); bf16_t* VT = wsp<bf16_t>(F, WS_VT); float* MT = wsp<float>(F, WS_META);
#pragma unroll
        for (int tt = 0; tt < 4; ++tt) { const int t = 4 * tq + tt;
            const float v = (part[(0 * 128 + c) * 16 + t] + part[(1 * 128 + c) * 16 + t]) + (part[(2 * 128 + c) * 16 + t] + part[(3 * 128 + c) * 16 + t]);
            const bf16_t bv = (bf16_t)(cvtpk(v, 0.f) & 0xffffu);
            if (sec4 == 0) { for (int b = 0; b < NB; ++b) KB[(size_t)(b * TPAD + KPAD + t) * 512 + jc] = bv; }
            else if (sec4 == 1) { for (int b = 0; b < NB; ++b) VT[(size_t)jc * (NB * TPAD) + b * TPAD + KPAD + t] = bv; }
            else if (t >= 14) MT[((sec4 - 2) * 2 + (t - 14)) * 512 + jc] = v;
        }
    }
    __syncthreads();
}
constexpr int CONV_ITEMS_GU = 32 * 8 * 32, CONV_ITEMS_D = 32 * 8 * 16, CONV_ITEMS = CONV_ITEMS_GU + CONV_ITEMS_D;
#ifndef P1_CONV_ITEMS
#define P1_CONV_ITEMS CONV_ITEMS
#endif
__device__ __forceinline__ void convert_expert_item(Frame& F, int it, LAS unsigned* scr) {
    unsigned char* WGU = wsp<unsigned char>(F, WS_WGU); unsigned char* WD = wsp<unsigned char>(F, WS_WD);
    if (it < CONV_ITEMS_GU) { const int e = it / 256, q = it % 256, kb = q / 32, nb = q % 32, n0 = 64 * nb, c = n0 & 1023;
        const int drow = (c >> 7) * 256 + (n0 >= 1024 ? 128 : 0) + (c & 127);
        p0_transpose_item8(F.w_gu + (size_t)e * 1024 * 2048, 2048, 128 * kb, n0, WGU + (size_t)e * 2048 * 1024, DM, drow, scr, F.lane); }
    else { const int r = it - CONV_ITEMS_GU, e = r / 128, q = r % 128, kb = q / 16, nb = q % 16;
        p0_transpose_item8(F.w_down + (size_t)e * 1024 * 1024, 1024, 128 * kb, 64 * nb, WD + (size_t)e * 1024 * 1024, FF, 64 * nb, scr, F.lane); }
}
struct ConvItem { const float* src; unsigned char* dst; int ldw; };
__device__ __forceinline__ ConvItem conv_item(Frame& F, int it, int lane) {
    const int ks = lane >> 4, n4 = lane & 15, ns = lane >> 3, c8 = lane & 7; ConvItem ci;
    if (it < CONV_ITEMS_GU) { const int e = it / 256, q = it % 256, kb = q / 32, nb = q % 32, n0 = 64 * nb, c = n0 & 1023;
        const int drow = (c >> 7) * 256 + (n0 >= 1024 ? 128 : 0) + (c & 127);
        ci.ldw = 2048; ci.src = F.w_gu + (size_t)e * 1024 * 2048 + (size_t)(128 * kb + 4 * ks) * 2048 + n0 + 4 * n4;
        ci.dst = wsp<unsigned char>(F, WS_WGU) + (size_t)e * 2048 * 1024 + (size_t)(drow + ns) * DM + 128 * kb + 16 * c8; }
    else { const int r = it - CONV_ITEMS_GU, e = r / 128, q = r % 128, kb = q / 16, nb = q % 16;
        ci.ldw = 1024; ci.src = F.w_down + (size_t)e * 1024 * 1024 + (size_t)(128 * kb + 4 * ks) * 1024 + 64 * nb + 4 * n4;
        ci.dst = wsp<unsigned char>(F, WS_WD) + (size_t)e * 1024 * 1024 + (size_t)(64 * nb + ns) * FF + 128 * kb + 16 * c8; }
    return ci;
}
#define CONV_LOAD(v, ci, h) do { _Pragma("unroll") for (int i_ = 0; i_ < 4; ++i_) _Pragma("unroll") for (int q_ = 0; q_ < 4; ++q_) \
        v[i_][q_] = *(const f32x4*)((ci).src + (size_t)(64 * (h) + 16 * i_ + q_) * (ci).ldw); } while (0)
#define CONV_PACK(v, h) do { _Pragma("unroll") for (int i_ = 0; i_ < 4; ++i_) _Pragma("unroll") for (int j_ = 0; j_ < 4; ++j_) \
        scr[(4 * n4 + j_) * 33 + 16 * (h) + 4 * i_ + ks] = pk4_fp8(v[i_][0][j_] * WSCALE, v[i_][1][j_] * WSCALE, v[i_][2][j_] * WSCALE, v[i_][3][j_] * WSCALE); } while (0)
__device__ __forceinline__ void convert_experts(Frame& F, int wv, int nw) {
    LAS unsigned* scr = (LAS unsigned*)(F.lds + F.wave * 8704);
    const int lane = F.lane, ks = lane >> 4, n4 = lane & 15, ns = lane >> 3, c8 = lane & 7;
    int it = wv; if (it >= P1_CONV_ITEMS) return;
    ConvItem cur = conv_item(F, it, lane);
    f32x4 va[4][4], vb[4][4];
    CONV_LOAD(va, cur, 0);
    for (;;) {
        CONV_LOAD(vb, cur, 1);
        CONV_PACK(va, 0);
        const int itn = it + nw; const bool more = itn < P1_CONV_ITEMS;
        ConvItem nxt = cur; if (more) { nxt = conv_item(F, itn, lane); CONV_LOAD(va, nxt, 0); }
        CONV_PACK(vb, 1);
        LDS_WAIT(); asm volatile("" ::: "memory");
#pragma unroll
        for (int r = 0; r < 8; ++r) { const LAS unsigned* t = scr + (8 * r + ns) * 33 + 4 * c8;
            u32x4 o; o.x = t[0]; o.y = t[1]; o.z = t[2]; o.w = t[3];
            *(u32x4*)(cur.dst + (size_t)(8 * r) * (it < CONV_ITEMS_GU ? DM : FF)) = o; }
        LDS_WAIT(); asm volatile("" ::: "memory");
        if (!more) break;
        cur = nxt; it = itn;
    }
}
#undef CONV_LOAD
#undef CONV_PACK

__device__ __forceinline__ void p0_prologue(Frame& F) {
    constexpr int NMW = 16;
    if (F.vcu < NMW) {
        p0_meta_job(F, F.vcu);
        bf16_t* KB = wsp<bf16_t>(F, WS_KB); bf16_t* VT = wsp<bf16_t>(F, WS_VT);
        const int gt = F.vcu * 512 + F.tid, NT = NMW * 512;
        for (int i = gt; i < NB * KPAD * 64; i += NT) { const int b = i / (KPAD * 64), r = i % (KPAD * 64); *(u32x4*)(KB + (size_t)(b * TPAD) * 512 + (size_t)r * 8) = (u32x4){0u, 0u, 0u, 0u}; }
        for (int i = gt; i < 512 * NB * 6; i += NT) { const int ch = i / (NB * 6), r = i % (NB * 6), b = r / 6, q = r % 6; *(u32x4*)(VT + (size_t)ch * (NB * TPAD) + b * TPAD + q * 8) = (u32x4){0u, 0u, 0u, 0u}; }
        return;
    }
    const int gw = (F.vcu - NMW) * NWAVES + F.wave, NGW = (F.G - NMW) * NWAVES;
    {
        float* rstd1 = wsp<float>(F, WS_RSTD1); bf16_t* A1 = wsp<bf16_t>(F, WS_A);
        f32x4 g4[4];
#pragma unroll
        for (int j = 0; j < 4; ++j) g4[j] = *(const f32x4*)(F.g_mix + 256 * j + 4 * F.lane);
        for (int m = gw; m < NTOK; m += NGW) {
            const f32x4* xr = (const f32x4*)(F.x + (size_t)m * DM) + F.lane;
            f32x4 v[4]; float s = 0.f;
#pragma unroll
            for (int j = 0; j < 4; ++j) { v[j] = xr[64 * j]; s += (v[j][0] * v[j][0] + v[j][1] * v[j][1]) + (v[j][2] * v[j][2] + v[j][3] * v[j][3]); }
            s = wave_sum(s);
            if (F.lane == 0) rstd1[m] = 1.0f / sqrtf(s * (1.0f / DM) + RMS_EPS);
            u32x2* o8 = (u32x2*)(A1 + (size_t)m * DM) + F.lane;
#pragma unroll
            for (int j = 0; j < 4; ++j) { const f32x4 a = v[j] * g4[j]; u32x2 o; o.x = cvtpk(a[0], a[1]); o.y = cvtpk(a[2], a[3]); o8[64 * j] = o; }
        }
    }
    {
        LAS unsigned* scr = (LAS unsigned*)(F.lds + F.wave * 8704);
        constexpr int I_IN = 16 * 48, I_OUT = 16 * 16, I_X = CONV_IN_P1 ? (32 * 8 * 48 - P1_CONV_ITEMS) : 32 * 8 * 48, NITEMS = I_IN + I_OUT + I_X;
        bf16_t* WIN = wsp<bf16_t>(F, WS_WIN); bf16_t* WOUT = wsp<bf16_t>(F, WS_WOUT); unsigned char* WGU = wsp<unsigned char>(F, WS_WGU); unsigned char* WD = wsp<unsigned char>(F, WS_WD);
        for (int it = gw; it < NITEMS; it += NGW) {
            int r = it;
            if (r < I_IN) { const int kb = r / 48, nb = r % 48, n0 = 64 * nb, sec = n0 >> 9;
                const int dsec = sec == 0 ? 0 : sec == 1 ? 1 : sec == 2 ? 5 : sec - 1;
                p0_transpose_item(F.w_in, 3072, 64 * kb, n0, WIN, DM, dsec * 512 + (n0 & 511), scr, F.lane); continue; }
            r -= I_IN;
            if (r < I_OUT) { const int kb = r / 16, nb = r % 16; p0_transpose_item(F.w_out, 1024, 64 * kb, 64 * nb, WOUT, DM, 64 * nb, scr, F.lane); continue; }
            r -= I_OUT;
            convert_expert_item(F, (CONV_IN_P1 ? P1_CONV_ITEMS : 0) + r, scr);
        }
    }
}
template <bool EDGE>
__device__ __forceinline__ void sb_tile(f32x16& s0, f32x16& s1, float& carry, int kp0  , int qpos, bool hi0, bf16x8 (&pf)[2][2]) {
    float R[4];
#pragma unroll
    for (int q = 0; q < 4; ++q) {
        float S = 1.0f;
#pragma unroll
        for (int i = 7; i >= 0; --i) {
            const int r = (q & 1) * 8 + i;
            const float z = fminf((q < 2) ? s0[r] : s1[r], 100.0f);
            const float e = ex2(z);
            float kp_ = __builtin_amdgcn_rcpf(1.0f + e);
            float sg = e * kp_;
            if (EDGE) { const int kp = kp0 + 16 * q + i; const bool valid = (kp < qpos) && (kp >= KPAD); kp_ = valid ? kp_ : 1.0f; sg = valid ? sg : 0.0f; }
            const float m = sg * S; S *= kp_;
            if (q < 2) s0[r] = m; else s1[r] = m;
        }
        R[q] = S;
        __builtin_amdgcn_sched_barrier(0);
    }
    const float P0 = __shfl_xor(R[0], 32), P1 = __shfl_xor(R[1], 32), P2 = __shfl_xor(R[2], 32), P3 = __shfl_xor(R[3], 32);
    const float T1 = R[1] * P1, T2 = R[2] * P2, T3 = R[3] * P3, T0 = R[0] * P0;
    const float b3 = carry * (hi0 ? P3 : 1.0f), b2 = carry * (T3 * (hi0 ? P2 : 1.0f)), b1 = carry * ((T3 * T2) * (hi0 ? P1 : 1.0f)), b0 = carry * ((T3 * T2 * T1) * (hi0 ? P0 : 1.0f));
#pragma unroll
    for (int i = 0; i < 8; ++i) { s0[i] *= b0; s0[8 + i] *= b1; s1[i] *= b2; s1[8 + i] *= b3; }
    carry *= (T0 * T1) * (T2 * T3);
    u32x4 w;
    w.x = cvtpk(s0[0], s0[1]); w.y = cvtpk(s0[2], s0[3]); w.z = cvtpk(s0[4], s0[5]); w.w = cvtpk(s0[6], s0[7]); pf[0][0] = __builtin_bit_cast(bf16x8, w);
    w.x = cvtpk(s0[8], s0[9]); w.y = cvtpk(s0[10], s0[11]); w.z = cvtpk(s0[12], s0[13]); w.w = cvtpk(s0[14], s0[15]); pf[0][1] = __builtin_bit_cast(bf16x8, w);
    w.x = cvtpk(s1[0], s1[1]); w.y = cvtpk(s1[2], s1[3]); w.z = cvtpk(s1[4], s1[5]); w.w = cvtpk(s1[6], s1[7]); pf[1][0] = __builtin_bit_cast(bf16x8, w);
    w.x = cvtpk(s1[8], s1[9]); w.y = cvtpk(s1[10], s1[11]); w.z = cvtpk(s1[12], s1[13]); w.w = cvtpk(s1[14], s1[15]); pf[1][1] = __builtin_bit_cast(bf16x8, w);
}
template <bool EDGE>
__device__ __forceinline__ void sb_tile32(f32x16& s0, float& carry, int kp0  , int qpos, bool hi0, bf16x8 (&pf)[2]) {
    float R[2];
#pragma unroll
    for (int q = 0; q < 2; ++q) {
        float S = 1.0f;
#pragma unroll
        for (int i = 7; i >= 0; --i) {
            const int r = q * 8 + i;
            const float z = fminf(s0[r], 100.0f);
            const float e = ex2(z);
            float kp_ = __builtin_amdgcn_rcpf(1.0f + e);
            float sg = e * kp_;
            if (EDGE) { const int kp = kp0 + 16 * q + i; const bool valid = (kp < qpos) && (kp >= KPAD); kp_ = valid ? kp_ : 1.0f; sg = valid ? sg : 0.0f; }
            s0[r] = sg * S; S *= kp_;
        }
        R[q] = S;
    }
    const float P0 = __shfl_xor(R[0], 32), P1 = __shfl_xor(R[1], 32);
    const float T0 = R[0] * P0, T1 = R[1] * P1;
    const float b1 = carry * (hi0 ? P1 : 1.0f), b0 = carry * (T1 * (hi0 ? P0 : 1.0f));
#pragma unroll
    for (int i = 0; i < 8; ++i) { s0[i] *= b0; s0[8 + i] *= b1; }
    carry *= T0 * T1;
    u32x4 w;
    w.x = cvtpk(s0[0], s0[1]); w.y = cvtpk(s0[2], s0[3]); w.z = cvtpk(s0[4], s0[5]); w.w = cvtpk(s0[6], s0[7]); pf[0] = __builtin_bit_cast(bf16x8, w);
    w.x = cvtpk(s0[8], s0[9]); w.y = cvtpk(s0[10], s0[11]); w.z = cvtpk(s0[12], s0[13]); w.w = cvtpk(s0[14], s0[15]); pf[1] = __builtin_bit_cast(bf16x8, w);
}
#define MFMA32(a, b, c) __builtin_amdgcn_mfma_f32_32x32x16_bf16((a), (b), (c), 0, 0, 0)
#define P2_LDS_BARRIER() do { asm volatile("s_waitcnt lgkmcnt(0)" ::: "memory"); __builtin_amdgcn_s_barrier(); asm volatile("" ::: "memory"); } while (0)
template <bool DO_CONV, bool DO_ATT, bool PROBE = false>
__device__ __forceinline__ void p2_unit(Frame& F, int b, int qb) {
    int lane_ = F.lane, head_ = F.wave;
    asm volatile("" : "+v"(lane_), "+s"(head_));
    const int lane = lane_, head = head_, l31 = lane & 31, hi = lane >> 5; const bool hi0 = hi == 0;
    const bf16_t* Q = wsp<bf16_t>(F, WS_Q); const bf16_t* KB = wsp<bf16_t>(F, WS_KB); const bf16_t* VT = wsp<bf16_t>(F, WS_VT);
    bf16_t* MX = wsp<bf16_t>(F, PROBE ? WS_YS : WS_MIXED);
    LAS float* ssA = (LAS float*)(F.lds + P2_SS_OFF);
    LAS float* ssC = (LAS float*)(F.lds + P2_SS_OFF + 2048);
    const int row0 = b * SEQ + qb * 64;
    const int pi = (l31 & 0x13) | ((l31 & 4) << 1) | ((l31 & 8) >> 1);
    const __amdgpu_buffer_rsrc_t rsK = __builtin_amdgcn_make_buffer_rsrc((void*)(KB + (size_t)b * TPAD * 512), (short)0, TPAD * 512 * 2, 0x00020000);
    const __amdgpu_buffer_rsrc_t rsV = __builtin_amdgcn_make_buffer_rsrc((void*)(VT + (size_t)b * TPAD), (short)0, (511 * NB * TPAD + TPAD) * 2, 0x00020000);
    const int voffK = (pi * 512 + head * 64 + hi * 8) * 2;
    const int voffV0 = ((head * 64 + l31) * (NB * TPAD) + hi * 8) * 2, voffV1 = voffV0 + 32 * NB * TPAD * 2;
    LAS unsigned char* kbuf = F.lds + head * 16384; LAS unsigned char* vbuf = kbuf + 8192;
    const int P0 = QOFF + 64 * qb, qpos = P0 + l31, NT = (P0 >> 5) + 1;
#define ATT_DMA_K(st, pp) do { \
        __builtin_amdgcn_raw_ptr_buffer_load_lds(rsK, (LAS void*)(kbuf + (pp) * 4096 + 0 * 1024), 16, voffK, (st) * 1024 + 0, 0, 0); \
        __builtin_amdgcn_raw_ptr_buffer_load_lds(rsK, (LAS void*)(kbuf + (pp) * 4096 + 1 * 1024), 16, voffK, (st) * 1024 + 32, 0, 0); \
        __builtin_amdgcn_raw_ptr_buffer_load_lds(rsK, (LAS void*)(kbuf + (pp) * 4096 + 2 * 1024), 16, voffK, (st) * 1024 + 64, 0, 0); \
        __builtin_amdgcn_raw_ptr_buffer_load_lds(rsK, (LAS void*)(kbuf + (pp) * 4096 + 3 * 1024), 16, voffK, (st) * 1024 + 96, 0, 0); } while (0)
#define ATT_DMA_V(st, pp) do { \
        __builtin_amdgcn_raw_ptr_buffer_load_lds(rsV, (LAS void*)(vbuf + (pp) * 4096 + 0 * 1024), 16, voffV0, (st) * 2 + 0, 0, 0); \
        __builtin_amdgcn_raw_ptr_buffer_load_lds(rsV, (LAS void*)(vbuf + (pp) * 4096 + 1 * 1024), 16, voffV0, (st) * 2 + 32, 0, 0); \
        __builtin_amdgcn_raw_ptr_buffer_load_lds(rsV, (LAS void*)(vbuf + (pp) * 4096 + 2 * 1024), 16, voffV1, (st) * 2 + 0, 0, 0); \
        __builtin_amdgcn_raw_ptr_buffer_load_lds(rsV, (LAS void*)(vbuf + (pp) * 4096 + 3 * 1024), 16, voffV1, (st) * 2 + 32, 0, 0); } while (0)
#define ATT_WAIT_VM(n) do { if ((n) >= 12) asm volatile("s_waitcnt vmcnt(12)" ::: "memory"); else if ((n) == 8) asm volatile("s_waitcnt vmcnt(8)" ::: "memory"); \
        else if ((n) == 4) asm volatile("s_waitcnt vmcnt(4)" ::: "memory"); else asm volatile("s_waitcnt vmcnt(0)" ::: "memory"); } while (0)
    bf16x8 qf[2][4];
    if constexpr (DO_ATT) {
        asm volatile("s_waitcnt lgkmcnt(0)" ::: "memory");
        ATT_DMA_K(P0 + 32, 0); ATT_DMA_V(P0 + 32, 0); ATT_DMA_K(P0, 1); ATT_DMA_V(P0, 1);
        const bf16_t* Qp = Q + (size_t)(row0 + l31) * 512 + head * 64 + hi * 8;
#pragma unroll
        for (int q2 = 0; q2 < 2; ++q2)
#pragma unroll
            for (int s = 0; s < 4; ++s) qf[q2][s] = *(const bf16x8*)(Qp + (size_t)q2 * 32 * 512 + s * 16);
    }
    if constexpr (DO_CONV) {
        const int cgp = lane & 7, rg = lane >> 3, ch0 = head * 64 + cgp * 8;
        const bf16_t* CB = wsp<bf16_t>(F, WS_CB); const bf16_t* CC = wsp<bf16_t>(F, WS_CC); const bf16_t* CX = wsp<bf16_t>(F, WS_CX); const float* MT = wsp<float>(F, WS_META);
        float cv[8][8];
        {
            float w0[8], w1[8], w2[8], bs[8], u2[8], u1[8];
#pragma unroll
            for (int k = 0; k < 8; ++k) { w0[k] = F.conv_w[ch0 + k]; w1[k] = F.conv_w[512 + ch0 + k]; w2[k] = F.conv_w[1024 + ch0 + k]; bs[k] = F.conv_b[ch0 + k]; u2[k] = 0.f; u1[k] = 0.f; }
            float um[2][8];
#pragma unroll
            for (int t = 0; t < 2; ++t)
#pragma unroll
                for (int k = 0; k < 8; ++k) um[t][k] = 0.f;
            if (qb == 0) {
#pragma unroll
                for (int t = 0; t < 2; ++t) { const f32x4 c0 = *(const f32x4*)(MT + t * 512 + ch0), c1 = *(const f32x4*)(MT + t * 512 + ch0 + 4), x0 = *(const f32x4*)(MT + (2 + t) * 512 + ch0), x1 = *(const f32x4*)(MT + (2 + t) * 512 + ch0 + 4);
#pragma unroll
                    for (int k = 0; k < 4; ++k) { um[t][k] = c0[k] * x0[k]; um[t][4 + k] = c1[k] * x1[k]; } }
            }
            u32x4 c4[10], x4[10], b4[8];
#pragma unroll
            for (int i = 0; i < 10; ++i) { const int sl = qb * 64 + rg * 8 + i - 2; const size_t ro = (size_t)(b * SEQ + (sl < 0 ? 0 : sl)) * 512 + ch0;
                c4[i] = *(const u32x4*)(CC + ro); x4[i] = *(const u32x4*)(CX + ro); }
#pragma unroll
            for (int i = 0; i < 8; ++i) b4[i] = *(const u32x4*)(CB + (size_t)(b * SEQ + qb * 64 + rg * 8 + i) * 512 + ch0);
#pragma unroll
            for (int i = 0; i < 10; ++i) {
                const int ri = i - 2;
                const int sl = qb * 64 + rg * 8 + ri;
                float u[8];
                u[0] = bflo(c4[i].x) * bflo(x4[i].x); u[1] = bfhi(c4[i].x) * bfhi(x4[i].x); u[2] = bflo(c4[i].y) * bflo(x4[i].y); u[3] = bfhi(c4[i].y) * bfhi(x4[i].y);
                u[4] = bflo(c4[i].z) * bflo(x4[i].z); u[5] = bfhi(c4[i].z) * bfhi(x4[i].z); u[6] = bflo(c4[i].w) * bflo(x4[i].w); u[7] = bfhi(c4[i].w) * bfhi(x4[i].w);
                if (ri < 0) {
#pragma unroll
                    for (int k = 0; k < 8; ++k) u[k] = (sl < 0) ? um[ri + 2][k] : u[k];
                } else {
                    const u32x4 bb = b4[ri];
                    const float cbv[8] = {bflo(bb.x), bfhi(bb.x), bflo(bb.y), bfhi(bb.y), bflo(bb.z), bfhi(bb.z), bflo(bb.w), bfhi(bb.w)};
#pragma unroll
                    for (int k = 0; k < 8; ++k) cv[ri][k] = cbv[k] * (w0[k] * u2[k] + w1[k] * u1[k] + w2[k] * u[k] + bs[k]);
                }
#pragma unroll
                for (int k = 0; k < 8; ++k) { u2[k] = u1[k]; u1[k] = u[k]; }
            }
        }
#pragma unroll
        for (int i = 0; i < 8; ++i) { float ss = 0.f;
#pragma unroll
            for (int k = 0; k < 8; ++k) ss += cv[i][k] * cv[i][k];
            ss += __shfl_xor(ss, 1); ss += __shfl_xor(ss, 2); ss += __shfl_xor(ss, 4);
            if (cgp == 0) ssC[head * 64 + rg * 8 + i] = ss; }
        P2_LDS_BARRIER();
        const f32x4 gc0 = *(const f32x4*)(F.g_conv + ch0), gc1 = *(const f32x4*)(F.g_conv + ch0 + 4);
#pragma unroll
        for (int i = 0; i < 8; ++i) { const int rl = rg * 8 + i; float tot = 0.f;
#pragma unroll
            for (int w = 0; w < 8; ++w) tot += ssC[w * 64 + rl];
            const float rstd = 1.0f / sqrtf(tot * (1.0f / AW) + RMS_EPS);
            u32x4 w4; w4.x = cvtpk(cv[i][0] * rstd * gc0[0], cv[i][1] * rstd * gc0[1]); w4.y = cvtpk(cv[i][2] * rstd * gc0[2], cv[i][3] * rstd * gc0[3]);
            w4.z = cvtpk(cv[i][4] * rstd * gc1[0], cv[i][5] * rstd * gc1[1]); w4.w = cvtpk(cv[i][6] * rstd * gc1[2], cv[i][7] * rstd * gc1[3]);
            *(u32x4*)(MX + (size_t)(row0 + rl) * DM + 512 + ch0) = w4; }
    }
    if constexpr (DO_ATT) {
    f32x16 o[2][2];
#pragma unroll
    for (int d = 0; d < 2; ++d)
#pragma unroll
        for (int q2 = 0; q2 < 2; ++q2)
#pragma unroll
            for (int r = 0; r < 16; ++r) o[d][q2][r] = 0.f;
    float carry0 = 1.0f, carry1 = 1.0f;
    if constexpr (DO_CONV) asm volatile("s_waitcnt vmcnt(8)" ::: "memory"); else asm volatile("s_waitcnt vmcnt(0)" ::: "memory");
    for (int t = 0; ; ++t) {
        const int start = P0 + 32 - 32 * t, pp = t & 1;
        const bool lastt = (t == NT - 1), e1 = (t + 1 < NT), e2 = (t + 2 < NT);
        ATT_WAIT_VM(4 + (e1 ? 8 : 0));
        bf16x8 kf[4];
#pragma unroll
        for (int i = 0; i < 4; ++i) kf[i] = *(const LAS bf16x8*)(kbuf + pp * 4096 + i * 1024 + lane * 16);
        asm volatile("s_waitcnt lgkmcnt(0)" ::: "memory");
        if (e2) ATT_DMA_K(start - 64, pp);
#pragma unroll
        for (int q2 = 0; q2 < 2; ++q2) {
            if (q2 == 0 && t == 0) continue;
            f32x16 s0;
#pragma unroll
            for (int r = 0; r < 16; ++r) s0[r] = 0.f;
#pragma unroll
            for (int s4 = 0; s4 < 4; ++s4) s0 = MFMA32(kf[s4], qf[q2][s4], s0);
            bf16x8 pf[2];
            float& carry = q2 ? carry1 : carry0;
            const bool edge = (start == P0 + 32 * q2) || lastt;
#ifdef PROBE_NOSB
            if (PROBE) { u32x4 w_; w_.x = cvtpk(s0[0], s0[1]); w_.y = cvtpk(s0[2], s0[3]); w_.z = cvtpk(s0[4], s0[5]); w_.w = cvtpk(s0[6], s0[7]); pf[0] = __builtin_bit_cast(bf16x8, w_); pf[1] = pf[0]; carry *= 0.5f; } else
#endif
            if (edge) sb_tile32<true>(s0, carry, start + 8 * hi, qpos + 32 * q2, hi0, pf);
            else sb_tile32<false>(s0, carry, start + 8 * hi, qpos + 32 * q2, hi0, pf);
            if (q2 == 0 || t == 0) ATT_WAIT_VM((e1 ? 8 : 0) + (e2 ? 4 : 0));
            bf16x8 vf[4];
#pragma unroll
            for (int i = 0; i < 4; ++i) vf[i] = *(const LAS bf16x8*)(vbuf + pp * 4096 + i * 1024 + lane * 16);
#pragma unroll
            for (int d = 0; d < 2; ++d)
#pragma unroll
                for (int s2 = 0; s2 < 2; ++s2) o[d][q2] = MFMA32(vf[d * 2 + s2], pf[s2], o[d][q2]);
        }
#ifdef PROBE_MAXT
        if (PROBE && t >= PROBE_MAXT - 1) break;
#endif
        if (lastt || __all((carry0 < EXIT_THR) && (carry1 < EXIT_THR))) break;
        asm volatile("s_waitcnt lgkmcnt(0)" ::: "memory");
        if (e2) ATT_DMA_V(start - 64, pp);
    }
    asm volatile("s_waitcnt vmcnt(0)" ::: "memory");
    int lane2 = lane; asm volatile("" : "+v"(lane2));
    const int l31b = lane2 & 31, hib = lane2 >> 5;
#pragma unroll
    for (int q2 = 0; q2 < 2; ++q2) {
        float ss = 0.f;
#pragma unroll
        for (int d = 0; d < 2; ++d)
#pragma unroll
            for (int r = 0; r < 16; ++r) ss += o[d][q2][r] * o[d][q2][r];
        ss += __shfl_xor(ss, 32);
        if (hib == 0) ssA[head * 64 + q2 * 32 + l31b] = ss;
    }
    P2_LDS_BARRIER();
    {
        LAS unsigned char* obuf = F.lds + head * 16384;
#pragma unroll
        for (int q2 = 0; q2 < 2; ++q2) {
            const int rl = q2 * 32 + l31b; float tot = 0.f;
#pragma unroll
            for (int h = 0; h < 8; ++h) tot += ssA[h * 64 + rl];
            const float rstd = 1.0f / sqrtf(tot * (1.0f / AW) + RMS_EPS);
#pragma unroll
            for (int d = 0; d < 2; ++d)
#pragma unroll
                for (int g = 0; g < 4; ++g) { const f32x4 ga = *(const f32x4*)(F.g_attn + head * 64 + 32 * d + 8 * g + 4 * hib);
                    u32x2 w; w.x = cvtpk(o[d][q2][4 * g] * rstd * ga[0], o[d][q2][4 * g + 1] * rstd * ga[1]); w.y = cvtpk(o[d][q2][4 * g + 2] * rstd * ga[2], o[d][q2][4 * g + 3] * rstd * ga[3]);
                    *(LAS u32x2*)(obuf + rl * 144 + (32 * d + 8 * g + 4 * hib) * 2) = w; }
        }
        asm volatile("s_waitcnt lgkmcnt(0)" ::: "memory");
#pragma unroll
        for (int k = 0; k < 8; ++k) { const int rr = 8 * k + (lane2 >> 3), ch = lane2 & 7;
            const u32x4 v = *(const LAS u32x4*)(obuf + rr * 144 + ch * 16);
            *(u32x4*)(MX + (size_t)(row0 + rr) * DM + head * 64 + ch * 8) = v; }
    }
    if constexpr (!DO_CONV) P2_LDS_BARRIER();
    }
#undef ATT_DMA_K
#undef ATT_DMA_V
#undef ATT_WAIT_VM
}

__device__ __forceinline__ void p4_router(Frame& F) {
    LAS unsigned char* img = F.lds;
    LAS int* hist = (LAS int*)(F.lds + 65536);
    for (int idx = F.tid; idx < 64 * 2 * 32; idx += 512) { const int s = idx >> 6, h = (idx >> 5) & 1, e = idx & 31; const int k0 = 16 * s + 8 * h; const float* wp = F.w_router + (size_t)k0 * NE + e; const float* gp = F.g_ffn + k0;
        u32x4 w; w.x = cvtpk(wp[0] * gp[0], wp[NE] * gp[1]); w.y = cvtpk(wp[2 * NE] * gp[2], wp[3 * NE] * gp[3]); w.z = cvtpk(wp[4 * NE] * gp[4], wp[5 * NE] * gp[5]); w.w = cvtpk(wp[6 * NE] * gp[6], wp[7 * NE] * gp[7]);
        *(LAS u32x4*)(img + idx * 16) = w; }
    if (F.tid < 32) hist[F.tid] = 0;
    __syncthreads();
    const bf16_t* A2 = wsp<bf16_t>(F, WS_A); float* rstd2 = wsp<float>(F, WS_RSTD2);
    int* tope = wsp<int>(F, WS_TOPE); float* gate = wsp<float>(F, WS_GATE); int* cnt = wsp<int>(F, WS_CNT);
    const int wg = F.vcu;
    if (F.wave < 4) {
        const int l31 = F.lane & 31, hi = F.lane >> 5, row = wg * 128 + F.wave * 32 + l31;
        f32x16 acc;
#pragma unroll
        for (int r = 0; r < 16; ++r) acc[r] = 0.f;
        const bf16_t* ap = A2 + (size_t)row * DM + 8 * hi;
        float ss = 0.f;
#pragma unroll 8
        for (int s = 0; s < 64; ++s) { const bf16x8 a = *(const LAS bf16x8*)(img + ((s * 2 + hi) * 32 + l31) * 16); const bf16x8 bq = *(const bf16x8*)(ap + 16 * s); acc = MFMA32(a, bq, acc);
            const u32x4 bu = __builtin_bit_cast(u32x4, bq);
            const float f0 = bflo(bu.x), f1 = bfhi(bu.x), f2 = bflo(bu.y), f3 = bfhi(bu.y), f4 = bflo(bu.z), f5 = bfhi(bu.z), f6 = bflo(bu.w), f7 = bfhi(bu.w);
            ss += ((f0 * f0 + f1 * f1) + (f2 * f2 + f3 * f3)) + ((f4 * f4 + f5 * f5) + (f6 * f6 + f7 * f7)); }
        ss += __shfl_xor(ss, 32);
        const float rstd = 1.0f / sqrtf(ss * (1.0f / DM) + RMS_EPS);
        float lg[16];
#pragma unroll
        for (int r = 0; r < 16; ++r) lg[r] = acc[r] * rstd + F.b_router[(r & 3) + 8 * (r >> 2) + 4 * hi];
        float cvv[8]; int cei[8];
#pragma unroll
        for (int k = 0; k < 4; ++k) { float best = -INFINITY; int bi = 0;
#pragma unroll
            for (int r = 0; r < 16; ++r) { const bool gtb = lg[r] > best; best = gtb ? lg[r] : best; bi = gtb ? r : bi; }
#pragma unroll
            for (int r = 0; r < 16; ++r) lg[r] = (r == bi) ? -INFINITY : lg[r];
            cvv[k] = best; cei[k] = (bi & 3) + 8 * (bi >> 2) + 4 * hi; }
#pragma unroll
        for (int k = 0; k < 4; ++k) { cvv[4 + k] = __shfl_xor(cvv[k], 32); cei[4 + k] = __shfl_xor(cei[k], 32); }
        float tv[4]; int te[4];
#pragma unroll
        for (int k = 0; k < 4; ++k) { float best = -INFINITY; int be = 1 << 30, bi = 0;
#pragma unroll
            for (int c = 0; c < 8; ++c) { const bool better = (cvv[c] > best) || (cvv[c] == best && cei[c] < be); best = better ? cvv[c] : best; be = better ? cei[c] : be; bi = better ? c : bi; }
#pragma unroll
            for (int c = 0; c < 8; ++c) { const bool hit = (c == bi); cvv[c] = hit ? -INFINITY : cvv[c]; cei[c] = hit ? (1 << 30) : cei[c]; }
            tv[k] = best; te[k] = be; }
        const float e1 = ex2((tv[1] - tv[0]) * LOG2E), e2 = ex2((tv[2] - tv[0]) * LOG2E), e3 = ex2((tv[3] - tv[0]) * LOG2E);
        const float inv = 1.0f / (1.0f + e1 + e2 + e3);
        if (hi == 0) {
            rstd2[row] = rstd;
            *(i32x4*)(tope + (size_t)row * 4) = (i32x4){te[0], te[1], te[2], te[3]};
            *(f32x4*)(gate + (size_t)row * 4) = (f32x4){inv, e1 * inv, e2 * inv, e3 * inv};
#pragma unroll
            for (int k = 0; k < 4; ++k) atomicAdd((int*)(hist + te[k]), 1);
        }
    }
    __syncthreads();
    if (F.tid < 32) cnt[wg * 32 + F.tid] = hist[F.tid];
    __syncthreads();
}

__device__ __forceinline__ void p5_scatter(Frame& F) {
    LAS int* tot = (LAS int*)F.lds; LAS int* pre = tot + 32; LAS int* ctr = tot + 64; LAS int* pstart = tot + 96;
    const int* cnt = wsp<int>(F, WS_CNT); const int wg = F.vcu;
    if (F.tid < 64) tot[F.tid] = 0;
    __syncthreads();
    { const int e = F.tid & 31, j = F.tid >> 5; int t = 0, p = 0;
        for (int w = j; w < 256; w += 16) { const int c = ld_i(cnt + w * 32 + e); t += c; p += (w < wg) ? c : 0; }
        atomicAdd((int*)(tot + e), t); atomicAdd((int*)(pre + e), p); }
    __syncthreads();
    if (F.tid == 0) { int run = 0; for (int e = 0; e < 32; ++e) { pstart[e] = run; run += (tot[e] + 255) & ~255; } pstart[32] = run; }
    __syncthreads();
    if (F.tid < 32) ctr[F.tid] = pstart[F.tid] + pre[F.tid];
    int* slot_tok = wsp<int>(F, WS_SLOTTOK); float* slot_gate = wsp<float>(F, WS_SLOTGATE); float* slot_rstd = wsp<float>(F, WS_SLOTRSTD);
    int* tile_e = wsp<int>(F, WS_TILEE);
    if (wg == 0) {
        if (F.tid < 32) { for (int rt = pstart[F.tid] >> 8; rt < (pstart[F.tid + 1] >> 8); ++rt) tile_e[rt] = F.tid; }
        if (F.tid == 0) tile_e[CAP_TILES] = pstart[32] >> 8;
        if (F.tid < 33) tile_e[CAP_TILES + 1 + F.tid] = pstart[F.tid] >> 8;
    }
    if (wg < 32) { const int e = wg; for (int s = pstart[e] + tot[e] + F.tid; s < pstart[e + 1]; s += 512) { slot_tok[s] = 0; slot_gate[s] = 0.f; slot_rstd[s] = 0.f; } }
    __syncthreads();
    { const int tok = wg * 128 + (F.tid >> 2), k = F.tid & 3;
        const int e = ld_i(wsp<int>(F, WS_TOPE) + tok * 4 + k);
        const int slot = atomicAdd((int*)(ctr + e), 1);
        slot_tok[slot] = tok; slot_gate[slot] = ld_f(wsp<float>(F, WS_GATE) + tok * 4 + k); slot_rstd[slot] = ld_f(wsp<float>(F, WS_RSTD2) + tok);
        wsp<int>(F, WS_TOKSLOT)[tok * 4 + k] = slot; }
    __syncthreads();
}

__device__ __forceinline__ void p8_combine(Frame& F, float* dst) {
    const int gw = F.vcu * NWAVES + F.wave, NGW = F.G * NWAVES;
    const unsigned char* ys = wsp<unsigned char>(F, WS_YS); const int* tokslot = wsp<int>(F, WS_TOKSLOT); const bf16_t* H1 = wsp<bf16_t>(F, WS_A);
    f32x4 gf[2][2];
#pragma unroll
    for (int j = 0; j < 2; ++j) { gf[j][0] = *(const f32x4*)(F.g_final + 512 * j + 8 * F.lane); gf[j][1] = *(const f32x4*)(F.g_final + 512 * j + 8 * F.lane + 4); }
    for (int m0 = gw; m0 < NTOK; m0 += 16 * NGW) {
        const int mrow = m0 + (F.lane >> 2) * NGW;
        const int myslot = (mrow < NTOK) ? ld_i(tokslot + (size_t)mrow * 4 + (F.lane & 3)) : 0;
#pragma unroll 1
        for (int r = 0; r < 16; r += 2) {
            const int ma = m0 + r * NGW, mb = ma + NGW;
            if (ma >= NTOK) break;
            const bool hasb = mb < NTOK; const int mbb = hasb ? mb : ma;
            int sa[4], sb[4];
#pragma unroll
            for (int k = 0; k < 4; ++k) { sa[k] = __builtin_amdgcn_readfirstlane(__shfl(myslot, 4 * r + k)); sb[k] = __builtin_amdgcn_readfirstlane(__shfl(myslot, 4 * r + 4 + k)); }
            u32x4 ha[2], hb[2]; u32x2 ya[2][4], yb[2][4];
#pragma unroll
            for (int j = 0; j < 2; ++j) { ha[j] = *(const u32x4*)(H1 + (size_t)ma * DM + 512 * j + 8 * F.lane); hb[j] = *(const u32x4*)(H1 + (size_t)mbb * DM + 512 * j + 8 * F.lane);
#pragma unroll
                for (int k = 0; k < 4; ++k) { ya[j][k] = *(const u32x2*)(ys + (size_t)sa[k] * DM + 512 * j + 8 * F.lane); yb[j][k] = *(const u32x2*)(ys + (size_t)sb[k] * DM + 512 * j + 8 * F.lane); } }
            f32x4 va[2][2], vb[2][2]; float ssa = 0.f, ssb = 0.f;
#pragma unroll
            for (int j = 0; j < 2; ++j) {
                f32x4 ea0 = {0.f, 0.f, 0.f, 0.f}, ea1 = ea0, eb0 = ea0, eb1 = ea0;
#pragma unroll
                for (int k = 0; k < 4; ++k) { const u32x2 y = ya[j][k], z = yb[j][k];
                    const f32x2 y0 = fp8lo(y.x), y1 = fp8hi(y.x), y2 = fp8lo(y.y), y3 = fp8hi(y.y), z0 = fp8lo(z.x), z1 = fp8hi(z.x), z2 = fp8lo(z.y), z3 = fp8hi(z.y);
                    ea0[0] += y0[0]; ea0[1] += y0[1]; ea0[2] += y1[0]; ea0[3] += y1[1]; ea1[0] += y2[0]; ea1[1] += y2[1]; ea1[2] += y3[0]; ea1[3] += y3[1];
                    eb0[0] += z0[0]; eb0[1] += z0[1]; eb0[2] += z1[0]; eb0[3] += z1[1]; eb1[0] += z2[0]; eb1[1] += z2[1]; eb1[2] += z3[0]; eb1[3] += z3[1]; }
                va[j][0] = (f32x4){bflo(ha[j].x), bfhi(ha[j].x), bflo(ha[j].y), bfhi(ha[j].y)} + ea0 * YINV; va[j][1] = (f32x4){bflo(ha[j].z), bfhi(ha[j].z), bflo(ha[j].w), bfhi(ha[j].w)} + ea1 * YINV;
                vb[j][0] = (f32x4){bflo(hb[j].x), bfhi(hb[j].x), bflo(hb[j].y), bfhi(hb[j].y)} + eb0 * YINV; vb[j][1] = (f32x4){bflo(hb[j].z), bfhi(hb[j].z), bflo(hb[j].w), bfhi(hb[j].w)} + eb1 * YINV;
#pragma unroll
                for (int q = 0; q < 2; ++q) { ssa += (va[j][q][0] * va[j][q][0] + va[j][q][1] * va[j][q][1]) + (va[j][q][2] * va[j][q][2] + va[j][q][3] * va[j][q][3]);
                    ssb += (vb[j][q][0] * vb[j][q][0] + vb[j][q][1] * vb[j][q][1]) + (vb[j][q][2] * vb[j][q][2] + vb[j][q][3] * vb[j][q][3]); } }
            const float ra = 1.0f / sqrtf(wave_sum(ssa) * (1.0f / DM) + RMS_EPS), rb = 1.0f / sqrtf(wave_sum(ssb) * (1.0f / DM) + RMS_EPS);
            float* oa = dst + (size_t)ma * DM + 8 * F.lane; float* ob = dst + (size_t)mbb * DM + 8 * F.lane;
#pragma unroll
            for (int j = 0; j < 2; ++j) { *(f32x4*)(oa + 512 * j) = va[j][0] * ra * gf[j][0]; *(f32x4*)(oa + 512 * j + 4) = va[j][1] * ra * gf[j][1]; }
            if (hasb) {
#pragma unroll
                for (int j = 0; j < 2; ++j) { *(f32x4*)(ob + 512 * j) = vb[j][0] * rb * gf[j][0]; *(f32x4*)(ob + 512 * j + 4) = vb[j][1] * rb * gf[j][1]; } }
        }
    }
}

#ifndef ALIGN_P3
#define ALIGN_P3 true
#endif
#ifndef ALIGN_P67
#define ALIGN_P67 true
#endif
#ifndef CONV_WG_MOD
#define CONV_WG_MOD 4
#endif
#ifndef REP3
#define REP3 1
#endif
#ifndef REP1
#define REP1 1
#endif
#ifndef REP6
#define REP6 1
#endif
#ifndef REP7
#define REP7 1
#endif
__device__ __forceinline__ void run_p1(Frame& F) {
    const int bx = (int)blockIdx.x, xcd = bx & 7, j = bx >> 3;
    constexpr int CM = CONV_WG_MOD, NCONV = 256 / CM;
    if (CONV_IN_P1 && F.G == 256 && (j & (CM - 1)) == CM - 1) { convert_experts(F, ((j / CM) * 8 + xcd) * NWAVES + F.wave, NCONV * NWAVES); return; }
    pg8::SchedIn S; S.A = (const char*)wsp<bf16_t>(F, WS_WIN); S.Bt = S.A; S.rep = REP1;
    if (CONV_IN_P1 && F.G == 256) { S.G = 256 - NCONV; S.c = ((CM - 1) * (j / CM) + (j & (CM - 1))) * 8 + xcd; } else { S.G = F.G; S.c = bx; }
    EpiIn E{EpiProj{wsp<bf16_t>(F, WS_Q), wsp<bf16_t>(F, WS_KB), wsp<bf16_t>(F, WS_CB), wsp<bf16_t>(F, WS_CC), wsp<bf16_t>(F, WS_CX), wsp<float>(F, WS_RSTD1)}, EpiVt{wsp<bf16_t>(F, WS_VT), wsp<float>(F, WS_RSTD1)}};
    pg8::gemm_phase<EpiIn, pg8::SchedIn, false>(F.lds, S, E);
}
template <bool DO_CONV, bool DO_ATT, bool PROBE = false>
__device__ __forceinline__ void run_p2(Frame& F) {
    for (int u = F.vcu; u < NB * (SEQ / 64); u += F.G) p2_unit<DO_CONV, DO_ATT, PROBE>(F, u >> 6, u & 63);
}
__device__ __forceinline__ void run_p3(Frame& F) {
#ifdef P3_STAGGER
    if (F.vcu & 1) { for (int i_ = 0; i_ < P3_STAGGER; ++i_) __builtin_amdgcn_s_sleep(127); }
#endif
    pg8::SchedPlain S; S.init(wsp<bf16_t>(F, WS_MIXED), wsp<bf16_t>(F, WS_WOUT), NTOK, DM, F.G, (int)blockIdx.x); S.rep = REP3;
    EpiOut E{F.x, wsp<bf16_t>(F, WS_A), wsp<unsigned char>(F, WS_A8), F.g_ffn};
    pg8::gemm_phase<EpiOut, pg8::SchedPlain, false, false, ALIGN_P3>(F.lds, S, E);
}
__device__ __forceinline__ void run_p6(Frame& F) {
    pg8::SchedGrouped<1024> S; S.A = (const char*)wsp<unsigned char>(F, WS_A8); S.Bt = (const char*)wsp<unsigned char>(F, WS_WGU); S.estep = (size_t)2048 * 1024; S.nN = 8; S.G = F.G; S.c = F.vcu; S.rep = REP6;
    S.tile_e = wsp<int>(F, WS_TILEE); S.slot_tok = wsp<int>(F, WS_SLOTTOK); S.ntiles = __builtin_amdgcn_readfirstlane(ld_i(S.tile_e + CAP_TILES));
    S.ltile = (LAS int*)(F.lds + RING_BYTES + 1024); S.ltok = (LAS int*)(F.lds + RING_BYTES + 4096); S.setup();
    EpiGU E{wsp<unsigned char>(F, WS_HID), F.b_gu, wsp<float>(F, WS_SLOTRSTD)};
    pg8::gemm_phase<EpiGU, pg8::SchedGrouped<1024>, true, true, ALIGN_P67>(F.lds, S, E);
}
__device__ __forceinline__ void run_p7(Frame& F) {
    pg8::SchedGrouped<1024> S; S.A = (const char*)wsp<unsigned char>(F, WS_HID); S.Bt = (const char*)wsp<unsigned char>(F, WS_WD); S.estep = (size_t)1024 * 1024; S.nN = 4; S.G = F.G; S.c = F.vcu; S.rep = REP7;
    S.tile_e = wsp<int>(F, WS_TILEE); S.slot_tok = wsp<int>(F, WS_SLOTTOK); S.ntiles = __builtin_amdgcn_readfirstlane(ld_i(S.tile_e + CAP_TILES));
    S.ltile = (LAS int*)(F.lds + RING_BYTES + 1024); S.ltok = (LAS int*)(F.lds + RING_BYTES + 4096); S.setup();
    EpiDown E{wsp<unsigned char>(F, WS_YS), F.b_down, wsp<float>(F, WS_SLOTGATE)};
    pg8::gemm_phase<EpiDown, pg8::SchedGrouped<1024>, false, true, ALIGN_P67>(F.lds, S, E);
}

constexpr int N_PHASES = 9;
__global__ void __launch_bounds__(NWAVES * 64, 2) fwd(Args args) {
    extern __shared__ __attribute__((aligned(16))) unsigned char lds_raw[];
    Frame F;
    F.lds = (LAS unsigned char*)lds_raw;
    F.tid = threadIdx.x; F.lane = F.tid & 63; F.wave = __builtin_amdgcn_readfirstlane(F.tid >> 6);
    F.G = gridDim.x; { const int bx = blockIdx.x; F.vcu = (F.G % 8 == 0) ? (bx % 8) * (F.G / 8) + bx / 8 : bx; }
    F.ws = args.ws; F.ctl = (gu32*)(args.ws + WS_CTL); F.out = args.out;
    F.x = args.in[0]; F.meta = args.in[1]; F.g_mix = args.in[2]; F.w_in = args.in[3]; F.g_attn = args.in[4]; F.conv_w = args.in[5]; F.conv_b = args.in[6]; F.g_conv = args.in[7];
    F.w_out = args.in[8]; F.g_ffn = args.in[9]; F.w_router = args.in[10]; F.b_router = args.in[11]; F.w_gu = args.in[12]; F.b_gu = args.in[13]; F.w_down = args.in[14]; F.b_down = args.in[15]; F.g_final = args.in[16];
    volatile LAS unsigned* MISC = (volatile LAS unsigned*)(F.lds + MISC_OFF);
    for (int u = F.tid; u < (LDS_BYTES - LDSCTL_OFF) / 4; u += NWAVES * 64) ((LAS unsigned*)(F.lds + LDSCTL_OFF))[u] = 0u;
    __syncthreads();
    const int lo = args.ph_lo, hi = args.ph_hi;
    const bool multi = (hi - lo) > 1;
    XcdBarrier bar; bar.bar = (unsigned*)(F.ctl + CW_BAR); bar.x = 0; bar.st = nullptr;
    if (multi) bar = xcd_barrier_post((unsigned*)(F.ctl + CW_BAR), MISC + 8);
#ifndef PH_MASK
#define PH_MASK 0x1ff
#endif
#define IN(k) (((PH_MASK >> (k)) & 1) && lo <= (k) && (k) < hi)
#define SEAM(k) do { if (IN(k) && IN((k) + 1)) xcd_barrier(bar); } while (0)
#ifndef DUP_MASK
#define DUP_MASK 0
#endif
#define DUPK(k) ((((DUP_MASK) >> (k)) & 1) != 0)

    if (IN(0)) { p0_prologue(F); if (DUPK(0)) { xcd_barrier(bar); p0_prologue(F); } }
    SEAM(0);
    if (IN(1)) { run_p1(F); if (DUPK(1)) { xcd_barrier(bar); run_p1(F); } }
    SEAM(1);
#ifndef P2DUP_CONV
#define P2DUP_CONV true
#endif
#ifndef P2DUP_ATT
#define P2DUP_ATT true
#endif
#ifndef P2M_CONV
#define P2M_CONV true
#endif
#ifndef P2M_ATT
#define P2M_ATT true
#endif
    if (IN(2)) { run_p2<P2M_CONV, P2M_ATT>(F); if (DUPK(2)) { xcd_barrier(bar); run_p2<P2DUP_CONV, P2DUP_ATT, true>(F); } }
    SEAM(2);
    if (IN(3)) { run_p3(F); if (DUPK(3)) { xcd_barrier(bar); run_p3(F); } }
    SEAM(3);
#ifdef XTRA_BAR
    for (int xb_ = 0; xb_ < XTRA_BAR; ++xb_) xcd_barrier(bar);
#endif
    if (IN(4)) { p4_router(F); if (DUPK(4)) { xcd_barrier(bar); p4_router(F); } }
    SEAM(4);
    if (IN(5)) { p5_scatter(F); if (DUPK(5)) { xcd_barrier(bar); p5_scatter(F); } }
    SEAM(5);
#ifdef PREWARM_W
    if (IN(6)) { const u32x4* wp_ = wsp<u32x4>(F, WS_WGU); const size_t n16_ = (size_t)PREWARM_W * 1024 * 1024 / 16; u32x4 a_ = {0u, 0u, 0u, 0u};
        for (size_t i_ = (size_t)blockIdx.x * 512 + F.tid; i_ < n16_; i_ += (size_t)F.G * 512) { const u32x4 v_ = wp_[i_]; a_.x ^= v_.x; a_.y ^= v_.y; a_.z ^= v_.z; a_.w ^= v_.w; }
        asm volatile("" :: "v"(a_.x), "v"(a_.y), "v"(a_.z), "v"(a_.w)); }
#endif
    if (IN(6)) { run_p6(F); if (DUPK(6)) { xcd_barrier(bar); run_p6(F); } }
    SEAM(6);
#ifdef DUP7_LOOP
    if (IN(7)) { for (int rep_ = 0; rep_ < 2; ++rep_) { if (rep_) xcd_barrier(bar); run_p7(F); } }
#else
    if (IN(7)) { run_p7(F); if (DUPK(7)) { xcd_barrier(bar); run_p7(F); } }
#endif
    SEAM(7);
    if (IN(8)) { if (DUPK(8)) { p8_combine(F, wsp<float>(F, WS_HID)); xcd_barrier(bar); } p8_combine(F, F.out); }
#undef IN
#undef SEAM
}

#ifndef MK_N_LAUNCHES
#define MK_N_LAUNCHES 1
#endif
extern "C" void kernel_launch(void* const* d_in, const int* in_sizes, int n_in, void* d_out, int out_size, void* d_ws, size_t ws_size, hipStream_t stream) {
    static int grid = 0;
    if (grid == 0) {
        if (n_in != 17 || out_size != NTOK * DM || ws_size < WS_END) { fprintf(stderr, "kernel_launch: unexpected problem (n_in %d out %d ws %zu)\n", n_in, out_size, ws_size); grid = -1; return; }
        int dev = 0, cus = 0, per_cu = 0;
        if (hipGetDevice(&dev) != hipSuccess || hipDeviceGetAttribute(&cus, hipDeviceAttributeMultiprocessorCount, dev) != hipSuccess) { grid = -1; return; }
        if (hipFuncSetAttribute((const void*)fwd, hipFuncAttributeMaxDynamicSharedMemorySize, LDS_BYTES) != hipSuccess) { fprintf(stderr, "kernel_launch: hipFuncSetAttribute failed\n"); grid = -1; return; }
        if (hipOccupancyMaxActiveBlocksPerMultiprocessor(&per_cu, (const void*)fwd, NWAVES * 64, LDS_BYTES) != hipSuccess || per_cu < 1) { fprintf(stderr, "kernel_launch: occupancy query says %d\n", per_cu); }
        (void)hipGetLastError();
        grid = cus;
        if (grid != 256) fprintf(stderr, "kernel_launch: %d CUs (built for 256)\n", grid);
    }
    if (grid < 0) return;
    (void)hipMemsetAsync((char*)d_ws + WS_CTL, 0, CTL_ZERO_BYTES, stream);
    Args a{};
    for (int i = 0; i < 17; ++i) a.in[i] = (const float*)d_in[i];
    a.out = (float*)d_out; a.ws = (unsigned char*)d_ws;
    if (MK_N_LAUNCHES == 1) { a.ph_lo = 0; a.ph_hi = N_PHASES; hipLaunchKernelGGL(fwd, dim3(grid), dim3(NWAVES * 64), LDS_BYTES, stream, a); }
    else for (int p = 0; p < N_PHASES; ++p) { a.ph_lo = p; a.ph_hi = p + 1; hipLaunchKernelGGL(fwd, dim3(grid), dim3(NWAVES * 64), LDS_BYTES, stream, a); }
    const hipError_t le = hipPeekAtLastError();
    if (le != hipSuccess) fprintf(stderr, "kernel_launch: launch failed: %s\n", hipGetErrorName(le));
}
```

```cpp
#include <hip/hip_runtime.h>
#include <cstdio>
#include <cstdint>

#define GAS __attribute__((address_space(1)))
#define LAS __attribute__((address_space(3)))
typedef unsigned short bf16_t;
typedef short bf16x8 __attribute__((ext_vector_type(8)));
typedef float f32x2 __attribute__((ext_vector_type(2)));
typedef float f32x4 __attribute__((ext_vector_type(4)));
typedef float f32x16 __attribute__((ext_vector_type(16)));
typedef unsigned u32x2 __attribute__((ext_vector_type(2)));
typedef unsigned u32x4 __attribute__((ext_vector_type(4)));
typedef int i32x4 __attribute__((ext_vector_type(4)));
typedef int i32x8 __attribute__((ext_vector_type(8)));
typedef __bf16 bf16x2_t __attribute__((ext_vector_type(2)));
typedef GAS unsigned gu32;
#define RLX_AGENT __ATOMIC_RELAXED, __HIP_MEMORY_SCOPE_AGENT

constexpr int DM = 1024, NB = 8, SEQ = 4096, NTOK = NB * SEQ;
constexpr int NMETA = 16, KPAD = 48, TPAD = KPAD + NMETA + SEQ;
constexpr int QOFF = KPAD + NMETA;
constexpr int VT_TILES = TPAD / 32;
__host__ __device__ __forceinline__ size_t vt_byte(int b, int head, int d, int p) {
    return ((size_t)((b * 8 + head) * VT_TILES + (p >> 5)) * 32 + (d >> 1)) * 128 + (size_t)(((d & 1) * 4 + ((p & 31) >> 3)) * 16 + (p & 7) * 2); }
constexpr int AW = 512, NH = 8, HD = 64;
constexpr int NE = 32, TOPK = 4, FF = 1024;
constexpr int CAP_TILES = 544, CAP = CAP_TILES * 256;
constexpr float RMS_EPS = 1e-6f;
constexpr float LOG2E = 1.4426950408889634f;
constexpr float QSCALE = 0.125f * LOG2E;
#ifndef EXIT_THR_VAL
#define EXIT_THR_VAL 5.421010862427522e-20f
#endif
constexpr float EXIT_THR = EXIT_THR_VAL;
constexpr int NWAVES = 8;
#ifndef CONV_IN_P1
#define CONV_IN_P1 1
#endif
constexpr float YSCALE = 16.0f, YINV = 1.0f / 16.0f;
constexpr float WSCALE = 32.0f, WINV = 1.0f / 32.0f;

constexpr size_t MiB = 1u << 20, KiB = 1u << 10;
constexpr size_t WS_CTL = 0, CTL_ZERO_BYTES = 64 * KiB;
constexpr size_t WS_RSTD1 = 1 * MiB, WS_RSTD2 = WS_RSTD1 + 128 * KiB, WS_CNT = WS_RSTD2 + 128 * KiB, WS_TILEE = WS_CNT + 64 * KiB, WS_META = WS_TILEE + 64 * KiB;
constexpr size_t WS_TOPE = 2 * MiB, WS_GATE = WS_TOPE + 512 * KiB, WS_TOKSLOT = 3 * MiB;
constexpr size_t WS_SLOTTOK = 4 * MiB, WS_SLOTGATE = 5 * MiB, WS_SLOTRSTD = 6 * MiB;
constexpr size_t WS_WIN = 10 * MiB, WS_WGU = 16 * MiB, WS_WD = 144 * MiB, WS_A = 208 * MiB;
constexpr size_t WS_HID = 272 * MiB;
constexpr size_t WS_Q = 272 * MiB, WS_KB = 304 * MiB, WS_VT = 337 * MiB, WS_CB = 370 * MiB, WS_CC = 402 * MiB, WS_CX = 434 * MiB, WS_MIXED = 466 * MiB;
constexpr size_t WS_YS = 544 * MiB, WS_WOUT = 816 * MiB, WS_A8 = 820 * MiB, WS_END = 852 * MiB;
static_assert(WS_MIXED + 64 * MiB <= WS_HID + (size_t)CAP * 2048 && WS_HID + (size_t)CAP * 2048 <= WS_YS && WS_YS + (size_t)CAP * 2048 <= WS_WOUT, "ws map");
static_assert((size_t)NB * TPAD * 512 * 2 <= 33 * MiB, "K/Vt size");
constexpr int CW_TMO = 0, CW_QCONV = 64, CW_QATT = 128, CW_BAR = 1024;

constexpr int RING_BYTES = 131072, LDSCTL_OFF = RING_BYTES, MISC_OFF = LDSCTL_OFF + 320, P2_SS_OFF = 147456, LDS_BYTES = 151552;

__device__ __forceinline__ unsigned cvtpk(float lo, float hi) { f32x2 v = {lo, hi}; bf16x2_t b = __builtin_convertvector(v, bf16x2_t); return __builtin_bit_cast(unsigned, b); }
__device__ __forceinline__ unsigned pk4_fp8(float a, float b, float c, float d) { int w = 0; w = __builtin_amdgcn_cvt_pk_fp8_f32(a, b, w, false); w = __builtin_amdgcn_cvt_pk_fp8_f32(c, d, w, true); return (unsigned)w; }
__device__ __forceinline__ f32x2 fp8lo(unsigned w) { return __builtin_amdgcn_cvt_pk_f32_fp8((int)w, false); }
__device__ __forceinline__ f32x2 fp8hi(unsigned w) { return __builtin_amdgcn_cvt_pk_f32_fp8((int)w, true); }
__device__ __forceinline__ float bflo(unsigned u) { return __builtin_bit_cast(float, u << 16); }
__device__ __forceinline__ float bfhi(unsigned u) { return __builtin_bit_cast(float, u & 0xffff0000u); }
__device__ __forceinline__ float ex2(float x) { return __builtin_amdgcn_exp2f(x); }
__device__ __forceinline__ float lg2(float x) { return __builtin_amdgcn_logf(x); }
__device__ __forceinline__ int ld_i(const int* p) { return __hip_atomic_load(p, RLX_AGENT); }
__device__ __forceinline__ float ld_f(const float* p) { return __builtin_bit_cast(float, __hip_atomic_load((const int*)p, RLX_AGENT)); }
__device__ __forceinline__ float wave_sum(float v) {
#pragma unroll
    for (int o = 1; o < 64; o <<= 1) v += __shfl_xor(v, o);
    return v;
}
#define LDS_WAIT() asm volatile("s_waitcnt lgkmcnt(0)" ::: "memory")
#define VM_WAIT() asm volatile("s_waitcnt vmcnt(0)" ::: "memory")

namespace pg8 {
constexpr int BM = 256, BK = 64, HALF = 128, HTB = HALF * BK * 2, STAGE_BYTES = 8 * HTB, NXCD = 8, WGM = 8, GK = 1024;
__host__ __device__ __forceinline__ int lds_byte(int r, int c) { const int st = (r >> 4) * 2 + (c >> 5), rr = r & 15, cc = c & 31, ob = rr * 64 + cc * 2; return st * 1024 + (ob ^ (((ob >> 9) & 1) << 5)); }
__host__ __device__ __forceinline__ void stage_rc(int b, int& R, int& C) { const int st = b / 1024, sb = b % 1024, swz = sb ^ (((sb >> 9) & 1) << 5); R = (st >> 1) * 16 + swz / 64; C = (st & 1) * 32 + (swz % 64) / 2; }
__host__ __device__ __forceinline__ int perm32(int rho) { const int n = rho >> 4, i = rho & 15; return 8 * (i >> 2) + 4 * n + (i & 3); }
struct Unit { int pm, pn, e, dup; };

struct SchedPlain {
    const char* A; const char* Bt; int nM, nN, nwg, G, c, rep = 1; static constexpr int RB = 2048;
    __device__ void init(const void* A_, const void* Bt_, int M, int N, int G_, int c_) { A = (const char*)A_; Bt = (const char*)Bt_; nM = M / BM; nN = N / BM; nwg = nM * nN; G = G_; c = c_; }
    __device__ __forceinline__ bool next(int i, Unit& u) const {
        const int nmy = (c < nwg) ? (nwg - c + G - 1) / G : 0; if (i >= nmy * rep) return false;
        const long L = (long)(i % nmy) * G + c;
        int wgid = (int)L; { const int q = nwg / NXCD, r = nwg % NXCD, xcd = wgid % NXCD, off = wgid / NXCD; wgid = (xcd < r ? xcd * (q + 1) : r * (q + 1) + (xcd - r) * q) + off; }
        const int nig = WGM * nN, gid = wgid / nig, fm = gid * WGM, gsz = (nM - fm) < WGM ? (nM - fm) : WGM;
        u.pm = fm + ((wgid % nig) % gsz); u.pn = (wgid % nig) / gsz; u.e = 0; u.dup = (i >= nmy) ? 1 : 0; return true;
    }
    __device__ __forceinline__ unsigned a_tile(const Unit& u) const { return (unsigned)u.pm * (unsigned)(BM * RB); }
    __device__ __forceinline__ unsigned b_tile(const Unit& u) const { return (unsigned)u.pn * (unsigned)(BM * RB); }
    __device__ __forceinline__ unsigned tok_off(int) const { return 0u; }
    __device__ __forceinline__ unsigned tok_lds(int, int) const { return 0u; }
    __device__ __forceinline__ void tok_dma(int, int, int, int) const {}
};
struct SchedIn {
    const char* A; const char* Bt; int G, c, rep = 1; static constexpr int RB = 2048;
    static constexpr unsigned A1OFF = (unsigned)(WS_A - WS_WIN);
    __device__ __forceinline__ bool next(int i, Unit& u) const {
        constexpr int NU0 = 128 * 10, NU1 = 2 * 128, NU = NU0 + NU1;
        const int nmy = (c < NU) ? (NU - c + G - 1) / G : 0; if (i >= nmy * rep) return false;
        const int L = (i % nmy) * G + c; u.dup = (i >= nmy) ? 1 : 0;
        int nM, nN, nwg, wgid;
        if (L < NU0) { u.e = 0; nM = 128; nN = 10; nwg = NU0; wgid = L; } else { u.e = 1; nM = 2; nN = 128; nwg = NU1; wgid = L - NU0; }
        { const int q = nwg / NXCD, r = nwg % NXCD, xcd = wgid % NXCD, off = wgid / NXCD; wgid = (xcd < r ? xcd * (q + 1) : r * (q + 1) + (xcd - r) * q) + off; }
        const int nig = WGM * nN, gid = wgid / nig, fm = gid * WGM, gsz = (nM - fm) < WGM ? (nM - fm) : WGM;
        u.pm = fm + ((wgid % nig) % gsz); u.pn = (wgid % nig) / gsz; return true;
    }
    __device__ __forceinline__ unsigned a_tile(const Unit& u) const { return u.e ? (unsigned)(2560 + u.pm * BM) * (unsigned)RB : A1OFF + (unsigned)u.pm * (unsigned)(BM * RB); }
    __device__ __forceinline__ unsigned b_tile(const Unit& u) const { return u.e ? A1OFF + (unsigned)u.pn * (unsigned)(BM * RB) : (unsigned)u.pn * (unsigned)(BM * RB); }
    __device__ __forceinline__ unsigned tok_off(int) const { return 0u; }
    __device__ __forceinline__ unsigned tok_lds(int, int) const { return 0u; }
    __device__ __forceinline__ void tok_dma(int, int, int, int) const {}
};
template <int RB_> struct SchedGrouped {
    static constexpr int RB = RB_;
    const char* A; const char* Bt; size_t estep; int nN, G, c, ntiles; const int* tile_e; const int* slot_tok;
    LAS int* ltile;
    LAS int* ltok;
    int rep;
    __device__ __forceinline__ void setup() const { if (threadIdx.x < 33) ltile[threadIdx.x] = ld_i(tile_e + CAP_TILES + 1 + threadIdx.x); __syncthreads(); }
    __device__ __forceinline__ bool next(int i, Unit& u) const {
        const int g = c >> 5, w = c & 31;
        const int t0 = ltile[g], t1 = ltile[g + 1], t2 = ltile[g + 8], t3 = ltile[g + 9], t4 = ltile[g + 16], t5 = ltile[g + 17], t6 = ltile[g + 24], t7 = ltile[g + 25];
        const int n0 = (t1 - t0) * nN, n1 = (t3 - t2) * nN, n2 = (t5 - t4) * nN, n3 = (t7 - t6) * nN, tot = n0 + n1 + n2 + n3;
        const int nmy = (w < tot) ? (tot - w + 31) / 32 : 0; if (i >= nmy * rep) return false;
        int l = (i % nmy) * 32 + w, e, tb;
        if (l < n0) { e = g; tb = t0; } else if (l < n0 + n1) { l -= n0; e = g + 8; tb = t2; } else if (l < n0 + n1 + n2) { l -= n0 + n1; e = g + 16; tb = t4; } else { l -= n0 + n1 + n2; e = g + 24; tb = t6; }
        u.pm = __builtin_amdgcn_readfirstlane(tb + l / nN); u.pn = __builtin_amdgcn_readfirstlane(l % nN); u.e = __builtin_amdgcn_readfirstlane(e); u.dup = (i >= nmy) ? 1 : 0; return true;
    }
    __device__ __forceinline__ unsigned a_tile(const Unit& u) const { return (unsigned)u.pm * (unsigned)(BM * RB); }
    __device__ __forceinline__ unsigned b_tile(const Unit& u) const { return (unsigned)u.e * (unsigned)estep + (unsigned)u.pn * (unsigned)(BM * RB); }
    __device__ __forceinline__ unsigned tok_off(int row) const { return (unsigned)ld_i(slot_tok + row) * (unsigned)RB; }
    __device__ __forceinline__ unsigned tok_lds(int par, int r) const { return (unsigned)ltok[par * 256 + r] * (unsigned)RB; }
    __device__ __forceinline__ void tok_dma(int par, int pm, int wid, int lane) const {
        const __amdgpu_buffer_rsrc_t rsT = __builtin_amdgcn_make_buffer_rsrc((void*)slot_tok, (short)0, CAP * 4, 0x00020000);
        __builtin_amdgcn_raw_ptr_buffer_load_lds(rsT, (LAS void*)(ltok + par * 256 + wid * 64), 4, lane * 4, (pm * 256 + wid * 64) * 4, 0, 0);
    }
};

template <class Epi, class Sched, bool GATHER, bool FP8 = false, bool ALIGN_EPI = true>
__device__ __forceinline__ void gemm_phase(LAS unsigned char* lds, const Sched& S, const Epi& E) {
    constexpr int RB = Sched::RB, nt = RB / 128;
    const int tid = threadIdx.x, wid = __builtin_amdgcn_readfirstlane(tid >> 6), lane = tid & 63, wr = wid >> 2, wc = wid & 3, fr = lane & 15, fq = lane >> 4;
    unsigned voffA[2], voffB[2], stC2[2]; int stR[2];
#pragma unroll
    for (int i = 0; i < 2; ++i) { int R, C; stage_rc(tid * 16 + i * 8192, R, C); const int Rb = (R & ~31) + perm32(R & 31);
        voffA[i] = (unsigned)(R * RB + C * 2); voffB[i] = (unsigned)(Rb * RB + C * 2); stR[i] = R; stC2[i] = (unsigned)C * 2u; }
    constexpr unsigned kstep = 128u, hstep = (unsigned)(HALF * RB);
    const __amdgpu_buffer_rsrc_t rsA = __builtin_amdgcn_make_buffer_rsrc((void*)S.A, (short)0, 0x7fffff00, 0x00020000), rsB = __builtin_amdgcn_make_buffer_rsrc((void*)S.Bt, (short)0, 0x7fffff00, 0x00020000);
    const unsigned ldsw = (unsigned)wid * 1024u;
    const int aoff = lds_byte(wr * 64 + fr, fq * 8), boff = lds_byte(wc * 32 + fr, fq * 8);
#define PG8_SA(b, h) (((b) * 2 + (h)) * HTB)
#define PG8_SB(b, h) ((4 + (b) * 2 + (h)) * HTB)
#define PG8_STAGE2(bufoff, rs, soff, o0, o1) do { \
        __builtin_amdgcn_raw_ptr_buffer_load_lds(rs, (LAS void*)(lds + (bufoff) + ldsw), 16, (int)(o0), (int)(soff), 0, 0); \
        __builtin_amdgcn_raw_ptr_buffer_load_lds(rs, (LAS void*)(lds + (bufoff) + ldsw + 8192), 16, (int)(o1), (int)(soff), 0, 0); } while (0)
#define PG8_STAGE_B(bufoff, soff) PG8_STAGE2(bufoff, rsB, soff, voffB[0], voffB[1])
#define PG8_STAGE_A(bufoff, usenext, h, koff) do { if constexpr (GATHER) { \
            const unsigned _o0 = (usenext) ? ng[h][0] : cg[h][0], _o1 = (usenext) ? ng[h][1] : cg[h][1]; PG8_STAGE2(bufoff, rsA, (koff), _o0, _o1); } \
        else { PG8_STAGE2(bufoff, rsA, ((usenext) ? nA : cA) + (unsigned)(h) * hstep + (koff), voffA[0], voffA[1]); } } while (0)
#define PG8_LDA(dst, b, h) do { _Pragma("unroll") for (int m = 0; m < 4; ++m) _Pragma("unroll") for (int k = 0; k < 2; ++k) dst[m][k] = *(const LAS bf16x8*)(lds + PG8_SA(b, h) + aoff + m * 2048 + k * 1024); } while (0)
#define PG8_LDB(dst, b, h) do { _Pragma("unroll") for (int n = 0; n < 2; ++n) _Pragma("unroll") for (int k = 0; k < 2; ++k) dst[n][k] = *(const LAS bf16x8*)(lds + PG8_SB(b, h) + boff + n * 2048 + k * 1024); } while (0)
#define PG8_MMA(ai, bj, At, Bt) do { __builtin_amdgcn_s_setprio(1); _Pragma("unroll") for (int m = 0; m < 4; ++m) _Pragma("unroll") for (int n = 0; n < 2; ++n) { \
        if constexpr (FP8) { const i32x8 bb_ = __builtin_shufflevector(__builtin_bit_cast(i32x4, Bt[n][0]), __builtin_bit_cast(i32x4, Bt[n][1]), 0, 1, 2, 3, 4, 5, 6, 7); \
            const i32x8 aa_ = __builtin_shufflevector(__builtin_bit_cast(i32x4, At[m][0]), __builtin_bit_cast(i32x4, At[m][1]), 0, 1, 2, 3, 4, 5, 6, 7); \
            asm volatile("v_mfma_scale_f32_16x16x128_f8f6f4 %0, %1, %2, %0, %3, %3 op_sel_hi:[0,0,0]" : "+v"(acc[ai][bj][m][n]) : "v"(bb_), "v"(aa_), "v"(scl8)); } \
        else { _Pragma("unroll") for (int k = 0; k < 2; ++k) acc[ai][bj][m][n] = __builtin_amdgcn_mfma_f32_16x16x32_bf16(Bt[n][k], At[m][k], acc[ai][bj][m][n], 0, 0, 0); } } \
        __builtin_amdgcn_s_setprio(0); } while (0)
#define PG8_MFMA_DRAIN() do { if constexpr (FP8) asm volatile("s_nop 7\n\ts_nop 7" ::: "memory"); } while (0)
#define PG8_WAIT_V(n) asm volatile("s_waitcnt vmcnt(" #n ")" ::: "memory")
#define PG8_WAIT_L(n) asm volatile("s_waitcnt lgkmcnt(" #n ")" ::: "memory")
#define PG8_BAR __builtin_amdgcn_s_barrier()
#define PG8_SCHED __builtin_amdgcn_sched_barrier(0)
    Unit cur, nxt; int ui = 0;
    if (!S.next(0, cur)) return;
    f32x4 acc[2][2][4][2];
    if constexpr (Epi::HAS_INIT) E.init(acc, cur, wr, wc, fr, fq); else {
#pragma unroll
    for (int a = 0; a < 2; ++a)
#pragma unroll
        for (int b = 0; b < 2; ++b)
#pragma unroll
            for (int m = 0; m < 4; ++m)
#pragma unroll
                for (int n = 0; n < 2; ++n) acc[a][b][m][n] = (f32x4){0.f, 0.f, 0.f, 0.f};
    }
    bf16x8 At[4][2], B0[2][2], B1[2][2];
    int scl8 = 0x7f7f7f7f; asm volatile("" : "+v"(scl8));
    unsigned cA = S.a_tile(cur), cB = S.b_tile(cur), nA = cA;
    unsigned cg[2][2], ng[2][2];
    if constexpr (GATHER) {
#pragma unroll
        for (int h = 0; h < 2; ++h)
#pragma unroll
            for (int i = 0; i < 2; ++i) { cg[h][i] = S.tok_off(cur.pm * BM + h * HALF + stR[i]) + stC2[i]; ng[h][i] = cg[h][i]; }
    } else {
#pragma unroll
        for (int h = 0; h < 2; ++h)
#pragma unroll
            for (int i = 0; i < 2; ++i) { cg[h][i] = 0u; ng[h][i] = 0u; }
    }
    PG8_STAGE_B(PG8_SB(0, 0), cB); PG8_STAGE_B(PG8_SB(0, 1), cB + hstep); PG8_STAGE_A(PG8_SA(0, 0), false, 0, 0); PG8_STAGE_A(PG8_SA(0, 1), false, 1, 0);
    if (wr == 1) PG8_BAR;
    PG8_WAIT_V(2); PG8_BAR;
    PG8_STAGE_B(PG8_SB(1, 0), cB + kstep); PG8_STAGE_A(PG8_SA(1, 0), false, 0, kstep); PG8_STAGE_B(PG8_SB(1, 1), cB + hstep + kstep);
    PG8_WAIT_V(6); PG8_BAR;
    for (;;) {
        const bool has_next = S.next(ui + 1, nxt);
        nA = has_next ? S.a_tile(nxt) : cA; const unsigned nB = has_next ? S.b_tile(nxt) : cB;
#pragma unroll 1
        for (int t = 0; t < nt; t += 2) {
            const bool last = (t == nt - 2);
            const unsigned koff1 = (unsigned)(t + 1) * kstep, koff2 = last ? 0u : (unsigned)(t + 2) * kstep, koff3 = koff2 + kstep;
            const unsigned b2 = last ? nB : cB + (unsigned)(t + 2) * kstep, b3 = b2 + kstep;
            if constexpr (GATHER) {
                if (t == nt - 4 && has_next && wid < 4) S.tok_dma((ui + 1) & 1, nxt.pm, wid, lane);
                if (last && has_next) {
#pragma unroll
                    for (int h = 0; h < 2; ++h)
#pragma unroll
                        for (int i = 0; i < 2; ++i) ng[h][i] = S.tok_lds((ui + 1) & 1, h * HALF + stR[i]) + stC2[i]; } }
            PG8_LDB(B0, 0, 0); PG8_LDB(B1, 0, 1); PG8_SCHED; PG8_LDA(At, 0, 0); PG8_STAGE_A(PG8_SA(1, 1), false, 1, koff1);
            PG8_WAIT_V(8); PG8_WAIT_L(0); PG8_BAR; PG8_MMA(0, 0, At, B0); PG8_MMA(0, 1, At, B1); PG8_BAR; PG8_SCHED;
            PG8_LDA(At, 0, 1); PG8_STAGE_B(PG8_SB(0, 0), b2); PG8_STAGE_B(PG8_SB(0, 1), b2 + hstep); PG8_STAGE_A(PG8_SA(0, 0), last, 0, koff2);
            PG8_WAIT_V(8); PG8_WAIT_L(0); PG8_BAR; PG8_MMA(1, 0, At, B0); PG8_MMA(1, 1, At, B1); PG8_BAR; PG8_SCHED;
            PG8_LDB(B0, 1, 0); PG8_LDB(B1, 1, 1); PG8_SCHED; PG8_LDA(At, 1, 0); PG8_STAGE_A(PG8_SA(0, 1), last, 1, koff2);
            PG8_WAIT_V(8); PG8_WAIT_L(0); PG8_BAR; PG8_MMA(0, 0, At, B0); PG8_MMA(0, 1, At, B1); PG8_BAR; PG8_SCHED;
            PG8_LDA(At, 1, 1); PG8_STAGE_B(PG8_SB(1, 0), b3); PG8_STAGE_B(PG8_SB(1, 1), b3 + hstep); PG8_STAGE_A(PG8_SA(1, 0), last, 0, koff3);
            PG8_WAIT_V(8); PG8_WAIT_L(0); PG8_BAR; PG8_MMA(1, 0, At, B0); PG8_MMA(1, 1, At, B1); PG8_BAR; PG8_SCHED;
        }
        if constexpr (ALIGN_EPI) { if (wr == 0) PG8_BAR; }
        PG8_MFMA_DRAIN();
        E(acc, cur, wr, wc, fr, fq);
        if (!has_next) break;
        if constexpr (Epi::HAS_INIT) E.init(acc, nxt, wr, wc, fr, fq); else {
#pragma unroll
        for (int a = 0; a < 2; ++a)
#pragma unroll
            for (int b = 0; b < 2; ++b)
#pragma unroll
                for (int m = 0; m < 4; ++m)
#pragma unroll
                    for (int n = 0; n < 2; ++n) acc[a][b][m][n] = (f32x4){0.f, 0.f, 0.f, 0.f};
        }
        cur = nxt; cA = nA; cB = nB; ++ui;
#pragma unroll
        for (int h = 0; h < 2; ++h)
#pragma unroll
            for (int i = 0; i < 2; ++i) cg[h][i] = ng[h][i];
        if constexpr (ALIGN_EPI) { if (wr == 1) PG8_BAR; }
    }
    PG8_WAIT_V(0);
    if constexpr (!ALIGN_EPI) { if (wr == 0) PG8_BAR; }
    PG8_BAR;
#undef PG8_SA
#undef PG8_SB
#undef PG8_STAGE2
#undef PG8_STAGE_B
#undef PG8_STAGE_A
#undef PG8_LDA
#undef PG8_LDB
#undef PG8_MMA
#undef PG8_MFMA_DRAIN
#undef PG8_WAIT_V
#undef PG8_WAIT_L
#undef PG8_BAR
#undef PG8_SCHED
}
}

#define XB_TMO      128
#define XB_XCNT(j)  (256  + 64 * (j))
#define XB_XSUB(j)  (1280 + 64 * (j))
#define XB_XGEN(j)  (2304 + 64 * (j))
#define XB_TOP      3328
#define XB_TOPGEN   3392
#define XCD_BAR_WORDS 3456
#define XB_SPIN_CAP (1u << 18)

__device__ __forceinline__ unsigned xb_ld(unsigned* p)              { return __hip_atomic_load(p, __ATOMIC_RELAXED, __HIP_MEMORY_SCOPE_AGENT); }
__device__ __forceinline__ unsigned xb_add(unsigned* p, unsigned v) { return __hip_atomic_fetch_add(p, v, __ATOMIC_RELAXED, __HIP_MEMORY_SCOPE_AGENT); }
__device__ __forceinline__ unsigned xb_xcc_id() { return (unsigned)__builtin_amdgcn_s_getreg((3 << 11) | 20) & 0xFu; }
#define XB_SPIN(cond, bar) do { unsigned _sp = 0; while (cond) { __builtin_amdgcn_s_sleep(1); \
    if ((++_sp & 255u) == 0u) { if (xb_ld(&(bar)[XB_TMO])) break; if (_sp > XB_SPIN_CAP) { atomicAdd(&(bar)[XB_TMO], 1u); break; } } } } while (0)

struct XcdBarrier {
    unsigned* bar; unsigned x;
    volatile LAS unsigned* st;
};

__device__ __forceinline__ XcdBarrier xcd_barrier_post(unsigned* bar, volatile LAS unsigned* st) {
    XcdBarrier b; b.bar = bar; b.x = xb_xcc_id(); b.st = st;
    if (threadIdx.x == 0) (void)xb_add(&bar[XB_XCNT(b.x)], 1u);
    return b;
}
__device__ __forceinline__ void xcd_barrier_complete(unsigned* bar, unsigned x, unsigned& nloc, unsigned& nx) {
    const unsigned G = gridDim.x * gridDim.y * gridDim.z;
    unsigned sum, cnt, mine, sp = 0u;
    for (;;) {
        sum = 0u; cnt = 0u; mine = 0u;
#pragma unroll
        for (unsigned j = 0; j < 16; ++j) { const unsigned c = xb_ld(&bar[XB_XCNT(j)]); sum += c; cnt += (c > 0u) ? 1u : 0u; mine = (j == x) ? c : mine; }
        if (sum == G) break;
        __builtin_amdgcn_s_sleep(1);
        if ((++sp & 255u) == 0u) { if (xb_ld(&bar[XB_TMO])) break; if (sp > XB_SPIN_CAP) { atomicAdd(&bar[XB_TMO], 1u); break; } }
    }
    nloc = mine > 0u ? mine : 1u; nx = cnt > 0u ? cnt : 1u;
}

__device__ __forceinline__ void xcd_barrier(const XcdBarrier& b) {
    asm volatile("s_waitcnt vmcnt(0)" ::: "memory");
    __syncthreads();
    if (threadIdx.x == 0) {
        unsigned* bar = b.bar;
        __builtin_amdgcn_s_waitcnt(0);
        unsigned nloc = b.st[0], nx = b.st[1];
        if (nloc == 0u) { xcd_barrier_complete(bar, b.x, nloc, nx); b.st[0] = nloc; b.st[1] = nx; }
        const unsigned old = xb_add(&bar[XB_XSUB(b.x)], 1u);
        const unsigned gen = old / nloc;
        if (old + 1u == (gen + 1u) * nloc) {
            __builtin_amdgcn_fence(__ATOMIC_RELEASE, "agent");
            asm volatile("s_waitcnt vmcnt(0)" ::: "memory");
            const unsigned og = xb_add(&bar[XB_TOP], 1u);
            const unsigned tg = og / nx;
            if (og + 1u == (tg + 1u) * nx) xb_add(&bar[XB_TOPGEN], 1u);
            else XB_SPIN(xb_ld(&bar[XB_TOPGEN]) == tg, bar);
            __builtin_amdgcn_fence(__ATOMIC_ACQUIRE, "agent");
            xb_add(&bar[XB_XGEN(b.x)], 1u);
            asm volatile("s_waitcnt vmcnt(0)" ::: "memory");
        } else {
            XB_SPIN(xb_ld(&bar[XB_XGEN(b.x)]) == gen, bar);
            __builtin_amdgcn_fence(__ATOMIC_ACQUIRE, "agent");
            asm volatile("s_waitcnt vmcnt(0)" ::: "memory");
        }
    }
    __syncthreads();
}

typedef f32x4 AccT[2][2][4][2];
struct EpiProj {
    static constexpr bool HAS_INIT = false;
    bf16_t *Q, *KB, *CB, *CU; const float* rstd1;
    __device__ __forceinline__ void operator()(const AccT& acc, const pg8::Unit& u, int wr, int wc, int fr, int fq) const {
#ifdef SKIP_REP_EPI
        if (u.dup) return;
#endif
        const int row0 = u.pm * 256 + wr * 64 + fr;
        float rsv[2][4];
#pragma unroll
        for (int ai = 0; ai < 2; ++ai)
#pragma unroll
            for (int m = 0; m < 4; ++m) rsv[ai][m] = rstd1[row0 + ai * 128 + m * 16];
        const bool isu = u.pn >= 6;
        const int sec = u.pn >> 1, col0 = isu ? (u.pn - 6) * 128 + wc * 32 + 8 * fq : (u.pn & 1) * 256 + wc * 32 + 8 * fq;
        bf16_t* base = isu ? CU : sec == 0 ? Q : sec == 1 ? KB : CB;
        const int radd = (sec == 1) ? 64 * ((u.pm >> 4) + 1) : 0;
        const float sc0 = (sec == 0) ? QSCALE : 1.0f;
#pragma unroll
        for (int ai = 0; ai < 2; ++ai)
#pragma unroll
            for (int m = 0; m < 4; ++m) { const int r = row0 + ai * 128 + m * 16; const float rsx = rsv[ai][m], sc = rsx * sc0;
                bf16_t* rowp = base + (size_t)(r + radd) * 512 + col0;
                if (isu) {
                    const float s2 = rsx * rsx;
                    const f32x4 v0 = acc[ai][0][m][0] * acc[ai][1][m][0] * s2, v1 = acc[ai][0][m][1] * acc[ai][1][m][1] * s2;
                    u32x4 w; w.x = cvtpk(v0[0], v0[1]); w.y = cvtpk(v0[2], v0[3]); w.z = cvtpk(v1[0], v1[1]); w.w = cvtpk(v1[2], v1[3]);
                    *(u32x4*)rowp = w;
                } else {
#pragma unroll
                    for (int bj = 0; bj < 2; ++bj) { const f32x4 v0 = acc[ai][bj][m][0] * sc, v1 = acc[ai][bj][m][1] * sc;
                        u32x4 w; w.x = cvtpk(v0[0], v0[1]); w.y = cvtpk(v0[2], v0[3]); w.z = cvtpk(v1[0], v1[1]); w.w = cvtpk(v1[2], v1[3]);
                        *(u32x4*)(rowp + bj * 128) = w; } } }
    }
};
struct EpiVt {
    static constexpr bool HAS_INIT = false;
    bf16_t* VT; const float* rstd1;
    __device__ __forceinline__ void operator()(const AccT& acc, const pg8::Unit& u, int wr, int wc, int fr, int fq) const {
#ifdef SKIP_REP_EPI
        if (u.dup) return;
#endif
        const int row0 = u.pm * 256 + wr * 64 + fr, col0 = u.pn * 256 + wc * 32 + 8 * fq;
        f32x4 rs[2][2];
#pragma unroll
        for (int bj = 0; bj < 2; ++bj)
#pragma unroll
            for (int n = 0; n < 2; ++n) rs[bj][n] = *(const f32x4*)(rstd1 + col0 + bj * 128 + 4 * n);
        const int b = u.pn >> 4;
#pragma unroll
        for (int ai = 0; ai < 2; ++ai)
#pragma unroll
            for (int m = 0; m < 4; ++m) { const int rch = row0 + ai * 128 + m * 16;
#pragma unroll
                for (int bj = 0; bj < 2; ++bj) { const f32x4 v0 = acc[ai][bj][m][0] * rs[bj][0], v1 = acc[ai][bj][m][1] * rs[bj][1];
                    u32x4 w; w.x = cvtpk(v0[0], v0[1]); w.y = cvtpk(v0[2], v0[3]); w.z = cvtpk(v1[0], v1[1]); w.w = cvtpk(v1[2], v1[3]);
                    const int p = QOFF + ((col0 + bj * 128) & 4095);
                    *(u32x4*)((unsigned char*)VT + vt_byte(b, rch >> 6, rch & 63, p)) = w; } }
    }
};
struct EpiIn {
    static constexpr bool HAS_INIT = false;
    EpiProj ep; EpiVt ev;
    __device__ __forceinline__ void operator()(const AccT& acc, const pg8::Unit& u, int wr, int wc, int fr, int fq) const { if (u.e) ev(acc, u, wr, wc, fr, fq); else ep(acc, u, wr, wc, fr, fq); }
};
struct EpiOut {
    static constexpr bool HAS_INIT = false;
    const float* x; bf16_t* H1; unsigned char* A8; const float* gffn;
    __device__ __forceinline__ void init(AccT&, const pg8::Unit&, int, int, int, int) const {}
    __device__ __forceinline__ void operator()(const AccT& acc, const pg8::Unit& u, int wr, int wc, int fr, int fq) const {
        const int row0 = u.pm * 256 + wr * 64 + fr, col0 = u.pn * 256 + wc * 32 + 8 * fq;
        f32x4 g[2][2];
#pragma unroll
        for (int bj = 0; bj < 2; ++bj)
#pragma unroll
            for (int n = 0; n < 2; ++n) g[bj][n] = *(const f32x4*)(gffn + col0 + bj * 128 + 4 * n);
        f32x4 xc[2][2], xn[2][2];
        { const size_t ro = (size_t)row0 * DM + col0;
#pragma unroll
          for (int bj = 0; bj < 2; ++bj) { xc[bj][0] = *(const f32x4*)(x + ro + bj * 128); xc[bj][1] = *(const f32x4*)(x + ro + bj * 128 + 4); } }
#pragma unroll
        for (int gi = 0; gi < 8; ++gi) { const int ai = gi >> 2, m = gi & 3;
            if (gi < 7) { const int r2 = row0 + ((gi + 1) >> 2) * 128 + ((gi + 1) & 3) * 16; const size_t ro2 = (size_t)r2 * DM + col0;
#pragma unroll
                for (int bj = 0; bj < 2; ++bj) { xn[bj][0] = *(const f32x4*)(x + ro2 + bj * 128); xn[bj][1] = *(const f32x4*)(x + ro2 + bj * 128 + 4); } }
            asm volatile("" ::: "memory");
            const int r = row0 + ai * 128 + m * 16; const size_t ro = (size_t)r * DM + col0; u32x2 w8[2];
#pragma unroll
            for (int bj = 0; bj < 2; ++bj) {
                const f32x4 v0 = acc[ai][bj][m][0] + xc[bj][0], v1 = acc[ai][bj][m][1] + xc[bj][1];
                u32x4 w; w.x = cvtpk(v0[0], v0[1]); w.y = cvtpk(v0[2], v0[3]); w.z = cvtpk(v1[0], v1[1]); w.w = cvtpk(v1[2], v1[3]);
                *(u32x4*)(H1 + ro + bj * 128) = w;
                const f32x4 a0 = v0 * g[bj][0], a1 = v1 * g[bj][1];
                w8[bj].x = pk4_fp8(a0[0], a0[1], a0[2], a0[3]); w8[bj].y = pk4_fp8(a1[0], a1[1], a1[2], a1[3]); }
            {
                const bool odd = fq & 1; const u32x2 snd = odd ? w8[0] : w8[1]; u32x2 rcv; rcv.x = __shfl_xor(snd.x, 16); rcv.y = __shfl_xor(snd.y, 16);
                const u32x4 o16 = odd ? (u32x4){rcv.x, rcv.y, w8[1].x, w8[1].y} : (u32x4){w8[0].x, w8[0].y, rcv.x, rcv.y};
                *(u32x4*)(A8 + (size_t)r * DM + u.pn * 256 + wc * 32 + 16 * (fq >> 1) + (odd ? 128 : 0)) = o16; }
            asm volatile("" ::: "memory");
#pragma unroll
            for (int bj = 0; bj < 2; ++bj) { xc[bj][0] = xn[bj][0]; xc[bj][1] = xn[bj][1]; }
        }
    }
};
struct EpiGU {
    static constexpr bool HAS_INIT = false;
    unsigned char* hid; const float* bgu; const float* slot_rstd;
    __device__ __forceinline__ void operator()(const AccT& acc, const pg8::Unit& u, int wr, int wc, int fr, int fq) const {
#ifdef SKIP_REP_EPI
        if (u.dup) return;
#endif
        const int row0 = u.pm * 256 + wr * 64 + fr, colr = u.pn * 128 + wc * 32 + 8 * fq;
        const float* bg = bgu + (size_t)u.e * 2048 + colr;
        const f32x4 bg0 = *(const f32x4*)(bg), bg1 = *(const f32x4*)(bg + 4), bl0 = *(const f32x4*)(bg + 1024), bl1 = *(const f32x4*)(bg + 1028);
        float rsv[2][4];
#pragma unroll
        for (int ai = 0; ai < 2; ++ai)
#pragma unroll
            for (int m = 0; m < 4; ++m) rsv[ai][m] = slot_rstd[row0 + ai * 128 + m * 16];
#pragma unroll
        for (int ai = 0; ai < 2; ++ai)
#pragma unroll
            for (int m = 0; m < 4; ++m) { const int r = row0 + ai * 128 + m * 16; const float rs = rsv[ai][m] * WINV;
                float hv[8];
#pragma unroll
                for (int n = 0; n < 2; ++n)
#pragma unroll
                    for (int i = 0; i < 4; ++i) {
                        float gt = acc[ai][0][m][n][i] * rs + (n ? bg1[i] : bg0[i]), ln = acc[ai][1][m][n][i] * rs + (n ? bl1[i] : bl0[i]);
                        gt = fminf(gt, 7.0f); ln = fminf(fmaxf(ln, -7.0f), 7.0f);
                        const float sg = __builtin_amdgcn_rcpf(1.0f + ex2(gt * (-1.702f * LOG2E)));
                        hv[n * 4 + i] = (ln + 1.0f) * (gt * sg); }
                u32x2 w; w.x = pk4_fp8(hv[0], hv[1], hv[2], hv[3]); w.y = pk4_fp8(hv[4], hv[5], hv[6], hv[7]);
                *(u32x2*)(hid + (size_t)r * FF + colr) = w; }
    }
};
struct EpiDown {
    static constexpr bool HAS_INIT = false;
    unsigned char* ys; const float* bd; const float* slot_gate;
    __device__ __forceinline__ void operator()(const AccT& acc, const pg8::Unit& u, int wr, int wc, int fr, int fq) const {
#ifdef SKIP_REP_EPI
        if (u.dup) return;
#endif
        const int row0 = u.pm * 256 + wr * 64 + fr, col0 = u.pn * 256 + wc * 32 + 8 * fq;
        f32x4 bv[2][2];
#pragma unroll
        for (int bj = 0; bj < 2; ++bj)
#pragma unroll
            for (int n = 0; n < 2; ++n) bv[bj][n] = *(const f32x4*)(bd + (size_t)u.e * DM + col0 + bj * 128 + 4 * n);
        float gtv[2][4];
#pragma unroll
        for (int ai = 0; ai < 2; ++ai)
#pragma unroll
            for (int m = 0; m < 4; ++m) gtv[ai][m] = slot_gate[row0 + ai * 128 + m * 16] * YSCALE;
#pragma unroll
        for (int ai = 0; ai < 2; ++ai)
#pragma unroll
            for (int m = 0; m < 4; ++m) { const int r = row0 + ai * 128 + m * 16; const float gt = gtv[ai][m];
                u32x2 w[2];
#pragma unroll
                for (int bj = 0; bj < 2; ++bj) { const f32x4 v0 = (acc[ai][bj][m][0] * WINV + bv[bj][0]) * gt, v1 = (acc[ai][bj][m][1] * WINV + bv[bj][1]) * gt;
                    w[bj].x = pk4_fp8(v0[0], v0[1], v0[2], v0[3]); w[bj].y = pk4_fp8(v1[0], v1[1], v1[2], v1[3]); }
                const bool odd = fq & 1; const u32x2 snd = odd ? w[0] : w[1]; u32x2 rcv; rcv.x = __shfl_xor(snd.x, 16); rcv.y = __shfl_xor(snd.y, 16);
                const u32x4 o16 = odd ? (u32x4){rcv.x, rcv.y, w[1].x, w[1].y} : (u32x4){w[0].x, w[0].y, rcv.x, rcv.y};
                *(u32x4*)(ys + (size_t)r * DM + u.pn * 256 + wc * 32 + 16 * (fq >> 1) + (odd ? 128 : 0)) = o16; }
    }
};

struct Args { const float* in[17]; float* out; unsigned char* ws; int ph_lo, ph_hi; };
struct Frame {
    LAS unsigned char* lds; gu32* ctl; int tid, lane, wave, vcu, G;
    const float *x, *meta, *g_mix, *w_in, *g_attn, *conv_w, *conv_b, *g_conv, *w_out, *g_ffn, *w_router, *b_router, *w_gu, *b_gu, *w_down, *b_down, *g_final;
    float* out; unsigned char* ws;
};
template <class T> __device__ __forceinline__ T* wsp(const Frame& F, size_t off) { return (T*)(F.ws + off); }

__device__ __forceinline__ void p0_transpose_item(const float* W, int ldw, int k0, int n0, bf16_t* WT, int Kd, int drow0, LAS unsigned* scr, int lane) {
    const int ks = lane >> 4, n4 = lane & 15;
    f32x4 va[8], vb[8];
    const float* src = W + (size_t)(k0 + 2 * ks) * ldw + n0 + 4 * n4;
#pragma unroll
    for (int i = 0; i < 8; ++i) { va[i] = *(const f32x4*)(src + (size_t)(8 * i) * ldw); vb[i] = *(const f32x4*)(src + (size_t)(8 * i + 1) * ldw); }
#pragma unroll
    for (int i = 0; i < 8; ++i)
#pragma unroll
        for (int j = 0; j < 4; ++j) scr[(4 * n4 + j) * 33 + 4 * i + ks] = cvtpk(va[i][j], vb[i][j]);
    LDS_WAIT(); asm volatile("" ::: "memory");
    const int ns = lane >> 3, c = lane & 7;
#pragma unroll
    for (int r = 0; r < 8; ++r) { const int n = 8 * r + ns; const LAS unsigned* t = scr + n * 33 + 4 * c;
        u32x4 o; o.x = t[0]; o.y = t[1]; o.z = t[2]; o.w = t[3];
        *(u32x4*)(WT + (size_t)(drow0 + n) * Kd + k0 + 8 * c) = o; }
    LDS_WAIT(); asm volatile("" ::: "memory");
}
#ifndef ITEM8_ALL32
#define ITEM8_ALL32 0
#endif
__device__ __forceinline__ void p0_transpose_item8(const float* W, int ldw, int k0, int n0, unsigned char* WT8, int Kd, int drow0, LAS unsigned* scr, int lane) {
    const int ks = lane >> 4, n4 = lane & 15;
#if ITEM8_ALL32
    f32x4 v[2][4][4];
#pragma unroll
    for (int h = 0; h < 2; ++h) {
        const float* src = W + (size_t)(k0 + 64 * h + 4 * ks) * ldw + n0 + 4 * n4;
#pragma unroll
        for (int i = 0; i < 4; ++i)
#pragma unroll
            for (int q = 0; q < 4; ++q) v[h][i][q] = *(const f32x4*)(src + (size_t)(16 * i + q) * ldw);
    }
#pragma unroll
    for (int h = 0; h < 2; ++h)
#pragma unroll
        for (int i = 0; i < 4; ++i)
#pragma unroll
            for (int j = 0; j < 4; ++j) scr[(4 * n4 + j) * 33 + 16 * h + 4 * i + ks] = pk4_fp8(v[h][i][0][j] * WSCALE, v[h][i][1][j] * WSCALE, v[h][i][2][j] * WSCALE, v[h][i][3][j] * WSCALE);
#else
#pragma unroll
    for (int h = 0; h < 2; ++h) {
        f32x4 v[4][4];
        const float* src = W + (size_t)(k0 + 64 * h + 4 * ks) * ldw + n0 + 4 * n4;
#pragma unroll
        for (int i = 0; i < 4; ++i)
#pragma unroll
            for (int q = 0; q < 4; ++q) v[i][q] = *(const f32x4*)(src + (size_t)(16 * i + q) * ldw);
#pragma unroll
        for (int i = 0; i < 4; ++i)
#pragma unroll
            for (int j = 0; j < 4; ++j) scr[(4 * n4 + j) * 33 + 16 * h + 4 * i + ks] = pk4_fp8(v[i][0][j] * WSCALE, v[i][1][j] * WSCALE, v[i][2][j] * WSCALE, v[i][3][j] * WSCALE);
    }
#endif
    LDS_WAIT(); asm volatile("" ::: "memory");
    const int ns = lane >> 3, c = lane & 7;
#pragma unroll
    for (int r = 0; r < 8; ++r) { const int n = 8 * r + ns; const LAS unsigned* t = scr + n * 33 + 4 * c;
        u32x4 o; o.x = t[0]; o.y = t[1]; o.z = t[2]; o.w = t[3];
        *(u32x4*)(WT8 + (size_t)(drow0 + n) * Kd + k0 + 16 * c) = o; }
    LDS_WAIT(); asm volatile("" ::: "memory");
}
__device__ __forceinline__ void p0_meta_job(Frame& F, int mw) {
    LAS float* nm = (LAS float*)F.lds;
    LAS float* part = (LAS float*)(F.lds + 65536);
    for (int t = F.wave * 2; t < F.wave * 2 + 2; ++t) {
        float v[16]; float ss = 0.f;
#pragma unroll
        for (int j = 0; j < 16; ++j) { v[j] = F.meta[t * DM + j * 64 + F.lane]; ss += v[j] * v[j]; }
        const float rstd = 1.0f / sqrtf(wave_sum(ss) * (1.0f / DM) + RMS_EPS);
#pragma unroll
        for (int j = 0; j < 16; ++j) { const int k = j * 64 + F.lane; nm[k * 16 + t] = v[j] * rstd * F.g_mix[k]; }
    }
    __syncthreads();
    const int kq = F.tid >> 7, c = F.tid & 127, j = mw * 128 + c, sec4 = j >> 9, jc = j & 511;
    const int ocol = (sec4 == 0 ? 512 : sec4 == 1 ? 1024 : sec4 == 2 ? 2048 : 2560) + jc;
    float acc[16];
#pragma unroll
    for (int t = 0; t < 16; ++t) acc[t] = 0.f;
    for (int kk = kq * 256; kk < kq * 256 + 256; kk += 16) {
        float wv[16];
#pragma unroll
        for (int u = 0; u < 16; ++u) wv[u] = F.w_in[(size_t)(kk + u) * 3072 + ocol];
#pragma unroll
        for (int u = 0; u < 16; ++u) { const float w = wv[u];
            const LAS f32x4* nv = (const LAS f32x4*)(nm + (kk + u) * 16);
#pragma unroll
            for (int q = 0; q < 4; ++q) { const f32x4 n4 = nv[q]; acc[4 * q] += w * n4[0]; acc[4 * q + 1] += w * n4[1]; acc[4 * q + 2] += w * n4[2]; acc[4 * q + 3] += w * n4[3]; } }
    }
#pragma unroll
    for (int t = 0; t < 16; ++t) part[(kq * 128 + c) * 16 + t] = acc[t];
    __syncthreads();
    {
        const int tq = F.tid >> 7;
        bf16_t* KB = wsp<bf16_t>(F, WS_KB); bf16_t* VT = wsp<bf16_t>(F, WS_VT); float* MT = wsp<float>(F, WS_META);
#pragma unroll
        for (int tt = 0; tt < 4; ++tt) { const int t = 4 * tq + tt;
            const float v = (part[(0 * 128 + c) * 16 + t] + part[(1 * 128 + c) * 16 + t]) + (part[(2 * 128 + c) * 16 + t] + part[(3 * 128 + c) * 16 + t]);
            const bf16_t bv = (bf16_t)(cvtpk(v, 0.f) & 0xffffu);
            if (sec4 == 0) { for (int b = 0; b < NB; ++b) KB[(size_t)(b * TPAD + KPAD + t) * 512 + jc] = bv; }
            else if (sec4 == 1) { for (int b = 0; b < NB; ++b) *(bf16_t*)((unsigned char*)VT + vt_byte(b, jc >> 6, jc & 63, KPAD + t)) = bv; }
            else if (t >= 14) MT[((sec4 - 2) * 2 + (t - 14)) * 512 + jc] = v;
        }
    }
    __syncthreads();
}
constexpr int CONV_ITEMS_GU = 32 * 8 * 32, CONV_ITEMS_D = 32 * 8 * 16, CONV_ITEMS = CONV_ITEMS_GU + CONV_ITEMS_D;
#ifndef P1_CONV_ITEMS
#define P1_CONV_ITEMS CONV_ITEMS
#endif
__device__ __forceinline__ void convert_expert_item(Frame& F, int it, LAS unsigned* scr) {
    unsigned char* WGU = wsp<unsigned char>(F, WS_WGU); unsigned char* WD = wsp<unsigned char>(F, WS_WD);
    if (it < CONV_ITEMS_GU) { const int e = it / 256, q = it % 256, kb = q / 32, nb = q % 32, n0 = 64 * nb, c = n0 & 1023;
        const int drow = (c >> 7) * 256 + (n0 >= 1024 ? 128 : 0) + (c & 127);
        p0_transpose_item8(F.w_gu + (size_t)e * 1024 * 2048, 2048, 128 * kb, n0, WGU + (size_t)e * 2048 * 1024, DM, drow, scr, F.lane); }
    else { const int r = it - CONV_ITEMS_GU, e = r / 128, q = r % 128, kb = q / 16, nb = q % 16;
        p0_transpose_item8(F.w_down + (size_t)e * 1024 * 1024, 1024, 128 * kb, 64 * nb, WD + (size_t)e * 1024 * 1024, FF, 64 * nb, scr, F.lane); }
}
struct ConvItem { const float* src; unsigned char* dst; int ldw; };
__device__ __forceinline__ ConvItem conv_item(Frame& F, int it, int lane) {
    const int ks = lane >> 4, n4 = lane & 15, ns = lane >> 3, c8 = lane & 7; ConvItem ci;
    if (it < CONV_ITEMS_GU) { const int e = it / 256, q = it % 256, kb = q / 32, nb = q % 32, n0 = 64 * nb, c = n0 & 1023;
        const int drow = (c >> 7) * 256 + (n0 >= 1024 ? 128 : 0) + (c & 127);
        ci.ldw = 2048; ci.src = F.w_gu + (size_t)e * 1024 * 2048 + (size_t)(128 * kb + 4 * ks) * 2048 + n0 + 4 * n4;
        ci.dst = wsp<unsigned char>(F, WS_WGU) + (size_t)e * 2048 * 1024 + (size_t)(drow + ns) * DM + 128 * kb + 16 * c8; }
    else { const int r = it - CONV_ITEMS_GU, e = r / 128, q = r % 128, kb = q / 16, nb = q % 16;
        ci.ldw = 1024; ci.src = F.w_down + (size_t)e * 1024 * 1024 + (size_t)(128 * kb + 4 * ks) * 1024 + 64 * nb + 4 * n4;
        ci.dst = wsp<unsigned char>(F, WS_WD) + (size_t)e * 1024 * 1024 + (size_t)(64 * nb + ns) * FF + 128 * kb + 16 * c8; }
    return ci;
}
#define CONV_LOAD(v, ci, h) do { _Pragma("unroll") for (int i_ = 0; i_ < 4; ++i_) _Pragma("unroll") for (int q_ = 0; q_ < 4; ++q_) \
        v[i_][q_] = *(const f32x4*)((ci).src + (size_t)(64 * (h) + 16 * i_ + q_) * (ci).ldw); } while (0)
#define CONV_PACK(v, h) do { _Pragma("unroll") for (int i_ = 0; i_ < 4; ++i_) _Pragma("unroll") for (int j_ = 0; j_ < 4; ++j_) \
        scr[(4 * n4 + j_) * 33 + 16 * (h) + 4 * i_ + ks] = pk4_fp8(v[i_][0][j_] * WSCALE, v[i_][1][j_] * WSCALE, v[i_][2][j_] * WSCALE, v[i_][3][j_] * WSCALE); } while (0)
__device__ __forceinline__ void convert_experts(Frame& F, int wv, int nw) {
    LAS unsigned* scr = (LAS unsigned*)(F.lds + F.wave * 8704);
    const int lane = F.lane, ks = lane >> 4, n4 = lane & 15, ns = lane >> 3, c8 = lane & 7;
    int it = wv; if (it >= P1_CONV_ITEMS) return;
    ConvItem cur = conv_item(F, it, lane);
    f32x4 va[4][4], vb[4][4];
    CONV_LOAD(va, cur, 0);
    for (;;) {
        CONV_LOAD(vb, cur, 1);
        CONV_PACK(va, 0);
        const int itn = it + nw; const bool more = itn < P1_CONV_ITEMS;
        ConvItem nxt = cur; if (more) { nxt = conv_item(F, itn, lane); CONV_LOAD(va, nxt, 0); }
        CONV_PACK(vb, 1);
        LDS_WAIT(); asm volatile("" ::: "memory");
#pragma unroll
        for (int r = 0; r < 8; ++r) { const LAS unsigned* t = scr + (8 * r + ns) * 33 + 4 * c8;
            u32x4 o; o.x = t[0]; o.y = t[1]; o.z = t[2]; o.w = t[3];
            *(u32x4*)(cur.dst + (size_t)(8 * r) * (it < CONV_ITEMS_GU ? DM : FF)) = o; }
        LDS_WAIT(); asm volatile("" ::: "memory");
        if (!more) break;
        cur = nxt; it = itn;
    }
}
#undef CONV_LOAD
#undef CONV_PACK

__device__ __forceinline__ void p0_prologue(Frame& F) {
    constexpr int NMW = 16;
    if (F.vcu < NMW) {
        p0_meta_job(F, F.vcu);
        bf16_t* KB = wsp<bf16_t>(F, WS_KB); bf16_t* VT = wsp<bf16_t>(F, WS_VT);
        const int gt = F.vcu * 512 + F.tid, NT = NMW * 512;
        for (int i = gt; i < NB * KPAD * 64; i += NT) { const int b = i / (KPAD * 64), r = i % (KPAD * 64); *(u32x4*)(KB + (size_t)(b * TPAD) * 512 + (size_t)r * 8) = (u32x4){0u, 0u, 0u, 0u}; }
        for (int i = gt; i < 512 * NB * 6; i += NT) { const int ch = i / (NB * 6), r = i % (NB * 6), b = r / 6, q = r % 6; *(u32x4*)((unsigned char*)VT + vt_byte(b, ch >> 6, ch & 63, q * 8)) = (u32x4){0u, 0u, 0u, 0u}; }
        return;
    }
    const int gw = (F.vcu - NMW) * NWAVES + F.wave, NGW = (F.G - NMW) * NWAVES;
    {
        float* rstd1 = wsp<float>(F, WS_RSTD1); bf16_t* A1 = wsp<bf16_t>(F, WS_A);
        f32x4 g4[4];
#pragma unroll
        for (int j = 0; j < 4; ++j) g4[j] = *(const f32x4*)(F.g_mix + 256 * j + 4 * F.lane);
        for (int m = gw; m < NTOK; m += NGW) {
            const f32x4* xr = (const f32x4*)(F.x + (size_t)m * DM) + F.lane;
            f32x4 v[4]; float s = 0.f;
#pragma unroll
            for (int j = 0; j < 4; ++j) { v[j] = xr[64 * j]; s += (v[j][0] * v[j][0] + v[j][1] * v[j][1]) + (v[j][2] * v[j][2] + v[j][3] * v[j][3]); }
            s = wave_sum(s);
            if (F.lane == 0) rstd1[m] = 1.0f / sqrtf(s * (1.0f / DM) + RMS_EPS);
            u32x2* o8 = (u32x2*)(A1 + (size_t)m * DM) + F.lane;
#pragma unroll
            for (int j = 0; j < 4; ++j) { const f32x4 a = v[j] * g4[j]; u32x2 o; o.x = cvtpk(a[0], a[1]); o.y = cvtpk(a[2], a[3]); o8[64 * j] = o; }
        }
    }
    {
        LAS unsigned* scr = (LAS unsigned*)(F.lds + F.wave * 8704);
        constexpr int I_IN = 16 * 48, I_OUT = 16 * 16, I_X = CONV_IN_P1 ? (32 * 8 * 48 - P1_CONV_ITEMS) : 32 * 8 * 48, NITEMS = I_IN + I_OUT + I_X;
        bf16_t* WIN = wsp<bf16_t>(F, WS_WIN); bf16_t* WOUT = wsp<bf16_t>(F, WS_WOUT); unsigned char* WGU = wsp<unsigned char>(F, WS_WGU); unsigned char* WD = wsp<unsigned char>(F, WS_WD);
        for (int it = gw; it < NITEMS; it += NGW) {
            int r = it;
            if (r < I_IN) { const int kb = r / 48, nb = r % 48, n0 = 64 * nb, sec = n0 >> 9;
                const int nl = n0 & 511, drow = sec == 0 ? nl : sec == 1 ? 512 + nl : sec == 2 ? 2560 + nl : sec == 3 ? 1024 + nl : 1536 + (nl >> 7) * 256 + (sec == 5 ? 128 : 0) + (nl & 127);
                p0_transpose_item(F.w_in, 3072, 64 * kb, n0, WIN, DM, drow, scr, F.lane); continue; }
            r -= I_IN;
            if (r < I_OUT) { const int kb = r / 16, nb = r % 16; p0_transpose_item(F.w_out, 1024, 64 * kb, 64 * nb, WOUT, DM, 64 * nb, scr, F.lane); continue; }
            r -= I_OUT;
            convert_expert_item(F, (CONV_IN_P1 ? P1_CONV_ITEMS : 0) + r, scr);
        }
    }
}
template <bool EDGE>
__device__ __forceinline__ void sb_tile(f32x16& s0, f32x16& s1, float& carry, int kp0  , int qpos, bool hi0, bf16x8 (&pf)[2][2]) {
    float R[4];
#pragma unroll
    for (int q = 0; q < 4; ++q) {
        float S = 1.0f;
#pragma unroll
        for (int i = 7; i >= 0; --i) {
            const int r = (q & 1) * 8 + i;
            const float z = fminf((q < 2) ? s0[r] : s1[r], 100.0f);
            const float e = ex2(z);
            float kp_ = __builtin_amdgcn_rcpf(1.0f + e);
            float sg = e * kp_;
            if (EDGE) { const int kp = kp0 + 16 * q + i; const bool valid = (kp < qpos) && (kp >= KPAD); kp_ = valid ? kp_ : 1.0f; sg = valid ? sg : 0.0f; }
            const float m = sg * S; S *= kp_;
            if (q < 2) s0[r] = m; else s1[r] = m;
        }
        R[q] = S;
        __builtin_amdgcn_sched_barrier(0);
    }
    const float P0 = __shfl_xor(R[0], 32), P1 = __shfl_xor(R[1], 32), P2 = __shfl_xor(R[2], 32), P3 = __shfl_xor(R[3], 32);
    const float T1 = R[1] * P1, T2 = R[2] * P2, T3 = R[3] * P3, T0 = R[0] * P0;
    const float b3 = carry * (hi0 ? P3 : 1.0f), b2 = carry * (T3 * (hi0 ? P2 : 1.0f)), b1 = carry * ((T3 * T2) * (hi0 ? P1 : 1.0f)), b0 = carry * ((T3 * T2 * T1) * (hi0 ? P0 : 1.0f));
#pragma unroll
    for (int i = 0; i < 8; ++i) { s0[i] *= b0; s0[8 + i] *= b1; s1[i] *= b2; s1[8 + i] *= b3; }
    carry *= (T0 * T1) * (T2 * T3);
    u32x4 w;
    w.x = cvtpk(s0[0], s0[1]); w.y = cvtpk(s0[2], s0[3]); w.z = cvtpk(s0[4], s0[5]); w.w = cvtpk(s0[6], s0[7]); pf[0][0] = __builtin_bit_cast(bf16x8, w);
    w.x = cvtpk(s0[8], s0[9]); w.y = cvtpk(s0[10], s0[11]); w.z = cvtpk(s0[12], s0[13]); w.w = cvtpk(s0[14], s0[15]); pf[0][1] = __builtin_bit_cast(bf16x8, w);
    w.x = cvtpk(s1[0], s1[1]); w.y = cvtpk(s1[2], s1[3]); w.z = cvtpk(s1[4], s1[5]); w.w = cvtpk(s1[6], s1[7]); pf[1][0] = __builtin_bit_cast(bf16x8, w);
    w.x = cvtpk(s1[8], s1[9]); w.y = cvtpk(s1[10], s1[11]); w.z = cvtpk(s1[12], s1[13]); w.w = cvtpk(s1[14], s1[15]); pf[1][1] = __builtin_bit_cast(bf16x8, w);
}
template <bool EDGE>
__device__ __forceinline__ void sb_tile32(f32x16& s0, float& carry, int kp0  , int qpos, bool hi0, bf16x8 (&pf)[2]) {
    float R[2];
#pragma unroll
    for (int q = 0; q < 2; ++q) {
        float S = 1.0f;
#pragma unroll
        for (int i = 7; i >= 0; --i) {
            const int r = q * 8 + i;
            const float z = fminf(s0[r], 100.0f);
            const float e = ex2(z);
            float kp_ = __builtin_amdgcn_rcpf(1.0f + e);
            float sg = e * kp_;
            if (EDGE) { const int kp = kp0 + 16 * q + i; const bool valid = (kp < qpos) && (kp >= KPAD); kp_ = valid ? kp_ : 1.0f; sg = valid ? sg : 0.0f; }
            s0[r] = sg * S; S *= kp_;
        }
        R[q] = S;
    }
    const float P0 = __shfl_xor(R[0], 32), P1 = __shfl_xor(R[1], 32);
    const float T0 = R[0] * P0, T1 = R[1] * P1;
    const float b1 = carry * (hi0 ? P1 : 1.0f), b0 = carry * (T1 * (hi0 ? P0 : 1.0f));
#pragma unroll
    for (int i = 0; i < 8; ++i) { s0[i] *= b0; s0[8 + i] *= b1; }
    carry *= T0 * T1;
    u32x4 w;
    w.x = cvtpk(s0[0], s0[1]); w.y = cvtpk(s0[2], s0[3]); w.z = cvtpk(s0[4], s0[5]); w.w = cvtpk(s0[6], s0[7]); pf[0] = __builtin_bit_cast(bf16x8, w);
    w.x = cvtpk(s0[8], s0[9]); w.y = cvtpk(s0[10], s0[11]); w.z = cvtpk(s0[12], s0[13]); w.w = cvtpk(s0[14], s0[15]); pf[1] = __builtin_bit_cast(bf16x8, w);
}
#define MFMA32(a, b, c) __builtin_amdgcn_mfma_f32_32x32x16_bf16((a), (b), (c), 0, 0, 0)
#define P2_LDS_BARRIER() do { asm volatile("s_waitcnt lgkmcnt(0)" ::: "memory"); __builtin_amdgcn_s_barrier(); asm volatile("" ::: "memory"); } while (0)
template <bool DO_CONV, bool DO_ATT, bool PROBE = false>
__device__ __forceinline__ void p2_unit(Frame& F, int b, int qb) {
    int lane_ = F.lane, head_ = F.wave;
    asm volatile("" : "+v"(lane_), "+s"(head_));
    const int lane = lane_, head = head_, l31 = lane & 31, hi = lane >> 5; const bool hi0 = hi == 0;
    const bf16_t* Q = wsp<bf16_t>(F, WS_Q); const bf16_t* KB = wsp<bf16_t>(F, WS_KB); const bf16_t* VT = wsp<bf16_t>(F, WS_VT);
    bf16_t* MX = wsp<bf16_t>(F, PROBE ? WS_YS : WS_MIXED);
    LAS float* ssA = (LAS float*)(F.lds + P2_SS_OFF);
    LAS float* ssC = (LAS float*)(F.lds + P2_SS_OFF + 2048);
    const int row0 = b * SEQ + qb * 64;
    const int pi = (l31 & 0x13) | ((l31 & 4) << 1) | ((l31 & 8) >> 1);
    const __amdgpu_buffer_rsrc_t rsK = __builtin_amdgcn_make_buffer_rsrc((void*)(KB + (size_t)b * TPAD * 512), (short)0, TPAD * 512 * 2, 0x00020000);
    const __amdgpu_buffer_rsrc_t rsV = __builtin_amdgcn_make_buffer_rsrc((void*)((const unsigned char*)VT + (size_t)(b * 8 + head) * VT_TILES * 4096), (short)0, VT_TILES * 4096, 0x00020000);
    const int voffKe = ((lane >> 3) * 512 + head * 64) * 2 + ((lane & 7) ^ (lane >> 4)) * 16, voffKo = ((lane >> 3) * 512 + head * 64) * 2 + ((lane & 7) ^ (lane >> 4) ^ 4) * 16;
    const int voffV = (lane >> 3) * 128 + ((lane & 7) ^ (lane >> 4)) * 16;
    LAS unsigned char* kbuf = F.lds + head * 16384; LAS unsigned char* vbuf = kbuf + 8192;
    const int P0 = QOFF + 64 * qb, qpos = P0 + l31, NT = (P0 >> 5) + 1;
    int koff[4], voff2[2];
    { const int fk = (pi >> 1) & 7, fv = (l31 >> 2) & 3;
#pragma unroll
      for (int s4 = 0; s4 < 4; ++s4) koff[s4] = pi * 128 + (((2 * s4 + hi) ^ fk) << 4);
#pragma unroll
      for (int s2 = 0; s2 < 2; ++s2) voff2[s2] = (l31 >> 1) * 128 + (((4 * (l31 & 1) + 2 * s2 + hi) ^ fv) << 4); }
#define ATT_DMA_K(st, pp) do { \
        __builtin_amdgcn_raw_ptr_buffer_load_lds(rsK, (LAS void*)(kbuf + (pp) * 4096 + 0 * 1024), 16, voffKe, (st) * 1024 + 0 * 8192, 0, 0); \
        __builtin_amdgcn_raw_ptr_buffer_load_lds(rsK, (LAS void*)(kbuf + (pp) * 4096 + 1 * 1024), 16, voffKo, (st) * 1024 + 1 * 8192, 0, 0); \
        __builtin_amdgcn_raw_ptr_buffer_load_lds(rsK, (LAS void*)(kbuf + (pp) * 4096 + 2 * 1024), 16, voffKe, (st) * 1024 + 2 * 8192, 0, 0); \
        __builtin_amdgcn_raw_ptr_buffer_load_lds(rsK, (LAS void*)(kbuf + (pp) * 4096 + 3 * 1024), 16, voffKo, (st) * 1024 + 3 * 8192, 0, 0); } while (0)
#define ATT_DMA_V(st, pp) do { \
        __builtin_amdgcn_raw_ptr_buffer_load_lds(rsV, (LAS void*)(vbuf + (pp) * 4096 + 0 * 1024), 16, voffV, ((st) >> 5) * 4096 + 0 * 1024, 0, 0); \
        __builtin_amdgcn_raw_ptr_buffer_load_lds(rsV, (LAS void*)(vbuf + (pp) * 4096 + 1 * 1024), 16, voffV, ((st) >> 5) * 4096 + 1 * 1024, 0, 0); \
        __builtin_amdgcn_raw_ptr_buffer_load_lds(rsV, (LAS void*)(vbuf + (pp) * 4096 + 2 * 1024), 16, voffV, ((st) >> 5) * 4096 + 2 * 1024, 0, 0); \
        __builtin_amdgcn_raw_ptr_buffer_load_lds(rsV, (LAS void*)(vbuf + (pp) * 4096 + 3 * 1024), 16, voffV, ((st) >> 5) * 4096 + 3 * 1024, 0, 0); } while (0)
#define ATT_WAIT_VM(n) do { if ((n) >= 12) asm volatile("s_waitcnt vmcnt(12)" ::: "memory"); else if ((n) == 8) asm volatile("s_waitcnt vmcnt(8)" ::: "memory"); \
        else if ((n) == 4) asm volatile("s_waitcnt vmcnt(4)" ::: "memory"); else asm volatile("s_waitcnt vmcnt(0)" ::: "memory"); } while (0)
    bf16x8 qf[2][4];
    if constexpr (DO_ATT) {
        asm volatile("s_waitcnt lgkmcnt(0)" ::: "memory");
        ATT_DMA_K(P0 + 32, 0); ATT_DMA_V(P0 + 32, 0); ATT_DMA_K(P0, 1); ATT_DMA_V(P0, 1);
        const bf16_t* Qp = Q + (size_t)(row0 + l31) * 512 + head * 64 + hi * 8;
#pragma unroll
        for (int q2 = 0; q2 < 2; ++q2)
#pragma unroll
            for (int s = 0; s < 4; ++s) qf[q2][s] = *(const bf16x8*)(Qp + (size_t)q2 * 32 * 512 + s * 16);
    }
    if constexpr (DO_CONV) {
        const int cgp = lane & 7, rg = lane >> 3, ch0 = head * 64 + cgp * 8;
        const bf16_t* CB = wsp<bf16_t>(F, WS_CB); const bf16_t* CU = wsp<bf16_t>(F, WS_CC); const float* MT = wsp<float>(F, WS_META);
        float cv[8][8];
        {
            float w0[8], w1[8], w2[8], bs[8], u2[8], u1[8];
            { const f32x4 a0 = *(const f32x4*)(F.conv_w + ch0), a1 = *(const f32x4*)(F.conv_w + ch0 + 4), b0 = *(const f32x4*)(F.conv_w + 512 + ch0), b1 = *(const f32x4*)(F.conv_w + 512 + ch0 + 4);
              const f32x4 c0 = *(const f32x4*)(F.conv_w + 1024 + ch0), c1 = *(const f32x4*)(F.conv_w + 1024 + ch0 + 4), d0 = *(const f32x4*)(F.conv_b + ch0), d1 = *(const f32x4*)(F.conv_b + ch0 + 4);
#pragma unroll
              for (int k = 0; k < 4; ++k) { w0[k] = a0[k]; w0[4 + k] = a1[k]; w1[k] = b0[k]; w1[4 + k] = b1[k]; w2[k] = c0[k]; w2[4 + k] = c1[k]; bs[k] = d0[k]; bs[4 + k] = d1[k]; } }
#pragma unroll
            for (int k = 0; k < 8; ++k) { u2[k] = 0.f; u1[k] = 0.f; }
            float um[2][8];
#pragma unroll
            for (int t = 0; t < 2; ++t)
#pragma unroll
                for (int k = 0; k < 8; ++k) um[t][k] = 0.f;
            if (qb == 0) {
#pragma unroll
                for (int t = 0; t < 2; ++t) { const f32x4 c0 = *(const f32x4*)(MT + t * 512 + ch0), c1 = *(const f32x4*)(MT + t * 512 + ch0 + 4), x0 = *(const f32x4*)(MT + (2 + t) * 512 + ch0), x1 = *(const f32x4*)(MT + (2 + t) * 512 + ch0 + 4);
#pragma unroll
                    for (int k = 0; k < 4; ++k) { um[t][k] = c0[k] * x0[k]; um[t][4 + k] = c1[k] * x1[k]; } }
            }
            u32x4 c4[10], b4[8];
#pragma unroll
            for (int i = 0; i < 10; ++i) { const int sl = qb * 64 + rg * 8 + i - 2; c4[i] = *(const u32x4*)(CU + (size_t)(b * SEQ + (sl < 0 ? 0 : sl)) * 512 + ch0); }
#pragma unroll
            for (int i = 0; i < 8; ++i) b4[i] = *(const u32x4*)(CB + (size_t)(b * SEQ + qb * 64 + rg * 8 + i) * 512 + ch0);
#pragma unroll
            for (int i = 0; i < 10; ++i) {
                const int ri = i - 2;
                const int sl = qb * 64 + rg * 8 + ri;
                float u[8] = {bflo(c4[i].x), bfhi(c4[i].x), bflo(c4[i].y), bfhi(c4[i].y), bflo(c4[i].z), bfhi(c4[i].z), bflo(c4[i].w), bfhi(c4[i].w)};
                if (ri < 0) {
#pragma unroll
                    for (int k = 0; k < 8; ++k) u[k] = (sl < 0) ? um[ri + 2][k] : u[k];
                } else {
                    const u32x4 bb = b4[ri];
                    const float cbv[8] = {bflo(bb.x), bfhi(bb.x), bflo(bb.y), bfhi(bb.y), bflo(bb.z), bfhi(bb.z), bflo(bb.w), bfhi(bb.w)};
#pragma unroll
                    for (int k = 0; k < 8; ++k) cv[ri][k] = cbv[k] * (w0[k] * u2[k] + w1[k] * u1[k] + w2[k] * u[k] + bs[k]);
                }
#pragma unroll
                for (int k = 0; k < 8; ++k) { u2[k] = u1[k]; u1[k] = u[k]; }
            }
        }
#pragma unroll
        for (int i = 0; i < 8; ++i) { float ss = 0.f;
#pragma unroll
            for (int k = 0; k < 8; ++k) ss += cv[i][k] * cv[i][k];
            ss += __shfl_xor(ss, 1); ss += __shfl_xor(ss, 2); ss += __shfl_xor(ss, 4);
            if (cgp == 0) ssC[head * 64 + rg * 8 + i] = ss; }
        P2_LDS_BARRIER();
        const f32x4 gc0 = *(const f32x4*)(F.g_conv + ch0), gc1 = *(const f32x4*)(F.g_conv + ch0 + 4);
#pragma unroll
        for (int i = 0; i < 8; ++i) { const int rl = rg * 8 + i; float tot = 0.f;
#pragma unroll
            for (int w = 0; w < 8; ++w) tot += ssC[w * 64 + rl];
            const float rstd = 1.0f / sqrtf(tot * (1.0f / AW) + RMS_EPS);
            u32x4 w4; w4.x = cvtpk(cv[i][0] * rstd * gc0[0], cv[i][1] * rstd * gc0[1]); w4.y = cvtpk(cv[i][2] * rstd * gc0[2], cv[i][3] * rstd * gc0[3]);
            w4.z = cvtpk(cv[i][4] * rstd * gc1[0], cv[i][5] * rstd * gc1[1]); w4.w = cvtpk(cv[i][6] * rstd * gc1[2], cv[i][7] * rstd * gc1[3]);
            *(u32x4*)(MX + (size_t)(row0 + rl) * DM + 512 + ch0) = w4; }
    }
    if constexpr (DO_ATT) {
    f32x16 o[2][2];
#pragma unroll
    for (int d = 0; d < 2; ++d)
#pragma unroll
        for (int q2 = 0; q2 < 2; ++q2)
#pragma unroll
            for (int r = 0; r < 16; ++r) o[d][q2][r] = 0.f;
    float carry0 = 1.0f, carry1 = 1.0f;
    if constexpr (DO_CONV) asm volatile("s_waitcnt vmcnt(8)" ::: "memory"); else asm volatile("s_waitcnt vmcnt(0)" ::: "memory");
    for (int t = 0; ; ++t) {
        const int start = P0 + 32 - 32 * t, pp = t & 1;
        const bool lastt = (t == NT - 1), e1 = (t + 1 < NT), e2 = (t + 2 < NT);
        ATT_WAIT_VM(4 + (e1 ? 8 : 0));
        bf16x8 kf[4];
#pragma unroll
        for (int i = 0; i < 4; ++i) kf[i] = *(const LAS bf16x8*)(kbuf + pp * 4096 + koff[i]);
        asm volatile("s_waitcnt lgkmcnt(0)" ::: "memory");
        if (e2) ATT_DMA_K(start - 64, pp);
#pragma unroll
        for (int q2 = 0; q2 < 2; ++q2) {
            if (q2 == 0 && t == 0) continue;
            f32x16 s0;
#pragma unroll
            for (int r = 0; r < 16; ++r) s0[r] = 0.f;
#pragma unroll
            for (int s4 = 0; s4 < 4; ++s4) s0 = MFMA32(kf[s4], qf[q2][s4], s0);
            bf16x8 pf[2];
            float& carry = q2 ? carry1 : carry0;
            const bool edge = (start == P0 + 32 * q2) || lastt;
#ifdef PROBE_NOSB
            if (PROBE) { u32x4 w_; w_.x = cvtpk(s0[0], s0[1]); w_.y = cvtpk(s0[2], s0[3]); w_.z = cvtpk(s0[4], s0[5]); w_.w = cvtpk(s0[6], s0[7]); pf[0] = __builtin_bit_cast(bf16x8, w_); pf[1] = pf[0]; carry *= 0.5f; } else
#endif
            if (edge) sb_tile32<true>(s0, carry, start + 8 * hi, qpos + 32 * q2, hi0, pf);
            else sb_tile32<false>(s0, carry, start + 8 * hi, qpos + 32 * q2, hi0, pf);
            if (q2 == 0 || t == 0) ATT_WAIT_VM((e1 ? 8 : 0) + (e2 ? 4 : 0));
            bf16x8 vf[4];
#pragma unroll
            for (int i = 0; i < 4; ++i) vf[i] = *(const LAS bf16x8*)(vbuf + pp * 4096 + (i >> 1) * 2048 + voff2[i & 1]);
#pragma unroll
            for (int d = 0; d < 2; ++d)
#pragma unroll
                for (int s2 = 0; s2 < 2; ++s2) o[d][q2] = MFMA32(vf[d * 2 + s2], pf[s2], o[d][q2]);
        }
#ifdef PROBE_MAXT
        if (PROBE && t >= PROBE_MAXT - 1) break;
#endif
        if (lastt || __all((carry0 < EXIT_THR) && (carry1 < EXIT_THR))) break;
        asm volatile("s_waitcnt lgkmcnt(0)" ::: "memory");
        if (e2) ATT_DMA_V(start - 64, pp);
    }
    asm volatile("s_waitcnt vmcnt(0)" ::: "memory");
#ifdef PROBE_NOTAIL
    if (PROBE) { float keep_ = o[0][0][0] + o[1][1][3] + o[0][1][5] + o[1][0][7]; asm volatile("" :: "v"(keep_)); return; }
#endif
    int lane2 = lane; asm volatile("" : "+v"(lane2));
    const int l31b = lane2 & 31, hib = lane2 >> 5;
#pragma unroll
    for (int q2 = 0; q2 < 2; ++q2) {
        float ss = 0.f;
#pragma unroll
        for (int d = 0; d < 2; ++d)
#pragma unroll
            for (int r = 0; r < 16; ++r) ss += o[d][q2][r] * o[d][q2][r];
        ss += __shfl_xor(ss, 32);
        if (hib == 0) ssA[head * 64 + q2 * 32 + l31b] = ss;
    }
    P2_LDS_BARRIER();
    {
        LAS unsigned char* obuf = F.lds + head * 16384;
#pragma unroll
        for (int q2 = 0; q2 < 2; ++q2) {
            const int rl = q2 * 32 + l31b; float tot = 0.f;
#pragma unroll
            for (int h = 0; h < 8; ++h) tot += ssA[h * 64 + rl];
            const float rstd = 1.0f / sqrtf(tot * (1.0f / AW) + RMS_EPS);
#pragma unroll
            for (int d = 0; d < 2; ++d)
#pragma unroll
                for (int g = 0; g < 4; ++g) { const f32x4 ga = *(const f32x4*)(F.g_attn + head * 64 + 32 * d + 8 * g + 4 * hib);
                    u32x2 w; w.x = cvtpk(o[d][q2][4 * g] * rstd * ga[0], o[d][q2][4 * g + 1] * rstd * ga[1]); w.y = cvtpk(o[d][q2][4 * g + 2] * rstd * ga[2], o[d][q2][4 * g + 3] * rstd * ga[3]);
                    *(LAS u32x2*)(obuf + rl * 144 + (32 * d + 8 * g + 4 * hib) * 2) = w; }
        }
        asm volatile("s_waitcnt lgkmcnt(0)" ::: "memory");
#pragma unroll
        for (int k = 0; k < 8; ++k) { const int rr = 8 * k + (lane2 >> 3), ch = lane2 & 7;
            const u32x4 v = *(const LAS u32x4*)(obuf + rr * 144 + ch * 16);
            *(u32x4*)(MX + (size_t)(row0 + rr) * DM + head * 64 + ch * 8) = v; }
    }
    if constexpr (!DO_CONV) P2_LDS_BARRIER();
    }
#undef ATT_DMA_K
#undef ATT_DMA_V
#undef ATT_WAIT_VM
}

__device__ __forceinline__ void p4_router(Frame& F) {
    LAS unsigned char* img = F.lds;
    LAS int* hist = (LAS int*)(F.lds + 65536);
    for (int idx = F.tid; idx < 64 * 2 * 32; idx += 512) { const int s = idx >> 6, h = (idx >> 5) & 1, e = idx & 31; const int k0 = 16 * s + 8 * h; const float* wp = F.w_router + (size_t)k0 * NE + e; const float* gp = F.g_ffn + k0;
        u32x4 w; w.x = cvtpk(wp[0] * gp[0], wp[NE] * gp[1]); w.y = cvtpk(wp[2 * NE] * gp[2], wp[3 * NE] * gp[3]); w.z = cvtpk(wp[4 * NE] * gp[4], wp[5 * NE] * gp[5]); w.w = cvtpk(wp[6 * NE] * gp[6], wp[7 * NE] * gp[7]);
        *(LAS u32x4*)(img + idx * 16) = w; }
    if (F.tid < 32) hist[F.tid] = 0;
    __syncthreads();
    const bf16_t* A2 = wsp<bf16_t>(F, WS_A); float* rstd2 = wsp<float>(F, WS_RSTD2);
    int* tope = wsp<int>(F, WS_TOPE); float* gate = wsp<float>(F, WS_GATE); int* cnt = wsp<int>(F, WS_CNT);
    const int wg = F.vcu;
    if (F.wave < 4) {
        const int l31 = F.lane & 31, hi = F.lane >> 5, row = wg * 128 + F.wave * 32 + l31;
        f32x16 acc;
#pragma unroll
        for (int r = 0; r < 16; ++r) acc[r] = 0.f;
        const bf16_t* ap = A2 + (size_t)row * DM + 8 * hi;
        float ss = 0.f;
#pragma unroll 8
        for (int s = 0; s < 64; ++s) { const bf16x8 a = *(const LAS bf16x8*)(img + ((s * 2 + hi) * 32 + l31) * 16); const bf16x8 bq = *(const bf16x8*)(ap + 16 * s); acc = MFMA32(a, bq, acc);
            const u32x4 bu = __builtin_bit_cast(u32x4, bq);
            const float f0 = bflo(bu.x), f1 = bfhi(bu.x), f2 = bflo(bu.y), f3 = bfhi(bu.y), f4 = bflo(bu.z), f5 = bfhi(bu.z), f6 = bflo(bu.w), f7 = bfhi(bu.w);
            ss += ((f0 * f0 + f1 * f1) + (f2 * f2 + f3 * f3)) + ((f4 * f4 + f5 * f5) + (f6 * f6 + f7 * f7)); }
        ss += __shfl_xor(ss, 32);
        const float rstd = 1.0f / sqrtf(ss * (1.0f / DM) + RMS_EPS);
        float lg[16];
#pragma unroll
        for (int r = 0; r < 16; ++r) lg[r] = acc[r] * rstd + F.b_router[(r & 3) + 8 * (r >> 2) + 4 * hi];
        float cvv[8]; int cei[8];
#pragma unroll
        for (int k = 0; k < 4; ++k) { float best = -INFINITY; int bi = 0;
#pragma unroll
            for (int r = 0; r < 16; ++r) { const bool gtb = lg[r] > best; best = gtb ? lg[r] : best; bi = gtb ? r : bi; }
#pragma unroll
            for (int r = 0; r < 16; ++r) lg[r] = (r == bi) ? -INFINITY : lg[r];
            cvv[k] = best; cei[k] = (bi & 3) + 8 * (bi >> 2) + 4 * hi; }
#pragma unroll
        for (int k = 0; k < 4; ++k) { cvv[4 + k] = __shfl_xor(cvv[k], 32); cei[4 + k] = __shfl_xor(cei[k], 32); }
        float tv[4]; int te[4];
#pragma unroll
        for (int k = 0; k < 4; ++k) { float best = -INFINITY; int be = 1 << 30, bi = 0;
#pragma unroll
            for (int c = 0; c < 8; ++c) { const bool better = (cvv[c] > best) || (cvv[c] == best && cei[c] < be); best = better ? cvv[c] : best; be = better ? cei[c] : be; bi = better ? c : bi; }
#pragma unroll
            for (int c = 0; c < 8; ++c) { const bool hit = (c == bi); cvv[c] = hit ? -INFINITY : cvv[c]; cei[c] = hit ? (1 << 30) : cei[c]; }
            tv[k] = best; te[k] = be; }
        const float e1 = ex2((tv[1] - tv[0]) * LOG2E), e2 = ex2((tv[2] - tv[0]) * LOG2E), e3 = ex2((tv[3] - tv[0]) * LOG2E);
        const float inv = 1.0f / (1.0f + e1 + e2 + e3);
        if (hi == 0) {
            rstd2[row] = rstd;
            *(i32x4*)(tope + (size_t)row * 4) = (i32x4){te[0], te[1], te[2], te[3]};
            *(f32x4*)(gate + (size_t)row * 4) = (f32x4){inv, e1 * inv, e2 * inv, e3 * inv};
#pragma unroll
            for (int k = 0; k < 4; ++k) atomicAdd((int*)(hist + te[k]), 1);
        }
    }
    __syncthreads();
    if (F.tid < 32) cnt[wg * 32 + F.tid] = hist[F.tid];
    __syncthreads();
}

__device__ __forceinline__ void p5_scatter(Frame& F) {
    LAS int* tot = (LAS int*)F.lds; LAS int* pre = tot + 32; LAS int* ctr = tot + 64; LAS int* pstart = tot + 96;
    const int* cnt = wsp<int>(F, WS_CNT); const int wg = F.vcu;
    if (F.tid < 64) tot[F.tid] = 0;
    __syncthreads();
    { const int e = F.tid & 31, j = F.tid >> 5; int t = 0, p = 0;
        for (int w = j; w < 256; w += 16) { const int c = ld_i(cnt + w * 32 + e); t += c; p += (w < wg) ? c : 0; }
        atomicAdd((int*)(tot + e), t); atomicAdd((int*)(pre + e), p); }
    __syncthreads();
    if (F.tid == 0) { int run = 0; for (int e = 0; e < 32; ++e) { pstart[e] = run; run += (tot[e] + 255) & ~255; } pstart[32] = run; }
    __syncthreads();
    if (F.tid < 32) ctr[F.tid] = pstart[F.tid] + pre[F.tid];
    int* slot_tok = wsp<int>(F, WS_SLOTTOK); float* slot_gate = wsp<float>(F, WS_SLOTGATE); float* slot_rstd = wsp<float>(F, WS_SLOTRSTD);
    int* tile_e = wsp<int>(F, WS_TILEE);
    if (wg == 0) {
        if (F.tid < 32) { for (int rt = pstart[F.tid] >> 8; rt < (pstart[F.tid + 1] >> 8); ++rt) tile_e[rt] = F.tid; }
        if (F.tid == 0) tile_e[CAP_TILES] = pstart[32] >> 8;
        if (F.tid < 33) tile_e[CAP_TILES + 1 + F.tid] = pstart[F.tid] >> 8;
    }
    if (wg < 32) { const int e = wg; for (int s = pstart[e] + tot[e] + F.tid; s < pstart[e + 1]; s += 512) { slot_tok[s] = 0; slot_gate[s] = 0.f; slot_rstd[s] = 0.f; } }
    __syncthreads();
    { const int tok = wg * 128 + (F.tid >> 2), k = F.tid & 3;
        const int e = ld_i(wsp<int>(F, WS_TOPE) + tok * 4 + k);
        const int slot = atomicAdd((int*)(ctr + e), 1);
        slot_tok[slot] = tok; slot_gate[slot] = ld_f(wsp<float>(F, WS_GATE) + tok * 4 + k); slot_rstd[slot] = ld_f(wsp<float>(F, WS_RSTD2) + tok);
        wsp<int>(F, WS_TOKSLOT)[tok * 4 + k] = slot; }
    __syncthreads();
}

__device__ __forceinline__ void p8_combine(Frame& F, float* dst) {
    const int gw = F.vcu * NWAVES + F.wave, NGW = F.G * NWAVES;
    const unsigned char* ys = wsp<unsigned char>(F, WS_YS); const int* tokslot = wsp<int>(F, WS_TOKSLOT); const bf16_t* H1 = wsp<bf16_t>(F, WS_A);
    f32x4 gf[2][2];
#pragma unroll
    for (int j = 0; j < 2; ++j) { gf[j][0] = *(const f32x4*)(F.g_final + 512 * j + 8 * F.lane); gf[j][1] = *(const f32x4*)(F.g_final + 512 * j + 8 * F.lane + 4); }
    for (int m0 = gw; m0 < NTOK; m0 += 16 * NGW) {
        const int mrow = m0 + (F.lane >> 2) * NGW;
        const int myslot = (mrow < NTOK) ? ld_i(tokslot + (size_t)mrow * 4 + (F.lane & 3)) : 0;
#pragma unroll 1
        for (int r = 0; r < 16; r += 2) {
            const int ma = m0 + r * NGW, mb = ma + NGW;
            if (ma >= NTOK) break;
            const bool hasb = mb < NTOK; const int mbb = hasb ? mb : ma;
            int sa[4], sb[4];
#pragma unroll
            for (int k = 0; k < 4; ++k) { sa[k] = __builtin_amdgcn_readfirstlane(__shfl(myslot, 4 * r + k)); sb[k] = __builtin_amdgcn_readfirstlane(__shfl(myslot, 4 * r + 4 + k)); }
            u32x4 ha[2], hb[2]; u32x2 ya[2][4], yb[2][4];
#pragma unroll
            for (int j = 0; j < 2; ++j) { ha[j] = *(const u32x4*)(H1 + (size_t)ma * DM + 512 * j + 8 * F.lane); hb[j] = *(const u32x4*)(H1 + (size_t)mbb * DM + 512 * j + 8 * F.lane);
#pragma unroll
                for (int k = 0; k < 4; ++k) { ya[j][k] = *(const u32x2*)(ys + (size_t)sa[k] * DM + 512 * j + 8 * F.lane); yb[j][k] = *(const u32x2*)(ys + (size_t)sb[k] * DM + 512 * j + 8 * F.lane); } }
            f32x4 va[2][2], vb[2][2]; float ssa = 0.f, ssb = 0.f;
#pragma unroll
            for (int j = 0; j < 2; ++j) {
                f32x4 ea0 = {0.f, 0.f, 0.f, 0.f}, ea1 = ea0, eb0 = ea0, eb1 = ea0;
#pragma unroll
                for (int k = 0; k < 4; ++k) { const u32x2 y = ya[j][k], z = yb[j][k];
                    const f32x2 y0 = fp8lo(y.x), y1 = fp8hi(y.x), y2 = fp8lo(y.y), y3 = fp8hi(y.y), z0 = fp8lo(z.x), z1 = fp8hi(z.x), z2 = fp8lo(z.y), z3 = fp8hi(z.y);
                    ea0[0] += y0[0]; ea0[1] += y0[1]; ea0[2] += y1[0]; ea0[3] += y1[1]; ea1[0] += y2[0]; ea1[1] += y2[1]; ea1[2] += y3[0]; ea1[3] += y3[1];
                    eb0[0] += z0[0]; eb0[1] += z0[1]; eb0[2] += z1[0]; eb0[3] += z1[1]; eb1[0] += z2[0]; eb1[1] += z2[1]; eb1[2] += z3[0]; eb1[3] += z3[1]; }
                va[j][0] = (f32x4){bflo(ha[j].x), bfhi(ha[j].x), bflo(ha[j].y), bfhi(ha[j].y)} + ea0 * YINV; va[j][1] = (f32x4){bflo(ha[j].z), bfhi(ha[j].z), bflo(ha[j].w), bfhi(ha[j].w)} + ea1 * YINV;
                vb[j][0] = (f32x4){bflo(hb[j].x), bfhi(hb[j].x), bflo(hb[j].y), bfhi(hb[j].y)} + eb0 * YINV; vb[j][1] = (f32x4){bflo(hb[j].z), bfhi(hb[j].z), bflo(hb[j].w), bfhi(hb[j].w)} + eb1 * YINV;
#pragma unroll
                for (int q = 0; q < 2; ++q) { ssa += (va[j][q][0] * va[j][q][0] + va[j][q][1] * va[j][q][1]) + (va[j][q][2] * va[j][q][2] + va[j][q][3] * va[j][q][3]);
                    ssb += (vb[j][q][0] * vb[j][q][0] + vb[j][q][1] * vb[j][q][1]) + (vb[j][q][2] * vb[j][q][2] + vb[j][q][3] * vb[j][q][3]); } }
            const float ra = 1.0f / sqrtf(wave_sum(ssa) * (1.0f / DM) + RMS_EPS), rb = 1.0f / sqrtf(wave_sum(ssb) * (1.0f / DM) + RMS_EPS);
            float* oa = dst + (size_t)ma * DM + 8 * F.lane; float* ob = dst + (size_t)mbb * DM + 8 * F.lane;
#pragma unroll
            for (int j = 0; j < 2; ++j) { *(f32x4*)(oa + 512 * j) = va[j][0] * ra * gf[j][0]; *(f32x4*)(oa + 512 * j + 4) = va[j][1] * ra * gf[j][1]; }
            if (hasb) {
#pragma unroll
                for (int j = 0; j < 2; ++j) { *(f32x4*)(ob + 512 * j) = vb[j][0] * rb * gf[j][0]; *(f32x4*)(ob + 512 * j + 4) = vb[j][1] * rb * gf[j][1]; } }
        }
    }
}

#ifndef ALIGN_P3
#define ALIGN_P3 true
#endif
#ifndef ALIGN_P67
#define ALIGN_P67 true
#endif
#ifndef CONV_WG_MOD
#define CONV_WG_MOD 4
#endif
#ifndef REP3
#define REP3 1
#endif
#ifndef REP1
#define REP1 1
#endif
#ifndef REP6
#define REP6 1
#endif
#ifndef REP7
#define REP7 1
#endif
__device__ __forceinline__ void run_p1(Frame& F) {
    const int bx = (int)blockIdx.x, xcd = bx & 7, j = bx >> 3;
    constexpr int CM = CONV_WG_MOD, NCONV = 256 / CM;
    if (CONV_IN_P1 && F.G == 256 && (j & (CM - 1)) == CM - 1) { convert_experts(F, ((j / CM) * 8 + xcd) * NWAVES + F.wave, NCONV * NWAVES); return; }
    pg8::SchedIn S; S.A = (const char*)wsp<bf16_t>(F, WS_WIN); S.Bt = S.A; S.rep = REP1;
    if (CONV_IN_P1 && F.G == 256) { S.G = 256 - NCONV; S.c = ((CM - 1) * (j / CM) + (j & (CM - 1))) * 8 + xcd; } else { S.G = F.G; S.c = bx; }
    EpiIn E{EpiProj{wsp<bf16_t>(F, WS_Q), wsp<bf16_t>(F, WS_KB), wsp<bf16_t>(F, WS_CB), wsp<bf16_t>(F, WS_CC), wsp<float>(F, WS_RSTD1)}, EpiVt{wsp<bf16_t>(F, WS_VT), wsp<float>(F, WS_RSTD1)}};
    pg8::gemm_phase<EpiIn, pg8::SchedIn, false>(F.lds, S, E);
}
template <bool DO_CONV, bool DO_ATT, bool PROBE = false>
__device__ __forceinline__ void run_p2(Frame& F) {
    for (int u = F.vcu; u < NB * (SEQ / 64); u += F.G) p2_unit<DO_CONV, DO_ATT, PROBE>(F, u >> 6, u & 63);
}
__device__ __forceinline__ void run_p3(Frame& F) {
#ifdef P3_STAGGER
    if (F.vcu & 1) { for (int i_ = 0; i_ < P3_STAGGER; ++i_) __builtin_amdgcn_s_sleep(127); }
#endif
    pg8::SchedPlain S; S.init(wsp<bf16_t>(F, WS_MIXED), wsp<bf16_t>(F, WS_WOUT), NTOK, DM, F.G, (int)blockIdx.x); S.rep = REP3;
    EpiOut E{F.x, wsp<bf16_t>(F, WS_A), wsp<unsigned char>(F, WS_A8), F.g_ffn};
    pg8::gemm_phase<EpiOut, pg8::SchedPlain, false, false, ALIGN_P3>(F.lds, S, E);
}
__device__ __forceinline__ void run_p6(Frame& F) {
    pg8::SchedGrouped<1024> S; S.A = (const char*)wsp<unsigned char>(F, WS_A8); S.Bt = (const char*)wsp<unsigned char>(F, WS_WGU); S.estep = (size_t)2048 * 1024; S.nN = 8; S.G = F.G; S.c = F.vcu; S.rep = REP6;
    S.tile_e = wsp<int>(F, WS_TILEE); S.slot_tok = wsp<int>(F, WS_SLOTTOK); S.ntiles = __builtin_amdgcn_readfirstlane(ld_i(S.tile_e + CAP_TILES));
    S.ltile = (LAS int*)(F.lds + RING_BYTES + 1024); S.ltok = (LAS int*)(F.lds + RING_BYTES + 4096); S.setup();
    EpiGU E{wsp<unsigned char>(F, WS_HID), F.b_gu, wsp<float>(F, WS_SLOTRSTD)};
    pg8::gemm_phase<EpiGU, pg8::SchedGrouped<1024>, true, true, ALIGN_P67>(F.lds, S, E);
}
__device__ __forceinline__ void run_p7(Frame& F) {
    pg8::SchedGrouped<1024> S; S.A = (const char*)wsp<unsigned char>(F, WS_HID); S.Bt = (const char*)wsp<unsigned char>(F, WS_WD); S.estep = (size_t)1024 * 1024; S.nN = 4; S.G = F.G; S.c = F.vcu; S.rep = REP7;
    S.tile_e = wsp<int>(F, WS_TILEE); S.slot_tok = wsp<int>(F, WS_SLOTTOK); S.ntiles = __builtin_amdgcn_readfirstlane(ld_i(S.tile_e + CAP_TILES));
    S.ltile = (LAS int*)(F.lds + RING_BYTES + 1024); S.ltok = (LAS int*)(F.lds + RING_BYTES + 4096); S.setup();
    EpiDown E{wsp<unsigned char>(F, WS_YS), F.b_down, wsp<float>(F, WS_SLOTGATE)};
    pg8::gemm_phase<EpiDown, pg8::SchedGrouped<1024>, false, true, ALIGN_P67>(F.lds, S, E);
}

constexpr int N_PHASES = 9;
__global__ void __launch_bounds__(NWAVES * 64, 2) fwd(Args args) {
    extern __shared__ __attribute__((aligned(16))) unsigned char lds_raw[];
    Frame F;
    F.lds = (LAS unsigned char*)lds_raw;
    F.tid = threadIdx.x; F.lane = F.tid & 63; F.wave = __builtin_amdgcn_readfirstlane(F.tid >> 6);
    F.G = gridDim.x; { const int bx = blockIdx.x; F.vcu = (F.G % 8 == 0) ? (bx % 8) * (F.G / 8) + bx / 8 : bx; }
    F.ws = args.ws; F.ctl = (gu32*)(args.ws + WS_CTL); F.out = args.out;
    F.x = args.in[0]; F.meta = args.in[1]; F.g_mix = args.in[2]; F.w_in = args.in[3]; F.g_attn = args.in[4]; F.conv_w = args.in[5]; F.conv_b = args.in[6]; F.g_conv = args.in[7];
    F.w_out = args.in[8]; F.g_ffn = args.in[9]; F.w_router = args.in[10]; F.b_router = args.in[11]; F.w_gu = args.in[12]; F.b_gu = args.in[13]; F.w_down = args.in[14]; F.b_down = args.in[15]; F.g_final = args.in[16];
    volatile LAS unsigned* MISC = (volatile LAS unsigned*)(F.lds + MISC_OFF);
    for (int u = F.tid; u < (LDS_BYTES - LDSCTL_OFF) / 4; u += NWAVES * 64) ((LAS unsigned*)(F.lds + LDSCTL_OFF))[u] = 0u;
    __syncthreads();
    const int lo = args.ph_lo, hi = args.ph_hi;
    const bool multi = (hi - lo) > 1;
    XcdBarrier bar; bar.bar = (unsigned*)(F.ctl + CW_BAR); bar.x = 0; bar.st = nullptr;
    if (multi) bar = xcd_barrier_post((unsigned*)(F.ctl + CW_BAR), MISC + 8);
#ifndef PH_MASK
#define PH_MASK 0x1ff
#endif
#define IN(k) (((PH_MASK >> (k)) & 1) && lo <= (k) && (k) < hi)
#define SEAM(k) do { if (IN(k) && IN((k) + 1)) xcd_barrier(bar); } while (0)
#ifndef DUP_MASK
#define DUP_MASK 0
#endif
#define DUPK(k) ((((DUP_MASK) >> (k)) & 1) != 0)

    if (IN(0)) { p0_prologue(F); if (DUPK(0)) { xcd_barrier(bar); p0_prologue(F); } }
    SEAM(0);
    if (IN(1)) { run_p1(F); if (DUPK(1)) { xcd_barrier(bar); run_p1(F); } }
    SEAM(1);
#ifndef P2DUP_CONV
#define P2DUP_CONV true
#endif
#ifndef P2DUP_ATT
#define P2DUP_ATT true
#endif
#ifndef P2M_CONV
#define P2M_CONV true
#endif
#ifndef P2M_ATT
#define P2M_ATT true
#endif
    if (IN(2)) { run_p2<P2M_CONV, P2M_ATT>(F); if (DUPK(2)) { xcd_barrier(bar); run_p2<P2DUP_CONV, P2DUP_ATT, true>(F); } }
    SEAM(2);
    if (IN(3)) { run_p3(F); if (DUPK(3)) { xcd_barrier(bar); run_p3(F); } }
    SEAM(3);
#ifdef XTRA_BAR
    for (int xb_ = 0; xb_ < XTRA_BAR; ++xb_) xcd_barrier(bar);
#endif
    if (IN(4)) { p4_router(F); if (DUPK(4)) { xcd_barrier(bar); p4_router(F); } }
    SEAM(4);
    if (IN(5)) { p5_scatter(F); if (DUPK(5)) { xcd_barrier(bar); p5_scatter(F); } }
    SEAM(5);
#ifdef PREWARM_W
    if (IN(6)) { const u32x4* wp_ = wsp<u32x4>(F, WS_WGU); const size_t n16_ = (size_t)PREWARM_W * 1024 * 1024 / 16; u32x4 a_ = {0u, 0u, 0u, 0u};
        for (size_t i_ = (size_t)blockIdx.x * 512 + F.tid; i_ < n16_; i_ += (size_t)F.G * 512) { const u32x4 v_ = wp_[i_]; a_.x ^= v_.x; a_.y ^= v_.y; a_.z ^= v_.z; a_.w ^= v_.w; }
        asm volatile("" :: "v"(a_.x), "v"(a_.y), "v"(a_.z), "v"(a_.w)); }
#endif
    if (IN(6)) { run_p6(F); if (DUPK(6)) { xcd_barrier(bar); run_p6(F); } }
    SEAM(6);
#ifdef DUP7_LOOP
    if (IN(7)) { for (int rep_ = 0; rep_ < 2; ++rep_) { if (rep_) xcd_barrier(bar); run_p7(F); } }
#else
    if (IN(7)) { run_p7(F); if (DUPK(7)) { xcd_barrier(bar); run_p7(F); } }
#endif
    SEAM(7);
    if (IN(8)) { if (DUPK(8)) { p8_combine(F, wsp<float>(F, WS_HID)); xcd_barrier(bar); } p8_combine(F, F.out); }
#undef IN
#undef SEAM
}

#ifndef MK_N_LAUNCHES
#define MK_N_LAUNCHES 1
#endif
extern "C" void kernel_launch(void* const* d_in, const int* in_sizes, int n_in, void* d_out, int out_size, void* d_ws, size_t ws_size, hipStream_t stream) {
    static int grid = 0;
    if (grid == 0) {
        if (n_in != 17 || out_size != NTOK * DM || ws_size < WS_END) { fprintf(stderr, "kernel_launch: unexpected problem (n_in %d out %d ws %zu)\n", n_in, out_size, ws_size); grid = -1; return; }
        int dev = 0, cus = 0, per_cu = 0;
        if (hipGetDevice(&dev) != hipSuccess || hipDeviceGetAttribute(&cus, hipDeviceAttributeMultiprocessorCount, dev) != hipSuccess) { grid = -1; return; }
        if (hipFuncSetAttribute((const void*)fwd, hipFuncAttributeMaxDynamicSharedMemorySize, LDS_BYTES) != hipSuccess) { fprintf(stderr, "kernel_launch: hipFuncSetAttribute failed\n"); grid = -1; return; }
        if (hipOccupancyMaxActiveBlocksPerMultiprocessor(&per_cu, (const void*)fwd, NWAVES * 64, LDS_BYTES) != hipSuccess || per_cu < 1) { fprintf(stderr, "kernel_launch: occupancy query says %d\n", per_cu); }
        (void)hipGetLastError();
        grid = cus;
        if (grid != 256) fprintf(stderr, "kernel_launch: %d CUs (built for 256)\n", grid);
    }
    if (grid < 0) return;
    (void)hipMemsetAsync((char*)d_ws + WS_CTL, 0, CTL_ZERO_BYTES, stream);
    Args a{};
    for (int i = 0; i < 17; ++i) a.in[i] = (const float*)d_in[i];
    a.out = (float*)d_out; a.ws = (unsigned char*)d_ws;
    if (MK_N_LAUNCHES == 1) { a.ph_lo = 0; a.ph_hi = N_PHASES; hipLaunchKernelGGL(fwd, dim3(grid), dim3(NWAVES * 64), LDS_BYTES, stream, a); }
    else for (int p = 0; p < N_PHASES; ++p) { a.ph_lo = p; a.ph_hi = p + 1; hipLaunchKernelGGL(fwd, dim3(grid), dim3(NWAVES * 64), LDS_BYTES, stream, a); }
    const hipError_t le = hipPeekAtLastError();
    if (le != hipSuccess) fprintf(stderr, "kernel_launch: launch failed: %s\n", hipGetErrorName(le));
}
```
